# Optimizing an MI355X kernel written in HIP

```python
import jax, jax.numpy as jnp
from jax import lax
import numpy as np

D_MODEL = 2048
BATCH = 2
SEQ = 4096
DEPTH = 1

GRID_W = 64
CTX_LEN = 256
M_HEADS = 4
M_V = D_MODEL // 2
M_DV = M_V // M_HEADS
M_QK = M_V // 2
M_DQK = M_QK // M_HEADS
M_CHUNK = 64
R_W = D_MODEL // 2
R_N = 64
R_HEADS = R_W // R_N
R_LORA_W = 64
R_LORA_A = 64
R_LORA_G = 160
D_MIX = M_V + R_W
SPLIT_SIZES = (M_QK, M_QK, M_V, M_V, 4 * M_HEADS, R_W, R_W, R_W, 2 * R_LORA_W, 2 * R_LORA_A, R_LORA_G)
N_IN = 2 * M_QK + 2 * M_V + 4 * M_HEADS + 3 * R_W + 2 * R_LORA_W + 2 * R_LORA_A + R_LORA_G
D_FF = ((8 * D_MODEL // 3 + 255) // 256) * 256
NORM_EPS = 1e-6
GN_EPS = 64e-5

kernel_name = "hybrid_mlstm_rwkv7_prefix_dit_block"


def rms_norm(x, g):
    x32 = x.astype(jnp.float32)
    y = x32 * lax.rsqrt(jnp.mean(x32 * x32, axis=-1, keepdims=True) + NORM_EPS)
    return (y * g.astype(jnp.float32)).astype(x.dtype)


def adaln(cvec, w, b):
    mod = (jax.nn.silu(cvec) @ w + b).reshape(-1, 1, 6 * D_MODEL)
    return jnp.split(mod, 6, axis=-1)


def modulate(h, shift, scale):
    return h * (1 + scale) + shift


def conv1d_centred(x, w, b):
    xp = jnp.pad(x, ((0, 0), (1, 1), (0, 0)))
    return xp[:, :-2] * w[0] + xp[:, 1:-1] * w[1] + xp[:, 2:] * w[2] + b


def mlstm_chunkwise(q, k, v, i_pre, logf, state):
    B, H, L, _ = q.shape
    nc = L // M_CHUNK
    to_chunks = lambda t: jnp.moveaxis(t.reshape((B, H, nc, M_CHUNK) + t.shape[3:]), 2, 0)
    tri = jnp.tril(jnp.ones((M_CHUNK, M_CHUNK), dtype=bool))

    def body(carry, xs):
        C, n, m = carry
        qc, kc, vc, ic, fc = xs
        bcum = jnp.cumsum(fc, axis=-1)
        dmat = bcum[..., :, None] - bcum[..., None, :] + ic[..., None, :]
        dmat = jnp.where(tri, dmat, -jnp.inf)
        m_inter = bcum + m[..., None]
        m_j = jnp.maximum(m_inter, jnp.max(dmat, axis=-1))
        s = jnp.einsum("bhjd,bhsd->bhjs", qc, kc) * jnp.exp(dmat - m_j[..., None])
        inter = jnp.exp(m_inter - m_j)
        num = jnp.einsum("bhjs,bhsv->bhjv", s, vc) + inter[..., None] * jnp.einsum("bhvd,bhjd->bhjv", C, qc)
        den = jnp.sum(s, axis=-1) + inter * jnp.einsum("bhd,bhjd->bhj", n, qc)
        h = num / jnp.maximum(jnp.abs(den), jnp.exp(-m_j))[..., None]
        b_last = bcum[..., -1]
        glog = b_last[..., None] - bcum + ic
        m_new = jnp.maximum(b_last + m, jnp.max(glog, axis=-1))
        wk = jnp.exp(glog - m_new[..., None])
        decay = jnp.exp(b_last + m - m_new)
        C_new = decay[..., None, None] * C + jnp.einsum("bhs,bhsv,bhsd->bhvd", wk, vc, kc)
        n_new = decay[..., None] * n + jnp.einsum("bhs,bhsd->bhd", wk, kc)
        return (C_new, n_new, m_new), h

    xs = (to_chunks(q), to_chunks(k), to_chunks(v), to_chunks(i_pre), to_chunks(logf))
    final, hs = lax.scan(body, state, xs)
    h = jnp.moveaxis(hs, 0, 2).reshape(B, H, L, v.shape[-1])
    return h, final


def rwkv7_scan(r, w, k, v, kk, a, s0, reverse):
    def step(s, xs):
        r_t, w_t, k_t, v_t, kk_t, a_t = xs
        s = (s * w_t[:, :, None, :]
             - jnp.einsum("bhvk,bhk->bhv", s, kk_t)[..., None] * (kk_t * a_t)[:, :, None, :]
             + v_t[..., :, None] * k_t[..., None, :])
        return s, jnp.einsum("bhvk,bhk->bhv", s, r_t)
    xs = tuple(jnp.moveaxis(t, 1, 0) for t in (r, w, k, v, kk, a))
    s_final, ys = lax.scan(step, s0, xs, reverse=reverse)
    return jnp.moveaxis(ys, 0, 1), s_final


def zero_state(batch):
    mz = (jnp.zeros((batch, M_HEADS, M_DV, M_DQK), jnp.float32),
          jnp.zeros((batch, M_HEADS, M_DQK), jnp.float32),
          jnp.zeros((batch, M_HEADS), jnp.float32))
    sz = jnp.zeros((batch, R_HEADS, R_N, R_N), jnp.float32)
    return (mz, mz, sz, sz)


def hybrid_mixers(h, p, state):
    B, L, _ = h.shape
    proj = (h @ p["w_in"]).astype(jnp.float32)
    (q, k, v_m, o_m, gates, r, k_r, v_r, lw, la, lg) = jnp.split(
        proj, np.cumsum(SPLIT_SIZES)[:-1].tolist(), axis=-1)

    qk = conv1d_centred(jnp.concatenate([q, k], axis=-1), p["m_conv_w"], p["m_conv_b"])
    q, k = jnp.split(qk, 2, axis=-1)
    heads = lambda t, n: t.reshape(B, L, -1, n).transpose(0, 2, 1, 3)
    q = heads(q, M_DQK) * (M_DQK ** -0.5)
    k = heads(k, M_DQK)
    vm = heads(v_m, M_DV)
    g4 = (gates.reshape(B, L, 4, M_HEADS) + p["m_gate_b"]).transpose(2, 0, 3, 1)
    i_f, i_b = g4[0], g4[1]
    lf_f, lf_b = jax.nn.log_sigmoid(g4[2]), jax.nn.log_sigmoid(g4[3])
    flip = lambda t: jnp.flip(t, axis=2)
    h_f, st_mf = mlstm_chunkwise(q, k, vm, i_f, lf_f, state[0])
    h_b, st_mb = mlstm_chunkwise(flip(q), flip(k), flip(vm), flip(i_b), flip(lf_b), state[1])
    hm = h_f + flip(h_b)
    hm = hm * lax.rsqrt(jnp.mean(hm * hm, axis=-1, keepdims=True) + NORM_EPS)
    hm = hm.transpose(0, 2, 1, 3).reshape(B, L, M_V) * p["m_norm_g"] * jax.nn.sigmoid(o_m)

    lw = lw.reshape(B, L, 2, R_LORA_W)
    la = la.reshape(B, L, 2, R_LORA_A)
    wlog = -jax.nn.softplus(-(p["r_w0"] + jnp.einsum("bldr,drc->bldc", jnp.tanh(lw), p["r_w_up"]))) - 0.5
    decay = jnp.exp(-jnp.exp(wlog))
    a = jax.nn.sigmoid(p["r_a0"] + jnp.einsum("bldr,drc->bldc", la, p["r_a_up"]))
    g = jax.nn.sigmoid(lg) @ p["r_g_up"]
    hd = lambda t: t.reshape(B, L, R_HEADS, R_N)
    kk = hd(k_r * p["r_k_k"])
    kk = kk * lax.rsqrt(jnp.sum(kk * kk, axis=-1, keepdims=True) + 1e-12)
    k_dir = k_r[:, :, None, :] * (1 + (a - 1) * p["r_k_a"])
    rh, vh = hd(r), hd(v_r)
    y_f, s_f = rwkv7_scan(rh, hd(decay[:, :, 0]), hd(k_dir[:, :, 0]), vh, kk, hd(a[:, :, 0]), state[2], False)
    y_b, s_b = rwkv7_scan(rh, hd(decay[:, :, 1]), hd(k_dir[:, :, 1]), vh, kk, hd(a[:, :, 1]), state[3], True)
    y = y_f + y_b
    mu = jnp.mean(y, axis=-1, keepdims=True)
    var = jnp.mean(jnp.square(y - mu), axis=-1, keepdims=True)
    y = ((y - mu) * lax.rsqrt(var + GN_EPS)).reshape(B, L, R_W) * p["r_gn_w"] + p["r_gn_b"]
    bonus = jnp.sum(rh * hd(k_dir[:, :, 0] + k_dir[:, :, 1]) * p["r_r_k"], axis=-1, keepdims=True) * vh
    y = (y + bonus.reshape(B, L, R_W)) * g

    out = jnp.concatenate([hm, y], axis=-1).astype(h.dtype)
    return out, (st_mf, st_mb, s_f, s_b)


def conv_ffn(h, rows, cols, p):
    B, L, _ = h.shape
    u = (h @ p["f_w_up"]).reshape(B, rows, cols, D_FF)
    gt = h @ p["f_w_gate"]
    kern = p["f_conv_w"][:, :, None, :].astype(u.dtype)
    u = lax.conv_general_dilated(u, kern, (1, 1), "SAME",
                                 dimension_numbers=("NHWC", "HWIO", "NHWC"),
                                 feature_group_count=D_FF) + p["f_conv_b"]
    u = u.reshape(B, L, D_FF)
    return (jax.nn.gelu(u, approximate=True) * gt) @ p["f_w_down"]


def setup_inputs(seed: int = 0) -> dict:
    key = jax.random.key(seed)
    ks = jax.random.split(key, 32)
    nrm = lambda k, shape, s: jax.random.normal(k, shape, jnp.float32) * s
    D = D_MODEL
    m_gate_b = jnp.concatenate([
        nrm(ks[9], (DEPTH, 2, M_HEADS), 0.1),
        3.0 + 3.0 * jax.random.uniform(ks[10], (DEPTH, 2, M_HEADS), jnp.float32)], axis=1)
    return {
        "x": nrm(ks[0], (BATCH, SEQ, D), 1.0),
        "c": nrm(ks[1], (BATCH, D), 1.0),
        "ctx": nrm(ks[2], (BATCH, CTX_LEN, D), 1.0),
        "c_ctx": nrm(ks[3], (D,), 1.0),
        "w_mod": nrm(ks[4], (DEPTH, D, 6 * D), 0.5 * D ** -0.5),
        "b_mod": nrm(ks[5], (DEPTH, 6 * D), 0.02),
        "g_norm1": 1.0 + nrm(ks[6], (DEPTH, D), 0.02),
        "g_norm2": 1.0 + nrm(ks[7], (DEPTH, D), 0.02),
        "w_in": nrm(ks[8], (DEPTH, D, N_IN), D ** -0.5),
        "m_conv_w": nrm(ks[11], (DEPTH, 3, 2 * M_QK), 3 ** -0.5),
        "m_conv_b": nrm(ks[12], (DEPTH, 2 * M_QK), 0.02),
        "m_gate_b": m_gate_b,
        "m_norm_g": 1.0 + nrm(ks[13], (DEPTH, M_V), 0.02),
        "r_w0": jax.random.uniform(ks[14], (DEPTH, 2, R_W), jnp.float32, -6.0, 0.0),
        "r_w_up": nrm(ks[15], (DEPTH, 2, R_LORA_W, R_W), 0.5 * R_LORA_W ** -0.5),
        "r_a0": nrm(ks[16], (DEPTH, 2, R_W), 0.1),
        "r_a_up": nrm(ks[17], (DEPTH, 2, R_LORA_A, R_W), 0.5 * R_LORA_A ** -0.5),
        "r_g_up": nrm(ks[18], (DEPTH, R_LORA_G, R_W), R_LORA_G ** -0.5),
        "r_k_k": 0.85 + nrm(ks[19], (DEPTH, R_W), 0.05),
        "r_k_a": 1.0 + nrm(ks[20], (DEPTH, R_W), 0.05),
        "r_r_k": nrm(ks[21], (DEPTH, R_HEADS, R_N), 0.1),
        "r_gn_w": 1.0 + nrm(ks[22], (DEPTH, R_W), 0.02),
        "r_gn_b": nrm(ks[23], (DEPTH, R_W), 0.02),
        "w_out": nrm(ks[24], (DEPTH, D_MIX, D), D_MIX ** -0.5),
        "f_w_up": nrm(ks[25], (DEPTH, D, D_FF), D ** -0.5),
        "f_w_gate": nrm(ks[26], (DEPTH, D, D_FF), D ** -0.5),
        "f_conv_w": nrm(ks[27], (DEPTH, 3, 3, D_FF), 1.0 / 3.0),
        "f_conv_b": nrm(ks[28], (DEPTH, D_FF), 0.02),
        "f_w_down": nrm(ks[29], (DEPTH, D_FF, D), D_FF ** -0.5),
        "g_final": 1.0 + nrm(ks[30], (D,), 0.02),
    }


def reference(x, c, ctx, c_ctx, w_mod, b_mod, g_norm1, g_norm2, w_in, m_conv_w, m_conv_b, m_gate_b,
              m_norm_g, r_w0, r_w_up, r_a0, r_a_up, r_g_up, r_k_k, r_k_a, r_r_k, r_gn_w, r_gn_b,
              w_out, f_w_up, f_w_gate, f_conv_w, f_conv_b, f_w_down, g_final):
    B, L, _ = x.shape
    rows = L // GRID_W
    ctx_len = ctx.shape[1]
    for layer in range(DEPTH):
        last = layer == DEPTH - 1
        p = {
            "w_in": w_in[layer], "m_conv_w": m_conv_w[layer], "m_conv_b": m_conv_b[layer],
            "m_gate_b": m_gate_b[layer], "m_norm_g": m_norm_g[layer],
            "r_w0": r_w0[layer], "r_w_up": r_w_up[layer], "r_a0": r_a0[layer], "r_a_up": r_a_up[layer],
            "r_g_up": r_g_up[layer], "r_k_k": r_k_k[layer], "r_k_a": r_k_a[layer], "r_r_k": r_r_k[layer],
            "r_gn_w": r_gn_w[layer], "r_gn_b": r_gn_b[layer],
            "f_w_up": f_w_up[layer], "f_w_gate": f_w_gate[layer], "f_conv_w": f_conv_w[layer],
            "f_conv_b": f_conv_b[layer], "f_w_down": f_w_down[layer],
        }
        sh1, sc1, gt1, sh2, sc2, gt2 = adaln(c, w_mod[layer], b_mod[layer])
        csh1, csc1, cgt1, csh2, csc2, cgt2 = adaln(c_ctx, w_mod[layer], b_mod[layer])

        hc = modulate(rms_norm(ctx, g_norm1[layer]), csh1, csc1)
        yc, ctx_state = hybrid_mixers(hc, p, zero_state(ctx.shape[0]))
        hx = modulate(rms_norm(x, g_norm1[layer]), sh1, sc1)
        yx, _ = hybrid_mixers(hx, p, ctx_state)
        x = x + gt1 * (yx @ w_out[layer])

        hx = modulate(rms_norm(x, g_norm2[layer]), sh2, sc2)
        x = x + gt2 * conv_ffn(hx, rows, GRID_W, p)

        if not last:
            ctx = ctx + cgt1 * (yc @ w_out[layer])
            hc = modulate(rms_norm(ctx, g_norm2[layer]), csh2, csc2)
            ctx = ctx + cgt2 * conv_ffn(hc, 1, ctx_len, p)
    return rms_norm(x, g_final)
```

```cpp
#include <hip/hip_runtime.h>
#include <cstdint>
#include <cstdio>

typedef unsigned short bf16_t;
typedef float f32x4 __attribute__((ext_vector_type(4)));
typedef float f32x2 __attribute__((ext_vector_type(2)));
typedef unsigned u32x4 __attribute__((ext_vector_type(4)));
typedef unsigned u32x2 __attribute__((ext_vector_type(2)));

__device__ __forceinline__ float bf2f(bf16_t v) { return __uint_as_float(((unsigned)v) << 16); }
__device__ __forceinline__ unsigned f2bf(float f) { unsigned u = __float_as_uint(f); return (u + 0x7fffu + ((u >> 16) & 1u)) >> 16; }
__device__ __forceinline__ unsigned pk2(float lo, float hi) { return f2bf(lo) | (f2bf(hi) << 16); }
__device__ __forceinline__ float bflo(unsigned w) { return __uint_as_float(w << 16); }
__device__ __forceinline__ float bfhi(unsigned w) { return __uint_as_float(w & 0xffff0000u); }

constexpr int D = 2048, NB = 2, L = 4096, LC = 256;
constexpr int NTOK = NB * L, NCTX = NB * LC, NROW = NTOK + NCTX;
constexpr int NIN = 6576, LDP = 6656;
constexpr int C_Q = 0, C_K = 512, C_VM = 1024, C_OM = 2048, C_G = 3072, C_R = 3088, C_KR = 4112, C_VR = 5136, C_LW = 6160, C_LA = 6288, C_LG = 6416;
constexpr int FF = 5632, NMOD = 12288;
constexpr int RW = 1024;
constexpr int NSTEP = LC + L;

constexpr size_t MiB = 1u << 20;
constexpr size_t WS_CTL = 0;
constexpr size_t WS_MOD = 1 * MiB;
constexpr size_t WS_GATES = 2 * MiB;
constexpr size_t WS_BONUS = 3 * MiB;
constexpr size_t WS_WOUT_T = 8 * MiB;
constexpr size_t WS_WIN_T = 16 * MiB;
constexpr size_t WS_HX = 42 * MiB;
constexpr size_t WS_KK = 16 * MiB;
constexpr size_t WS_QC = 33 * MiB;
constexpr size_t WS_KC = 42 * MiB;
constexpr size_t WS_GG = 51 * MiB;
constexpr size_t WS_PROJ = 76 * MiB;
constexpr size_t WS_LWF = 187 * MiB;
constexpr size_t WS_LWB = 204 * MiB;
constexpr size_t WS_AF = 221 * MiB;
constexpr size_t WS_AB = 238 * MiB;
constexpr size_t WS_YF = 255 * MiB;
constexpr size_t WS_YB = 271 * MiB;
constexpr size_t WS_HF = 287 * MiB;
constexpr size_t WS_HB = 303 * MiB;
constexpr size_t WS_MIX = 319 * MiB;
constexpr size_t WS_HX2 = 8 * MiB;
constexpr size_t WS_WUG_T = 40 * MiB;
constexpr size_t WS_WDN_T = 84 * MiB;
constexpr size_t WS_UG = 106 * MiB;
constexpr size_t WS_ACT = 282 * MiB;
constexpr size_t WS_END = 370 * MiB;

struct P {
    const float *x, *c, *ctx, *c_ctx, *w_mod, *b_mod, *g_norm1, *g_norm2, *w_in, *m_conv_w, *m_conv_b, *m_gate_b, *m_norm_g;
    const float *r_w0, *r_w_up, *r_a0, *r_a_up, *r_g_up, *r_k_k, *r_k_a, *r_r_k, *r_gn_w, *r_gn_b, *w_out, *f_w_up, *f_w_gate, *f_conv_w, *f_conv_b, *f_w_down, *g_final;
    float* out; unsigned char* ws;
};

__device__ __forceinline__ float wave_sum(float v) {
#pragma unroll
    for (int o = 1; o < 64; o <<= 1) v += __shfl_xor(v, o);
    return v;
}
__device__ __forceinline__ float sigmoidf_(float x) { return 1.f / (1.f + __expf(-x)); }
__device__ __forceinline__ float softplusf_(float x) { return fmaxf(x, 0.f) + log1pf(__expf(-fabsf(x))); }

__device__ __forceinline__ void row_seq(int r, int& base, int& t, int& len) {
    if (r < NTOK) { base = r & ~(L - 1); t = r & (L - 1); len = L; } else { const int q = r - NTOK; base = NTOK + (q & ~(LC - 1)); t = q & (LC - 1); len = LC; }
}
__device__ __forceinline__ int step_row(int s, int b, int dir) {
    if (s < LC) { const int t = dir ? (LC - 1 - s) : s; return NTOK + b * LC + t; }
    const int u = s - LC; const int t = dir ? (L - 1 - u) : u; return b * L + t;
}

__device__ void phase_mod(const P& p, int bid, int nb, float* lds) {
    float* sc = lds;
    float* red = lds + 3 * 2048;
    const int tid = threadIdx.x;
    for (int i = tid; i < 3 * 2048; i += blockDim.x) { const int v = i >> 11, k = i & 2047; const float xv = v < 2 ? p.c[v * 2048 + k] : p.c_ctx[k]; sc[i] = xv / (1.f + __expf(-xv)); }
    __syncthreads();
    float* MOD = (float*)(p.ws + WS_MOD);
    for (int cb = bid; cb < NMOD / 48; cb += nb) {
        const int cg = tid % 12, kl = tid / 12;
        float a[3][4];
#pragma unroll
        for (int v = 0; v < 3; ++v)
#pragma unroll
            for (int j = 0; j < 4; ++j) a[v][j] = 0.f;
        if (kl < 42) {
            for (int k = kl; k < 2048; k += 42) {
                const f32x4 w = *(const f32x4*)(p.w_mod + (size_t)k * NMOD + cb * 48 + cg * 4);
#pragma unroll
                for (int v = 0; v < 3; ++v) { const float s = sc[v * 2048 + k]; a[v][0] += s * w.x; a[v][1] += s * w.y; a[v][2] += s * w.z; a[v][3] += s * w.w; }
            }
#pragma unroll
            for (int v = 0; v < 3; ++v)
#pragma unroll
                for (int j = 0; j < 4; ++j) red[kl * 144 + v * 48 + cg * 4 + j] = a[v][j];
        }
        __syncthreads();
        if (tid < 144) {
            float s = 0.f;
            for (int k = 0; k < 42; ++k) s += red[k * 144 + tid];
            const int v = tid / 48, cc = tid % 48;
            MOD[v * NMOD + cb * 48 + cc] = s + p.b_mod[cb * 48 + cc];
        }
        __syncthreads();
    }
}

__device__ __forceinline__ void normmod_row(const float* src, const float* g, const float* sh, const float* sc, bf16_t* dst, int lane) {
    f32x4 v[8]; float s = 0.f;
#pragma unroll
    for (int j = 0; j < 8; ++j) { v[j] = *((const f32x4*)src + lane + 64 * j); s += (v[j].x * v[j].x + v[j].y * v[j].y) + (v[j].z * v[j].z + v[j].w * v[j].w); }
    const float rs = rsqrtf(wave_sum(s) * (1.f / D) + 1e-6f);
#pragma unroll
    for (int j = 0; j < 8; ++j) {
        const f32x4 gg = *((const f32x4*)g + lane + 64 * j), a = *((const f32x4*)sc + lane + 64 * j), b = *((const f32x4*)sh + lane + 64 * j);
        const float o0 = v[j].x * rs * gg.x * (1.f + a.x) + b.x, o1 = v[j].y * rs * gg.y * (1.f + a.y) + b.y, o2 = v[j].z * rs * gg.z * (1.f + a.z) + b.z, o3 = v[j].w * rs * gg.w * (1.f + a.w) + b.w;
        u32x2 w; w.x = pk2(o0, o1); w.y = pk2(o2, o3);
        *((u32x2*)dst + lane + 64 * j) = w;
    }
}
__device__ void phase_normmod(const P& p, int which, int gw, int ngw, int lane) {
    const float* MOD = (const float*)(p.ws + WS_MOD);
    if (which == 0) {
        bf16_t* HX = (bf16_t*)(p.ws + WS_HX);
        for (int r = gw; r < NROW; r += ngw) {
            const float* src = r < NTOK ? p.x + (size_t)r * D : p.ctx + (size_t)(r - NTOK) * D;
            const int v = r < NTOK ? (r >> 12) : 2;
            normmod_row(src, p.g_norm1, MOD + v * NMOD + 0, MOD + v * NMOD + 2048, HX + (size_t)r * D, lane);
        }
    } else {
        bf16_t* HX2 = (bf16_t*)(p.ws + WS_HX2);
        for (int r = gw; r < NTOK; r += ngw) {
            const int v = r >> 12;
            normmod_row(p.out + (size_t)r * D, p.g_norm2, MOD + v * NMOD + 3 * 2048, MOD + v * NMOD + 4 * 2048, HX2 + (size_t)r * D, lane);
        }
    }
}

template <int MODE>
__global__ void __launch_bounds__(256) k_gemm_ref(const bf16_t* A, int lda, const float* W, int ldw, int M, int N, int K, bf16_t* C, int ldc, const float* base, float* outp, const float* gate) {
    __shared__ float As[16][68];
    __shared__ float Bs[16][68];
    const int tid = threadIdx.x, tx = tid & 15, ty = tid >> 4;
    const int m0 = blockIdx.y * 64, n0 = blockIdx.x * 64;
    float acc[4][4];
#pragma unroll
    for (int i = 0; i < 4; ++i)
#pragma unroll
        for (int j = 0; j < 4; ++j) acc[i][j] = 0.f;
    for (int k0 = 0; k0 < K; k0 += 16) {
        { const int row = tid >> 2, kq = (tid & 3) * 4; const u32x2 w = *(const u32x2*)(A + (size_t)(m0 + row) * lda + k0 + kq);
          As[kq + 0][row] = bflo(w.x); As[kq + 1][row] = bfhi(w.x); As[kq + 2][row] = bflo(w.y); As[kq + 3][row] = bfhi(w.y); }
        { const int k = tid >> 4, n4 = (tid & 15) * 4; f32x4 w = (f32x4){0.f, 0.f, 0.f, 0.f};
          if (n0 + n4 < N) w = *(const f32x4*)(W + (size_t)(k0 + k) * ldw + n0 + n4);
          Bs[k][n4 + 0] = w.x; Bs[k][n4 + 1] = w.y; Bs[k][n4 + 2] = w.z; Bs[k][n4 + 3] = w.w; }
        __syncthreads();
#pragma unroll
        for (int k = 0; k < 16; ++k) {
            float a[4], b[4];
#pragma unroll
            for (int i = 0; i < 4; ++i) { a[i] = As[k][ty * 4 + i]; b[i] = Bs[k][tx * 4 + i]; }
#pragma unroll
            for (int i = 0; i < 4; ++i)
#pragma unroll
                for (int j = 0; j < 4; ++j) acc[i][j] += a[i] * b[j];
        }
        __syncthreads();
    }
#pragma unroll
    for (int i = 0; i < 4; ++i) {
        const int row = m0 + ty * 4 + i;
#pragma unroll
        for (int j = 0; j < 4; ++j) {
            const int col = n0 + tx * 4 + j;
            if (col < N) {
                if (MODE == 0) C[(size_t)row * ldc + col] = (bf16_t)f2bf(acc[i][j]);
                else { const size_t o = (size_t)row * 2048 + col; outp[o] = base[o] + gate[(row >> 12) * NMOD + col] * acc[i][j]; }
            }
        }
    }
}

__device__ void phase_lora_ref(const P& p, int bid, int nb, float* lds) {
    float* tl = lds;
    float* la = lds + 128;
    float* sg = lds + 256;
    const bf16_t* PROJ = (const bf16_t*)(p.ws + WS_PROJ);
    bf16_t* LW[2] = {(bf16_t*)(p.ws + WS_LWF), (bf16_t*)(p.ws + WS_LWB)};
    bf16_t* AA[2] = {(bf16_t*)(p.ws + WS_AF), (bf16_t*)(p.ws + WS_AB)};
    bf16_t* GG = (bf16_t*)(p.ws + WS_GG);
    const int tid = threadIdx.x;
    for (int r = bid; r < NROW; r += nb) {
        const bf16_t* pr = PROJ + (size_t)r * LDP;
        if (tid < 128) tl[tid] = tanhf(bf2f(pr[C_LW + tid]));
        else if (tid < 256) la[tid - 128] = bf2f(pr[C_LA + tid - 128]);
        else if (tid < 416) sg[tid - 256] = sigmoidf_(bf2f(pr[C_LG + tid - 256]));
        __syncthreads();
        for (int c = tid; c < RW; c += blockDim.x) {
#pragma unroll
            for (int d = 0; d < 2; ++d) {
                float aw = p.r_w0[d * RW + c], aa = p.r_a0[d * RW + c];
                for (int k = 0; k < 64; ++k) { aw += tl[d * 64 + k] * p.r_w_up[(size_t)(d * 64 + k) * RW + c]; aa += la[d * 64 + k] * p.r_a_up[(size_t)(d * 64 + k) * RW + c]; }
                const float wlog = -softplusf_(-aw) - 0.5f;
                LW[d][(size_t)r * RW + c] = (bf16_t)f2bf(-__expf(wlog));
                AA[d][(size_t)r * RW + c] = (bf16_t)f2bf(sigmoidf_(aa));
            }
            if (r < NTOK) {
                float g = 0.f;
                for (int k = 0; k < 160; ++k) g += sg[k] * p.r_g_up[(size_t)k * RW + c];
                GG[(size_t)r * RW + c] = (bf16_t)f2bf(g);
            }
        }
        __syncthreads();
    }
}

__device__ void phase_prep(const P& p, int bid, int nb) {
    const bf16_t* PROJ = (const bf16_t*)(p.ws + WS_PROJ);
    bf16_t* QC = (bf16_t*)(p.ws + WS_QC); bf16_t* KC = (bf16_t*)(p.ws + WS_KC); bf16_t* KK = (bf16_t*)(p.ws + WS_KK);
    const bf16_t* AF = (const bf16_t*)(p.ws + WS_AF); const bf16_t* AB = (const bf16_t*)(p.ws + WS_AB);
    float* GATES = (float*)(p.ws + WS_GATES); float* BONUS = (float*)(p.ws + WS_BONUS);
    const int tid = threadIdx.x, c0 = 2 * tid;
    for (int r = bid; r < NROW; r += nb) {
        int base, t, len; row_seq(r, base, t, len);
        const bf16_t* pr = PROJ + (size_t)r * LDP;
        {
            const unsigned cur = *(const unsigned*)(pr + c0);
            const unsigned prv = t > 0 ? *(const unsigned*)(pr - LDP + c0) : 0u;
            const unsigned nxt = t + 1 < len ? *(const unsigned*)(pr + LDP + c0) : 0u;
            const float* cw = p.m_conv_w;
            float o0 = bflo(prv) * cw[c0] + bflo(cur) * cw[1024 + c0] + bflo(nxt) * cw[2048 + c0] + p.m_conv_b[c0];
            float o1 = bfhi(prv) * cw[c0 + 1] + bfhi(cur) * cw[1024 + c0 + 1] + bfhi(nxt) * cw[2048 + c0 + 1] + p.m_conv_b[c0 + 1];
            if (c0 < 512) { const float sc = 0.08838834764831845f; *(unsigned*)(QC + (size_t)r * 512 + c0) = pk2(o0 * sc, o1 * sc); }
            else *(unsigned*)(KC + (size_t)r * 512 + c0 - 512) = pk2(o0, o1);
        }
        if (tid < 16) {
            float v = bf2f(pr[C_G + tid]) + p.m_gate_b[tid];
            if (tid >= 8) v = -softplusf_(-v);
            GATES[(size_t)r * 16 + tid] = v;
        }
        {
            const unsigned krw = *(const unsigned*)(pr + C_KR + c0), rrw = *(const unsigned*)(pr + C_R + c0);
            const float k0 = bflo(krw), k1 = bfhi(krw);
            const float q0 = k0 * p.r_k_k[c0], q1 = k1 * p.r_k_k[c0 + 1];
            float ss = q0 * q0 + q1 * q1;
#pragma unroll
            for (int o = 1; o < 32; o <<= 1) ss += __shfl_xor(ss, o);
            const float rn = rsqrtf(ss + 1e-12f);
            *(unsigned*)(KK + (size_t)r * RW + c0) = pk2(q0 * rn, q1 * rn);
            const unsigned afw = *(const unsigned*)(AF + (size_t)r * RW + c0), abw = *(const unsigned*)(AB + (size_t)r * RW + c0);
            const float s0 = k0 * (2.f + (bflo(afw) + bflo(abw) - 2.f) * p.r_k_a[c0]), s1 = k1 * (2.f + (bfhi(afw) + bfhi(abw) - 2.f) * p.r_k_a[c0 + 1]);
            float bs = bflo(rrw) * s0 * p.r_r_k[c0] + bfhi(rrw) * s1 * p.r_r_k[c0 + 1];
#pragma unroll
            for (int o = 1; o < 32; o <<= 1) bs += __shfl_xor(bs, o);
            if ((tid & 31) == 0) BONUS[(size_t)r * 16 + (tid >> 5)] = bs;
        }
    }
}

__global__ void __launch_bounds__(256) k_rwkv_ref(P p) {
    const bf16_t* PROJ = (const bf16_t*)(p.ws + WS_PROJ); const bf16_t* KK = (const bf16_t*)(p.ws + WS_KK);
    const int gw = (blockIdx.x * blockDim.x + threadIdx.x) >> 6, lane = threadIdx.x & 63;
    if (gw >= 64 * 64) return;
    const int stream = gw >> 6, vrow = gw & 63, dir = stream >> 5, b = (stream >> 4) & 1, h = stream & 15;
    const bf16_t* LW = (const bf16_t*)(p.ws + (dir ? WS_LWB : WS_LWF)); const bf16_t* AA = (const bf16_t*)(p.ws + (dir ? WS_AB : WS_AF));
    bf16_t* Y = (bf16_t*)(p.ws + (dir ? WS_YB : WS_YF));
    const int c = h * 64 + lane; const float rka = p.r_k_a[c];
    float s = 0.f;
    for (int st = 0; st < NSTEP; ++st) {
        const int r = step_row(st, b, dir);
        const float w = __expf(bf2f(LW[(size_t)r * RW + c])), a = bf2f(AA[(size_t)r * RW + c]), kk = bf2f(KK[(size_t)r * RW + c]);
        const float kr = bf2f(PROJ[(size_t)r * LDP + C_KR + c]), rr = bf2f(PROJ[(size_t)r * LDP + C_R + c]), vv = bf2f(PROJ[(size_t)r * LDP + C_VR + h * 64 + vrow]);
        const float kd = kr * (1.f + (a - 1.f) * rka);
        const float sa = wave_sum(s * kk);
        s = s * w - sa * (kk * a) + vv * kd;
        const float y = wave_sum(s * rr);
        if (st >= LC && lane == 0) Y[(size_t)r * RW + h * 64 + vrow] = (bf16_t)f2bf(y);
    }
}
__global__ void __launch_bounds__(256) k_mlstm_ref(P p) {
    const bf16_t* PROJ = (const bf16_t*)(p.ws + WS_PROJ); const bf16_t* QC = (const bf16_t*)(p.ws + WS_QC); const bf16_t* KC = (const bf16_t*)(p.ws + WS_KC);
    const float* GATES = (const float*)(p.ws + WS_GATES);
    const int gw = (blockIdx.x * blockDim.x + threadIdx.x) >> 6, lane = threadIdx.x & 63;
    if (gw >= 16 * 256) return;
    const int stream = gw >> 8, vrow = gw & 255, dir = stream >> 3, b = (stream >> 2) & 1, h = stream & 3;
    bf16_t* H = (bf16_t*)(p.ws + (dir ? WS_HB : WS_HF));
    float c0 = 0.f, c1 = 0.f, n0 = 0.f, n1 = 0.f;
    for (int st = 0; st < NSTEP; ++st) {
        const int r = step_row(st, b, dir);
        const float ig = GATES[(size_t)r * 16 + dir * 4 + h], lf = GATES[(size_t)r * 16 + 8 + dir * 4 + h];
        const float f = __expf(lf), ei = __expf(ig);
        const float k0 = bf2f(KC[(size_t)r * 512 + h * 128 + lane]), k1 = bf2f(KC[(size_t)r * 512 + h * 128 + 64 + lane]);
        const float q0 = bf2f(QC[(size_t)r * 512 + h * 128 + lane]), q1 = bf2f(QC[(size_t)r * 512 + h * 128 + 64 + lane]);
        const float v = bf2f(PROJ[(size_t)r * LDP + C_VM + h * 256 + vrow]);
        c0 = f * c0 + ei * v * k0; c1 = f * c1 + ei * v * k1; n0 = f * n0 + ei * k0; n1 = f * n1 + ei * k1;
        const float num = wave_sum(c0 * q0 + c1 * q1), den = wave_sum(n0 * q0 + n1 * q1);
        if (st >= LC && lane == 0) H[(size_t)r * RW + h * 256 + vrow] = (bf16_t)f2bf(num / fmaxf(fabsf(den), 1.f));
    }
}

__device__ void phase_post(const P& p, int bid, int nb) {
    const bf16_t* PROJ = (const bf16_t*)(p.ws + WS_PROJ);
    const bf16_t* YF = (const bf16_t*)(p.ws + WS_YF); const bf16_t* YB = (const bf16_t*)(p.ws + WS_YB);
    const bf16_t* HF = (const bf16_t*)(p.ws + WS_HF); const bf16_t* HB = (const bf16_t*)(p.ws + WS_HB);
    const bf16_t* GG = (const bf16_t*)(p.ws + WS_GG); const float* BONUS = (const float*)(p.ws + WS_BONUS);
    bf16_t* MIX = (bf16_t*)(p.ws + WS_MIX);
    const int tid = threadIdx.x, c0 = 2 * tid;
    for (int r = bid; r < NTOK; r += nb) {
        const bf16_t* pr = PROJ + (size_t)r * LDP;
        {
            const unsigned a = *(const unsigned*)(HF + (size_t)r * RW + c0), b = *(const unsigned*)(HB + (size_t)r * RW + c0);
            const float h0 = bflo(a) + bflo(b), h1 = bfhi(a) + bfhi(b);
            float ss = wave_sum(h0 * h0 + h1 * h1);
            __shared__ float red[8];
            if ((tid & 63) == 0) red[tid >> 6] = ss;
            __syncthreads();
            const int hd = tid >> 7;
            ss = red[2 * hd] + red[2 * hd + 1];
            __syncthreads();
            const float rs = rsqrtf(ss * (1.f / 256.f) + 1e-6f);
            const unsigned om = *(const unsigned*)(pr + C_OM + c0);
            const float o0 = h0 * rs * p.m_norm_g[c0] * sigmoidf_(bflo(om)), o1 = h1 * rs * p.m_norm_g[c0 + 1] * sigmoidf_(bfhi(om));
            *(unsigned*)(MIX + (size_t)r * D + c0) = pk2(o0, o1);
        }
        {
            const unsigned a = *(const unsigned*)(YF + (size_t)r * RW + c0), b = *(const unsigned*)(YB + (size_t)r * RW + c0);
            const float y0 = bflo(a) + bflo(b), y1 = bfhi(a) + bfhi(b);
            float sm = y0 + y1;
#pragma unroll
            for (int o = 1; o < 32; o <<= 1) sm += __shfl_xor(sm, o);
            const float mu = sm * (1.f / 64.f);
            float sv = (y0 - mu) * (y0 - mu) + (y1 - mu) * (y1 - mu);
#pragma unroll
            for (int o = 1; o < 32; o <<= 1) sv += __shfl_xor(sv, o);
            const float rs = rsqrtf(sv * (1.f / 64.f) + 64e-5f);
            const float bn = BONUS[(size_t)r * 16 + (tid >> 5)];
            const unsigned vr = *(const unsigned*)(pr + C_VR + c0), gg = *(const unsigned*)(GG + (size_t)r * RW + c0);
            const float o0 = ((y0 - mu) * rs * p.r_gn_w[c0] + p.r_gn_b[c0] + bn * bflo(vr)) * bflo(gg);
            const float o1 = ((y1 - mu) * rs * p.r_gn_w[c0 + 1] + p.r_gn_b[c0 + 1] + bn * bfhi(vr)) * bfhi(gg);
            *(unsigned*)(MIX + (size_t)r * D + 1024 + c0) = pk2(o0, o1);
        }
    }
}

__device__ __forceinline__ float gelu_tanh(float u) { const float z = 0.7978845608028654f * (u + 0.044715f * u * u * u); return 0.5f * u * (1.f + tanhf(z)); }
__device__ void phase_convact(const P& p, int gtid, int ngt) {
    const bf16_t* UG = (const bf16_t*)(p.ws + WS_UG); bf16_t* ACT = (bf16_t*)(p.ws + WS_ACT);
    constexpr int FP = FF / 2;
    for (size_t i = gtid; i < (size_t)NTOK * FP; i += ngt) {
        const int r = (int)(i / FP), f = 2 * (int)(i % FP);
        const int b = r >> 12, t = r & 4095, gr = t >> 6, gc = t & 63;
        float u0 = p.f_conv_b[f], u1 = p.f_conv_b[f + 1];
#pragma unroll
        for (int dr = 0; dr < 3; ++dr)
#pragma unroll
            for (int dc = 0; dc < 3; ++dc) {
                const int rr = gr + dr - 1, cc = gc + dc - 1;
                if (rr >= 0 && rr < 64 && cc >= 0 && cc < 64) {
                    const unsigned w = *(const unsigned*)(UG + (size_t)(b * 4096 + rr * 64 + cc) * (2 * FF) + f);
                    u0 += bflo(w) * p.f_conv_w[(dr * 3 + dc) * FF + f]; u1 += bfhi(w) * p.f_conv_w[(dr * 3 + dc) * FF + f + 1];
                }
            }
        const unsigned g = *(const unsigned*)(UG + (size_t)r * (2 * FF) + FF + f);
        *(unsigned*)(ACT + (size_t)r * FF + f) = pk2(gelu_tanh(u0) * bflo(g), gelu_tanh(u1) * bfhi(g));
    }
}

__device__ void phase_final(const P& p, int gw, int ngw, int lane) {
    for (int r = gw; r < NTOK; r += ngw) {
        float* row = p.out + (size_t)r * D;
        f32x4 v[8]; float s = 0.f;
#pragma unroll
        for (int j = 0; j < 8; ++j) { v[j] = *((const f32x4*)row + lane + 64 * j); s += (v[j].x * v[j].x + v[j].y * v[j].y) + (v[j].z * v[j].z + v[j].w * v[j].w); }
        const float rs = rsqrtf(wave_sum(s) * (1.f / D) + 1e-6f);
#pragma unroll
        for (int j = 0; j < 8; ++j) { const f32x4 g = *((const f32x4*)p.g_final + lane + 64 * j); f32x4 o; o.x = v[j].x * rs * g.x; o.y = v[j].y * rs * g.y; o.z = v[j].z * rs * g.z; o.w = v[j].w * rs * g.w; *((f32x4*)row + lane + 64 * j) = o; }
    }
}

__global__ void __launch_bounds__(512) k_mod(P p) { __shared__ float lds[3 * 2048 + 42 * 144]; phase_mod(p, blockIdx.x, gridDim.x, lds); }
__global__ void __launch_bounds__(512) k_normmod(P p, int which) { phase_normmod(p, which, (blockIdx.x * blockDim.x + threadIdx.x) >> 6, (gridDim.x * blockDim.x) >> 6, threadIdx.x & 63); }
__global__ void __launch_bounds__(512) k_lora(P p) { __shared__ float lds[512]; phase_lora_ref(p, blockIdx.x, gridDim.x, lds); }
__global__ void __launch_bounds__(512) k_prep(P p) { phase_prep(p, blockIdx.x, gridDim.x); }
__global__ void __launch_bounds__(512) k_post(P p) { phase_post(p, blockIdx.x, gridDim.x); }
__global__ void __launch_bounds__(512) k_convact(P p) { phase_convact(p, blockIdx.x * blockDim.x + threadIdx.x, gridDim.x * blockDim.x); }
__global__ void __launch_bounds__(512) k_final(P p) { phase_final(p, (blockIdx.x * blockDim.x + threadIdx.x) >> 6, (gridDim.x * blockDim.x) >> 6, threadIdx.x & 63); }

extern "C" void kernel_launch(void* const* d_in, const int* in_sizes, int n_in, void* d_out, int out_size, void* d_ws, size_t ws_size, hipStream_t stream) {
    if (n_in != 30 || ws_size < WS_END) { fprintf(stderr, "kernel_launch: unexpected n_in %d / ws %zu\n", n_in, ws_size); return; }
    P p{};
    const float** f = (const float**)&p;
    for (int i = 0; i < 30; ++i) f[i] = (const float*)d_in[i];
    p.out = (float*)d_out; p.ws = (unsigned char*)d_ws;
    unsigned char* ws = p.ws;
    const float* MOD = (const float*)(ws + WS_MOD);
    k_mod<<<256, 512, 0, stream>>>(p);
    k_normmod<<<1024, 512, 0, stream>>>(p, 0);
    k_gemm_ref<0><<<dim3((NIN + 63) / 64, NROW / 64), 256, 0, stream>>>((const bf16_t*)(ws + WS_HX), D, p.w_in, NIN, NROW, NIN, D, (bf16_t*)(ws + WS_PROJ), LDP, nullptr, nullptr, nullptr);
    k_lora<<<2048, 512, 0, stream>>>(p);
    k_prep<<<2048, 512, 0, stream>>>(p);
    k_rwkv_ref<<<64 * 64 / 4, 256, 0, stream>>>(p);
    k_mlstm_ref<<<16 * 256 / 4, 256, 0, stream>>>(p);
    k_post<<<2048, 512, 0, stream>>>(p);
    k_gemm_ref<1><<<dim3(D / 64, NTOK / 64), 256, 0, stream>>>((const bf16_t*)(ws + WS_MIX), D, p.w_out, D, NTOK, D, D, nullptr, 0, p.x, p.out, MOD + 2 * 2048);
    k_normmod<<<1024, 512, 0, stream>>>(p, 1);
    k_gemm_ref<0><<<dim3(FF / 64, NTOK / 64), 256, 0, stream>>>((const bf16_t*)(ws + WS_HX2), D, p.f_w_up, FF, NTOK, FF, D, (bf16_t*)(ws + WS_UG), 2 * FF, nullptr, nullptr, nullptr);
    k_gemm_ref<0><<<dim3(FF / 64, NTOK / 64), 256, 0, stream>>>((const bf16_t*)(ws + WS_HX2), D, p.f_w_gate, FF, NTOK, FF, D, (bf16_t*)(ws + WS_UG) + FF, 2 * FF, nullptr, nullptr, nullptr);
    k_convact<<<2048, 512, 0, stream>>>(p);
    k_gemm_ref<1><<<dim3(D / 64, NTOK / 64), 256, 0, stream>>>((const bf16_t*)(ws + WS_ACT), FF, p.f_w_down, D, NTOK, D, FF, nullptr, 0, p.out, p.out, MOD + 5 * 2048);
    k_final<<<1024, 512, 0, stream>>>(p);
}
```

```cpp
#include <hip/hip_runtime.h>
#include <cstdint>
#include <cstdio>
namespace pg8 {
#define PG8_LAS __attribute__((address_space(3)))
typedef unsigned short bf16_t;
typedef short bf16x8 __attribute__((ext_vector_type(8)));
typedef float f32x4 __attribute__((ext_vector_type(4)));
typedef unsigned u32x4 __attribute__((ext_vector_type(4)));
constexpr int BM = 256, BK = 64, HALF = 128, HTB = HALF * BK * 2  , STAGE_BYTES = 8 * HTB, NXCD = 8, WGM = 8;

__host__ __device__ __forceinline__ int lds_byte(int r, int c) { const int st = (r >> 4) * 2 + (c >> 5), rr = r & 15, cc = c & 31, ob = rr * 64 + cc * 2; return st * 1024 + (ob ^ (((ob >> 9) & 1) << 5)); }
__host__ __device__ __forceinline__ void stage_rc(int b, int& R, int& C) { const int st = b / 1024, sb = b % 1024, swz = sb ^ (((sb >> 9) & 1) << 5); R = (st >> 1) * 16 + swz / 64; C = (st & 1) * 32 + (swz % 64) / 2; }
__host__ __device__ __forceinline__ int perm32(int rho) { const int n = rho >> 4, i = rho & 15; return 8 * (i >> 2) + 4 * n + (i & 3); }

struct Unit { int pm, pn; };
struct Gemm { const bf16_t* A; const bf16_t* Bt; int M, N, K; };

struct StaticOrder {
    int nM, nN, nwg, G, c;
    __host__ __device__ void init(int M, int N, int G_, int c_) { nM = M / BM; nN = N / BM; nwg = nM * nN; G = G_; c = c_; }
    __host__ __device__ bool next(int i, Unit& u) const {
        const long L = (long)i * G + c; if (L >= nwg) return false;
        int wgid = (int)L; { const int q = nwg / NXCD, r = nwg % NXCD, xcd = wgid % NXCD, off = wgid / NXCD; wgid = (xcd < r ? xcd * (q + 1) : r * (q + 1) + (xcd - r) * q) + off; }
        const int nig = WGM * nN, gid = wgid / nig, fm = gid * WGM, gsz = (nM - fm) < WGM ? (nM - fm) : WGM;
        u.pm = fm + ((wgid % nig) % gsz); u.pn = (wgid % nig) / gsz; return true;
    }
    __device__ __forceinline__ void a_ready(const Unit&) const {}
    __device__ __forceinline__ void done(const Unit&) const {}
};

__device__ __forceinline__ unsigned cvt_pk_bf16(float lo, float hi) { unsigned r; asm volatile("v_cvt_pk_bf16_f32 %0, %1, %2" : "=v"(r) : "v"(lo), "v"(hi)); return r; }
typedef float f32x2 __attribute__((ext_vector_type(2)));
__device__ __forceinline__ f32x2 gelu_pk(f32x2 v) {
    const f32x2 av = __builtin_elementwise_abs(v), d = av * 0.2316418882f + 1.0f;
    f32x2 t; t.x = __builtin_amdgcn_rcpf(d.x); t.y = __builtin_amdgcn_rcpf(d.y);
    f32x2 q = t * 0.5307027145f + (-0.7265760135f); q = q * t + 0.7107068705f; q = q * t + (-0.142248368f); q = q * t + 0.127414796f; q = q * t;
    const f32x2 s = (v * v) * (-0.72134752044f);
    f32x2 e; e.x = __builtin_amdgcn_exp2f(s.x); e.y = __builtin_amdgcn_exp2f(s.y);
    const f32x2 m = v * (q * e), r = v - m;
    f32x2 o; o.x = v.x < 0.f ? m.x : r.x; o.y = v.y < 0.f ? m.y : r.y; return o;
}

template <int ACT  > struct EpiBf16 {
    static constexpr bool PERM = true, AFTER_DRAIN = false; static_assert(ACT == 0 || ACT == 1, "EpiBf16: ACT is 0 (none) or 1 (gelu_pk)");
    bf16_t* O; int ldc; const float* bias; int split_cols; size_t split_stride; float scale0;
    __device__ __forceinline__ void operator()(const f32x4 (&acc)[2][2][4][2], const Unit& u, int wr, int wc, int fr, int fq) const {
        const int row0 = u.pm * BM + wr * 64 + fr; int colt = u.pn * BM; bf16_t* base = O;
        float sc = 1.f; if (split_cols) { const int t = colt / split_cols; base += (size_t)t * split_stride; colt -= t * split_cols; if (t == 0) sc = scale0; }
        const int col0 = colt + wc * 32 + 8 * fq, bcol0 = u.pn * BM + wc * 32 + 8 * fq;
        f32x4 bv[2][2];
#pragma unroll
        for (int bj = 0; bj < 2; ++bj)
#pragma unroll
            for (int n = 0; n < 2; ++n) bv[bj][n] = bias ? *(const f32x4*)(bias + bcol0 + bj * HALF + 4 * n) : (f32x4){0.f, 0.f, 0.f, 0.f};
#pragma unroll
        for (int ai = 0; ai < 2; ++ai)
#pragma unroll
            for (int m = 0; m < 4; ++m) { bf16_t* rowp = base + (size_t)(row0 + ai * HALF + m * 16) * ldc + col0;
#pragma unroll
                for (int bj = 0; bj < 2; ++bj) { f32x4 v0 = acc[ai][bj][m][0] + bv[bj][0], v1 = acc[ai][bj][m][1] + bv[bj][1];
                    if (ACT == 1) { f32x2 a = gelu_pk((f32x2){v0[0], v0[1]}), b = gelu_pk((f32x2){v0[2], v0[3]}), c = gelu_pk((f32x2){v1[0], v1[1]}), d = gelu_pk((f32x2){v1[2], v1[3]});
                        v0 = (f32x4){a.x, a.y, b.x, b.y}; v1 = (f32x4){c.x, c.y, d.x, d.y}; }
                    v0 = v0 * sc; v1 = v1 * sc; u32x4 w; w.x = cvt_pk_bf16(v0[0], v0[1]); w.y = cvt_pk_bf16(v0[2], v0[3]); w.z = cvt_pk_bf16(v1[0], v1[1]); w.w = cvt_pk_bf16(v1[2], v1[3]);
                    *(u32x4*)(rowp + bj * HALF) = w; } }
    }
};
struct EpiResid {
    static constexpr bool PERM = false, AFTER_DRAIN = false;
    const float* base; float* out; int ldc; const float* gate; int gstride;
    __device__ __forceinline__ void operator()(const f32x4 (&acc)[2][2][4][2], const Unit& u, int wr, int wc, int fr, int fq) const {
        const int row0 = u.pm * BM + wr * 64 + fr, col0 = u.pn * BM + wc * 32 + 4 * fq;
        const float* g = gate + (size_t)((u.pm * BM) >> 12) * gstride + col0;
        f32x4 gv[2][2];
#pragma unroll
        for (int bj = 0; bj < 2; ++bj)
#pragma unroll
            for (int n = 0; n < 2; ++n) gv[bj][n] = *(const f32x4*)(g + bj * HALF + n * 16);
#pragma unroll
        for (int ai = 0; ai < 2; ++ai)
#pragma unroll
            for (int m = 0; m < 4; ++m) { const size_t off = (size_t)(row0 + ai * HALF + m * 16) * ldc + col0;
#pragma unroll
                for (int bj = 0; bj < 2; ++bj)
#pragma unroll
                    for (int n = 0; n < 2; ++n) { const f32x4 bs = *(const f32x4*)(base + off + bj * HALF + n * 16); *(f32x4*)(out + off + bj * HALF + n * 16) = bs + gv[bj][n] * acc[ai][bj][m][n]; } }
    }
};
template <class Epi, class Sched, bool ALIGN_EPI = false, bool SP2 = false>
__device__ __forceinline__ void gemm_phase(PG8_LAS unsigned char* lds, const Gemm g, const Sched& S, const Epi& E) {
    const int tid = threadIdx.x, wid = __builtin_amdgcn_readfirstlane(tid >> 6), lane = tid & 63, wr = wid >> 2, wc = wid & 3, fr = lane & 15, fq = lane >> 4;
    const int K = g.K, nt = K / BK;
    unsigned voffA[2], voffB[2];
#pragma unroll
    for (int i = 0; i < 2; ++i) { int R, C; stage_rc(tid * 16 + i * 8192, R, C); const int Rb = Epi::PERM ? ((R & ~31) + perm32(R & 31)) : R;
        voffA[i] = (unsigned)(R * K + C) * 2u; voffB[i] = (unsigned)(Rb * K + C) * 2u; }
    const size_t kstep = (size_t)(BK * 2);
    const size_t hstep = (size_t)HALF * K * 2;
    const size_t tstep = 2 * hstep;
    const unsigned ldsw = (unsigned)wid * 1024u;
    const int aoff = lds_byte(wr * 64 + fr, fq * 8), boff = lds_byte(wc * 32 + fr, fq * 8);
#define PG8_SA(b, h) (((b) * 2 + (h)) * HTB)
#define PG8_SB(b, h) ((4 + (b) * 2 + (h)) * HTB)
#define PG8_STAGE(bufoff, gbase, voff) do { _Pragma("unroll") for (int _i = 0; _i < 2; ++_i) \
        __builtin_amdgcn_global_load_lds((const unsigned*)((const char*)(gbase) + (voff)[_i]), (PG8_LAS unsigned*)(lds + (bufoff) + ldsw + _i * 8192), 16, 0, 0); } while (0)
#define PG8_LDA(dst, b, h) do { _Pragma("unroll") for (int m = 0; m < 4; ++m) _Pragma("unroll") for (int k = 0; k < 2; ++k) dst[m][k] = *(const PG8_LAS bf16x8*)(lds + PG8_SA(b, h) + aoff + m * 2048 + k * 1024); } while (0)
#define PG8_LDB(dst, b, h) do { _Pragma("unroll") for (int n = 0; n < 2; ++n) _Pragma("unroll") for (int k = 0; k < 2; ++k) dst[n][k] = *(const PG8_LAS bf16x8*)(lds + PG8_SB(b, h) + boff + n * 2048 + k * 1024); } while (0)
#define PG8_MMA(ai, bj, At, Bt) do { __builtin_amdgcn_s_setprio(1); _Pragma("unroll") for (int m = 0; m < 4; ++m) _Pragma("unroll") for (int n = 0; n < 2; ++n) _Pragma("unroll") for (int k = 0; k < 2; ++k) \
        acc[ai][bj][m][n] = __builtin_amdgcn_mfma_f32_16x16x32_bf16(Bt[n][k], At[m][k], acc[ai][bj][m][n], 0, 0, 0); __builtin_amdgcn_s_setprio(0); } while (0)
#define PG8_WAIT_V(n) asm volatile("s_waitcnt vmcnt(" #n ")" ::: "memory")
#define PG8_WAIT_L(n) asm volatile("s_waitcnt lgkmcnt(" #n ")" ::: "memory")
#define PG8_BAR __builtin_amdgcn_s_barrier()
#define PG8_SCHED __builtin_amdgcn_sched_barrier(0)
    Unit cur, nxt; int ui = 0;
    if (!S.next(0, cur)) return;
    f32x4 acc[2][2][4][2];
#pragma unroll
    for (int a = 0; a < 2; ++a)
#pragma unroll
        for (int b = 0; b < 2; ++b)
#pragma unroll
            for (int m = 0; m < 4; ++m)
#pragma unroll
                for (int n = 0; n < 2; ++n) acc[a][b][m][n] = (f32x4){0.f, 0.f, 0.f, 0.f};
    bf16x8 At[4][2], B0[2][2], B1[2][2];
    const char* cA = (const char*)g.A + (size_t)cur.pm * tstep; const char* cB = (const char*)g.Bt + (size_t)cur.pn * tstep;
    S.a_ready(cur);
    if constexpr (SP2) {
        PG8_STAGE(PG8_SB(0, 0), cB, voffB); PG8_STAGE(PG8_SB(0, 1), cB + hstep, voffB); PG8_STAGE(PG8_SA(0, 0), cA, voffA); PG8_STAGE(PG8_SA(0, 1), cA + hstep, voffA);
        if (wr == 1) PG8_BAR;
        PG8_WAIT_V(2); PG8_BAR;
        PG8_STAGE(PG8_SB(1, 0), cB + kstep, voffB); PG8_STAGE(PG8_SA(1, 0), cA + kstep, voffA); PG8_STAGE(PG8_SB(1, 1), cB + hstep + kstep, voffB);
        PG8_WAIT_V(6); PG8_BAR;
    } else {
        PG8_STAGE(PG8_SB(0, 0), cB, voffB); PG8_STAGE(PG8_SA(0, 0), cA, voffA); PG8_STAGE(PG8_SB(0, 1), cB + hstep, voffB); PG8_STAGE(PG8_SA(0, 1), cA + hstep, voffA);
        if (wr == 1) PG8_BAR;
        PG8_WAIT_V(4); PG8_BAR;
        PG8_STAGE(PG8_SB(1, 0), cB + kstep, voffB); PG8_STAGE(PG8_SA(1, 0), cA + kstep, voffA); PG8_STAGE(PG8_SB(1, 1), cB + hstep + kstep, voffB);
        PG8_WAIT_V(6); PG8_BAR;
    }
    for (;;) {
        const bool has_next = S.next(ui + 1, nxt);
        const char* nA = has_next ? (const char*)g.A + (size_t)nxt.pm * tstep : cA; const char* nB = has_next ? (const char*)g.Bt + (size_t)nxt.pn * tstep : cB;
        for (int t = 0; t < nt; t += 2) {
            const bool last = (t == nt - 2);
            const char* a1 = cA + (size_t)(t + 1) * kstep;
            const char* a2 = last ? nA : cA + (size_t)(t + 2) * kstep; const char* b2 = last ? nB : cB + (size_t)(t + 2) * kstep;
            const char* a3 = a2 + kstep; const char* b3 = b2 + kstep;
            if (last && has_next) S.a_ready(nxt);
            if constexpr (SP2) {
            PG8_LDB(B0, 0, 0); PG8_LDB(B1, 0, 1); PG8_SCHED; PG8_LDA(At, 0, 0); PG8_STAGE(PG8_SA(1, 1), a1 + hstep, voffA);
            PG8_WAIT_V(8); PG8_WAIT_L(0); PG8_BAR; PG8_MMA(0, 0, At, B0); PG8_MMA(0, 1, At, B1); PG8_BAR; PG8_SCHED;
            PG8_LDA(At, 0, 1); PG8_STAGE(PG8_SB(0, 0), b2, voffB); PG8_STAGE(PG8_SB(0, 1), b2 + hstep, voffB); PG8_STAGE(PG8_SA(0, 0), a2, voffA);
            PG8_WAIT_V(8); PG8_WAIT_L(0); PG8_BAR; PG8_MMA(1, 0, At, B0); PG8_MMA(1, 1, At, B1); PG8_BAR; PG8_SCHED;
            PG8_LDB(B0, 1, 0); PG8_LDB(B1, 1, 1); PG8_SCHED; PG8_LDA(At, 1, 0); PG8_STAGE(PG8_SA(0, 1), a2 + hstep, voffA);
            PG8_WAIT_V(8); PG8_WAIT_L(0); PG8_BAR; PG8_MMA(0, 0, At, B0); PG8_MMA(0, 1, At, B1); PG8_BAR; PG8_SCHED;
            PG8_LDA(At, 1, 1); PG8_STAGE(PG8_SB(1, 0), b3, voffB); PG8_STAGE(PG8_SB(1, 1), b3 + hstep, voffB); PG8_STAGE(PG8_SA(1, 0), a3, voffA);
            PG8_WAIT_V(8); PG8_WAIT_L(0); PG8_BAR; PG8_MMA(1, 0, At, B0); PG8_MMA(1, 1, At, B1); PG8_BAR; PG8_SCHED;
            } else {
            PG8_LDB(B0, 0, 0); PG8_SCHED; PG8_LDA(At, 0, 0); PG8_STAGE(PG8_SA(1, 1), a1 + hstep, voffA);
            PG8_WAIT_L(8); PG8_BAR; PG8_WAIT_L(0); PG8_MMA(0, 0, At, B0); PG8_BAR; PG8_SCHED;
            PG8_LDB(B1, 0, 1); PG8_STAGE(PG8_SB(0, 0), b2, voffB);
            PG8_BAR; PG8_WAIT_L(0); PG8_MMA(0, 1, At, B1); PG8_BAR;
            PG8_LDA(At, 0, 1); PG8_STAGE(PG8_SA(0, 0), a2, voffA);
            PG8_BAR; PG8_WAIT_L(0); PG8_MMA(1, 0, At, B0); PG8_BAR; PG8_SCHED;
            PG8_STAGE(PG8_SB(0, 1), b2 + hstep, voffB);
            PG8_WAIT_V(6); PG8_BAR; PG8_MMA(1, 1, At, B1); PG8_BAR;
            PG8_LDB(B0, 1, 0); PG8_SCHED; PG8_LDA(At, 1, 0); PG8_STAGE(PG8_SA(0, 1), a2 + hstep, voffA);
            PG8_WAIT_L(8); PG8_BAR; PG8_WAIT_L(0); PG8_MMA(0, 0, At, B0); PG8_BAR; PG8_SCHED;
            PG8_LDB(B1, 1, 1); PG8_STAGE(PG8_SB(1, 0), b3, voffB);
            PG8_BAR; PG8_WAIT_L(0); PG8_MMA(0, 1, At, B1); PG8_BAR;
            PG8_LDA(At, 1, 1); PG8_STAGE(PG8_SA(1, 0), a3, voffA);
            PG8_BAR; PG8_WAIT_L(0); PG8_MMA(1, 0, At, B0); PG8_BAR; PG8_SCHED;
            PG8_STAGE(PG8_SB(1, 1), b3 + hstep, voffB);
            PG8_WAIT_V(6); PG8_BAR; PG8_MMA(1, 1, At, B1); PG8_BAR;
            }
        }
        if constexpr (ALIGN_EPI) { if (wr == 0) PG8_BAR; }
        if constexpr (!Epi::AFTER_DRAIN) { E(acc, cur, wr, wc, fr, fq); S.done(cur); }
        if (!has_next) break;
#pragma unroll
        for (int a = 0; a < 2; ++a)
#pragma unroll
            for (int b = 0; b < 2; ++b)
#pragma unroll
                for (int m = 0; m < 4; ++m)
#pragma unroll
                    for (int n = 0; n < 2; ++n) acc[a][b][m][n] = (f32x4){0.f, 0.f, 0.f, 0.f};
        cur = nxt; cA = nA; cB = nB; ++ui;
        if constexpr (ALIGN_EPI) { if (wr == 1) PG8_BAR; }
    }
    PG8_WAIT_V(0);
    if constexpr (!ALIGN_EPI) { if (wr == 0) PG8_BAR; }
    PG8_BAR;
    if constexpr (Epi::AFTER_DRAIN) { E.fused(acc, cur, wr, wc, fr, fq, lds, wid, lane); S.done(cur); }
#undef PG8_SA
#undef PG8_SB
#undef PG8_STAGE
#undef PG8_LDA
#undef PG8_LDB
#undef PG8_MMA
#undef PG8_WAIT_V
#undef PG8_WAIT_L
#undef PG8_BAR
#undef PG8_SCHED
}
}
#define GAS __attribute__((address_space(1)))
#define LAS __attribute__((address_space(3)))
typedef unsigned short bf16;
typedef unsigned v4u __attribute__((ext_vector_type(4)));
typedef float f32x4 __attribute__((ext_vector_type(4)));
typedef short bf16x8 __attribute__((ext_vector_type(8)));
typedef GAS unsigned gu32;
typedef GAS unsigned long long gu64;
#define RLX_AGENT __ATOMIC_RELAXED, __HIP_MEMORY_SCOPE_AGENT
#define LDS_WAIT() asm volatile("s_waitcnt lgkmcnt(0)" ::: "memory")
#define VM_WAIT() asm volatile("s_waitcnt vmcnt(0)" ::: "memory")
__device__ __forceinline__ unsigned long long rt() { return __builtin_amdgcn_s_memrealtime(); }
typedef float f32x2_cv __attribute__((ext_vector_type(2))); typedef __bf16 bf16x2_cv __attribute__((ext_vector_type(2)));
__device__ __forceinline__ unsigned pk2(float lo, float hi) { f32x2_cv v = {lo, hi}; bf16x2_cv b = __builtin_convertvector(v, bf16x2_cv); return __builtin_bit_cast(unsigned, b); }
__device__ __forceinline__ unsigned f2bf(float f) { return pk2(f, 0.f) & 0xffffu; }

#define XB_TMO      128
#define XB_XCNT(j)  (256  + 64 * (j))
#define XB_XSUB(j)  (1280 + 64 * (j))
#define XB_XGEN(j)  (2304 + 64 * (j))
#define XB_TOP      3328
#define XB_TOPGEN   3392
#define XCD_BAR_WORDS 3456
#define XB_SPIN_CAP (1u << 18)

__device__ __forceinline__ unsigned xb_ld(unsigned* p)              { return __hip_atomic_load(p, __ATOMIC_RELAXED, __HIP_MEMORY_SCOPE_AGENT); }
__device__ __forceinline__ unsigned xb_add(unsigned* p, unsigned v) { return __hip_atomic_fetch_add(p, v, __ATOMIC_RELAXED, __HIP_MEMORY_SCOPE_AGENT); }
__device__ __forceinline__ unsigned xb_xcc_id() { return (unsigned)__builtin_amdgcn_s_getreg((3 << 11) | 20) & 0xFu; }
#define XB_SPIN(cond, bar) do { unsigned _sp = 0; while (cond) { __builtin_amdgcn_s_sleep(1); \
    if ((++_sp & 255u) == 0u) { if (xb_ld(&(bar)[XB_TMO])) break; if (_sp > XB_SPIN_CAP) { atomicAdd(&(bar)[XB_TMO], 1u); break; } } } } while (0)

struct XcdBarrier {
    unsigned* bar; unsigned x;
    volatile LAS unsigned* st;
};

__device__ __forceinline__ XcdBarrier xcd_barrier_post(unsigned* bar, volatile LAS unsigned* st) {
    XcdBarrier b; b.bar = bar; b.x = xb_xcc_id(); b.st = st;
    if (threadIdx.x == 0) (void)xb_add(&bar[XB_XCNT(b.x)], 1u);
    return b;
}
__device__ __forceinline__ void xcd_barrier_complete(unsigned* bar, unsigned x, unsigned& nloc, unsigned& nx) {
    const unsigned G = gridDim.x * gridDim.y * gridDim.z;
    unsigned sum, cnt, mine, sp = 0u;
    for (;;) {
        sum = 0u; cnt = 0u; mine = 0u;
#pragma unroll
        for (unsigned j = 0; j < 16; ++j) { const unsigned c = xb_ld(&bar[XB_XCNT(j)]); sum += c; cnt += (c > 0u) ? 1u : 0u; mine = (j == x) ? c : mine; }
        if (sum == G) break;
        __builtin_amdgcn_s_sleep(1);
        if ((++sp & 255u) == 0u) { if (xb_ld(&bar[XB_TMO])) break; if (sp > XB_SPIN_CAP) { atomicAdd(&bar[XB_TMO], 1u); break; } }
    }
    nloc = mine > 0u ? mine : 1u; nx = cnt > 0u ? cnt : 1u;
}

__device__ __forceinline__ void xcd_barrier(const XcdBarrier& b) {
    asm volatile("s_waitcnt vmcnt(0)" ::: "memory");
    __syncthreads();
    if (threadIdx.x == 0) {
        unsigned* bar = b.bar;
        __builtin_amdgcn_s_waitcnt(0);
        unsigned nloc = b.st[0], nx = b.st[1];
        if (nloc == 0u) { xcd_barrier_complete(bar, b.x, nloc, nx); b.st[0] = nloc; b.st[1] = nx; }
        const unsigned old = xb_add(&bar[XB_XSUB(b.x)], 1u);
        const unsigned gen = old / nloc;
        if (old + 1u == (gen + 1u) * nloc) {
            __builtin_amdgcn_fence(__ATOMIC_RELEASE, "agent");
            asm volatile("s_waitcnt vmcnt(0)" ::: "memory");
            const unsigned og = xb_add(&bar[XB_TOP], 1u);
            const unsigned tg = og / nx;
            if (og + 1u == (tg + 1u) * nx) xb_add(&bar[XB_TOPGEN], 1u);
            else XB_SPIN(xb_ld(&bar[XB_TOPGEN]) == tg, bar);
            __builtin_amdgcn_fence(__ATOMIC_ACQUIRE, "agent");
            xb_add(&bar[XB_XGEN(b.x)], 1u);
            asm volatile("s_waitcnt vmcnt(0)" ::: "memory");
        } else {
            XB_SPIN(xb_ld(&bar[XB_XGEN(b.x)]) == gen, bar);
            __builtin_amdgcn_fence(__ATOMIC_ACQUIRE, "agent");
            asm volatile("s_waitcnt vmcnt(0)" ::: "memory");
        }
    }
    __syncthreads();
}
typedef unsigned short bf16_t;
typedef float f32x2 __attribute__((ext_vector_type(2)));
typedef unsigned u32x4 __attribute__((ext_vector_type(4)));
typedef unsigned u32x2 __attribute__((ext_vector_type(2)));
__device__ __forceinline__ float bf2f(bf16_t v) { return __uint_as_float(((unsigned)v) << 16); }
__device__ __forceinline__ float bflo(unsigned w) { return __uint_as_float(w << 16); }
__device__ __forceinline__ float bfhi(unsigned w) { return __uint_as_float(w & 0xffff0000u); }
__device__ __forceinline__ void st_b16(void* ptr, unsigned v) { asm volatile("global_store_short %0, %1, off" :: "v"(ptr), "v"(v) : "memory"); }
__device__ __forceinline__ void st_b32(void* ptr, float v) { asm volatile("global_store_dword %0, %1, off" :: "v"(ptr), "v"(v) : "memory"); }
__device__ __forceinline__ void st_b64(void* ptr, u32x2 v) { asm volatile("global_store_dwordx2 %0, %1, off" :: "v"(ptr), "v"(v) : "memory"); }
__device__ __forceinline__ void st_b128(void* ptr, u32x4 v) { asm volatile("global_store_dwordx4 %0, %1, off\n\ts_nop 1" :: "v"(ptr), "v"(v) : "memory"); }
__device__ __forceinline__ void st_f128(void* ptr, f32x4 v) { asm volatile("global_store_dwordx4 %0, %1, off\n\ts_nop 1" :: "v"(ptr), "v"(v) : "memory"); }
__device__ __forceinline__ void unpack8(const u32x4 v, float (&o)[8]) { o[0] = bflo(v.x); o[1] = bfhi(v.x); o[2] = bflo(v.y); o[3] = bfhi(v.y); o[4] = bflo(v.z); o[5] = bfhi(v.z); o[6] = bflo(v.w); o[7] = bfhi(v.w); }
constexpr int D = 2048, NB = 2, L = 4096, LC = 256;
constexpr int NTOK = NB * L, NCTX = NB * LC, NROW = NTOK + NCTX;
constexpr int NIN = 6576, LDP = 6656;
constexpr int C_Q = 0, C_K = 512, C_VM = 1024, C_OM = 2048, C_G = 3072, C_R = 3088, C_KR = 4112, C_VR = 5136, C_LW = 6160, C_LA = 6288, C_LG = 6416;
constexpr int FF = 5632, NMOD = 12288;
constexpr int RW = 1024;
constexpr int NSTEP = LC + L;

constexpr size_t MiB = 1u << 20;
constexpr size_t WS_CTL = 0;
constexpr size_t WS_MOD = 1 * MiB;
constexpr size_t WS_GATES = 2 * MiB;
constexpr size_t WS_BONUS = 3 * MiB;
constexpr size_t WS_BONUS_B = 4 * MiB;
constexpr size_t WS_DENS = 7 * MiB;
constexpr size_t WS_WUPT = 5 * MiB;
constexpr size_t WS_AUPT = 5 * MiB + 256 * 1024;
constexpr size_t WS_GUPT = 5 * MiB + 512 * 1024;
constexpr size_t WS_WOUT_T = 8 * MiB;
constexpr size_t WS_WIN_T = 16 * MiB;
constexpr size_t WS_HX = 42 * MiB;
constexpr size_t WS_KK = 16 * MiB;
constexpr size_t WS_QC = 33 * MiB;
constexpr size_t WS_KC = 42 * MiB;
constexpr size_t WS_GG = 51 * MiB;
constexpr size_t WS_PROJ = 76 * MiB;
constexpr size_t WS_LWF = 187 * MiB;
constexpr size_t WS_LWB = 204 * MiB;
constexpr size_t WS_AF = 221 * MiB;
constexpr size_t WS_AB = 238 * MiB;
constexpr size_t WS_CHD = 187 * MiB;
constexpr size_t WS_YF = 291 * MiB;
constexpr size_t WS_YB = 307 * MiB;
constexpr size_t WS_HF = 323 * MiB;
constexpr size_t WS_HB = 339 * MiB;
constexpr size_t WS_MIX = 187 * MiB;
constexpr size_t WS_HX2 = 8 * MiB;
constexpr size_t WS_WUG_T = 40 * MiB;
constexpr size_t WS_WDN_T = 84 * MiB;
constexpr size_t WS_UG = 106 * MiB;
constexpr size_t WS_ACT = 282 * MiB;
constexpr size_t WS_END = 370 * MiB;

struct P {
    const float *x, *c, *ctx, *c_ctx, *w_mod, *b_mod, *g_norm1, *g_norm2, *w_in, *m_conv_w, *m_conv_b, *m_gate_b, *m_norm_g;
    const float *r_w0, *r_w_up, *r_a0, *r_a_up, *r_g_up, *r_k_k, *r_k_a, *r_r_k, *r_gn_w, *r_gn_b, *w_out, *f_w_up, *f_w_gate, *f_conv_w, *f_conv_b, *f_w_down, *g_final;
    float* out; unsigned char* ws; unsigned mask, pad;
};

__device__ __forceinline__ float wave_sum(float v) {
#pragma unroll
    for (int o = 1; o < 64; o <<= 1) v += __shfl_xor(v, o);
    return v;
}
__device__ __forceinline__ float sigmoidf_(float x) { return 1.f / (1.f + __expf(-x)); }
__device__ __forceinline__ float softplusf_(float x) { return fmaxf(x, 0.f) + log1pf(__expf(-fabsf(x))); }

__device__ __forceinline__ void row_seq(int r, int& base, int& t, int& len) {
    if (r < NTOK) { base = r & ~(L - 1); t = r & (L - 1); len = L; } else { const int q = r - NTOK; base = NTOK + (q & ~(LC - 1)); t = q & (LC - 1); len = LC; }
}
__device__ __forceinline__ int step_row(int s, int b, int dir) {
    if (s < LC) { const int t = dir ? (LC - 1 - s) : s; return NTOK + b * LC + t; }
    const int u = s - LC; const int t = dir ? (L - 1 - u) : u; return b * L + t;
}

__device__ __forceinline__ void phase_mod(const P& p, int bid, int nb, float* lds) {
    float* sc = lds;
    float* red = lds + 3 * 2048;
    const int tid = threadIdx.x;
    for (int i = tid; i < 3 * 2048; i += blockDim.x) { const int v = i >> 11, k = i & 2047; const float xv = v < 2 ? p.c[v * 2048 + k] : p.c_ctx[k]; sc[i] = xv / (1.f + __expf(-xv)); }
    __syncthreads();
    float* MOD = (float*)(p.ws + WS_MOD);
    for (int cb = bid; cb < NMOD / 48; cb += nb) {
        const int cg = tid % 12, kl = tid / 12;
        float a[3][4];
#pragma unroll
        for (int v = 0; v < 3; ++v)
#pragma unroll
            for (int j = 0; j < 4; ++j) a[v][j] = 0.f;
        if (kl < 42) {
            for (int k = kl; k < 2048; k += 42) {
                const f32x4 w = *(const f32x4*)(p.w_mod + (size_t)k * NMOD + cb * 48 + cg * 4);
#pragma unroll
                for (int v = 0; v < 3; ++v) { const float s = sc[v * 2048 + k]; a[v][0] += s * w.x; a[v][1] += s * w.y; a[v][2] += s * w.z; a[v][3] += s * w.w; }
            }
#pragma unroll
            for (int v = 0; v < 3; ++v)
#pragma unroll
                for (int j = 0; j < 4; ++j) red[kl * 144 + v * 48 + cg * 4 + j] = a[v][j];
        }
        __syncthreads();
        if (tid < 144) {
            float s = 0.f;
            for (int k = 0; k < 42; ++k) s += red[k * 144 + tid];
            const int v = tid / 48, cc = tid % 48;
            MOD[v * NMOD + cb * 48 + cc] = s + p.b_mod[cb * 48 + cc];
        }
        __syncthreads();
    }
}

__device__ __forceinline__ void normmod_row(const float* src, const float* g, const float* sh, const float* sc, bf16_t* dst, int lane) {
    f32x4 v[8]; float s = 0.f;
#pragma unroll
    for (int j = 0; j < 8; ++j) { v[j] = *((const f32x4*)src + lane + 64 * j); s += (v[j].x * v[j].x + v[j].y * v[j].y) + (v[j].z * v[j].z + v[j].w * v[j].w); }
    const float rs = rsqrtf(wave_sum(s) * (1.f / D) + 1e-6f);
#pragma unroll
    for (int j = 0; j < 8; ++j) {
        const f32x4 gg = *((const f32x4*)g + lane + 64 * j), a = *((const f32x4*)sc + lane + 64 * j), b = *((const f32x4*)sh + lane + 64 * j);
        const float o0 = v[j].x * rs * gg.x * (1.f + a.x) + b.x, o1 = v[j].y * rs * gg.y * (1.f + a.y) + b.y, o2 = v[j].z * rs * gg.z * (1.f + a.z) + b.z, o3 = v[j].w * rs * gg.w * (1.f + a.w) + b.w;
        u32x2 w; w.x = pk2(o0, o1); w.y = pk2(o2, o3);
        *((u32x2*)dst + lane + 64 * j) = w;
    }
}
__device__ __forceinline__ void phase_normmod(const P& p, int which, int gw, int ngw, int lane) {
    const float* MOD = (const float*)(p.ws + WS_MOD);
    if (which == 0) {
        bf16_t* HX = (bf16_t*)(p.ws + WS_HX);
        for (int r = gw; r < NROW; r += ngw) {
            const float* src = r < NTOK ? p.x + (size_t)r * D : p.ctx + (size_t)(r - NTOK) * D;
            const int v = r < NTOK ? (r >> 12) : 2;
            normmod_row(src, p.g_norm1, MOD + v * NMOD + 0, MOD + v * NMOD + 2048, HX + (size_t)r * D, lane);
        }
    } else {
        bf16_t* HX2 = (bf16_t*)(p.ws + WS_HX2);
        for (int r = gw; r < NTOK; r += ngw) {
            const int v = r >> 12;
            normmod_row(p.out + (size_t)r * D, p.g_norm2, MOD + v * NMOD + 3 * 2048, MOD + v * NMOD + 4 * 2048, HX2 + (size_t)r * D, lane);
        }
    }
}

__device__ __forceinline__ void phase_lora_ref(const P& p, int bid, int nb, float* lds) {
    float* tl = lds;
    float* la = lds + 128;
    float* sg = lds + 256;
    const bf16_t* PROJ = (const bf16_t*)(p.ws + WS_PROJ);
    bf16_t* LW[2] = {(bf16_t*)(p.ws + WS_LWF), (bf16_t*)(p.ws + WS_LWB)};
    bf16_t* AA[2] = {(bf16_t*)(p.ws + WS_AF), (bf16_t*)(p.ws + WS_AB)};
    bf16_t* GG = (bf16_t*)(p.ws + WS_GG);
    const int tid = threadIdx.x;
    for (int r = bid; r < NROW; r += nb) {
        const bf16_t* pr = PROJ + (size_t)r * LDP;
        if (tid < 128) tl[tid] = tanhf(bf2f(pr[C_LW + tid]));
        else if (tid < 256) la[tid - 128] = bf2f(pr[C_LA + tid - 128]);
        else if (tid < 416) sg[tid - 256] = sigmoidf_(bf2f(pr[C_LG + tid - 256]));
        __syncthreads();
        for (int c = tid; c < RW; c += blockDim.x) {
#pragma unroll
            for (int d = 0; d < 2; ++d) {
                float aw = p.r_w0[d * RW + c], aa = p.r_a0[d * RW + c];
                for (int k = 0; k < 64; ++k) { aw += tl[d * 64 + k] * p.r_w_up[(size_t)(d * 64 + k) * RW + c]; aa += la[d * 64 + k] * p.r_a_up[(size_t)(d * 64 + k) * RW + c]; }
                const float wlog = -softplusf_(-aw) - 0.5f;
                LW[d][(size_t)r * RW + c] = (bf16_t)f2bf(-__expf(wlog));
                AA[d][(size_t)r * RW + c] = (bf16_t)f2bf(sigmoidf_(aa));
            }
            if (r < NTOK) {
                float g = 0.f;
                for (int k = 0; k < 160; ++k) g += sg[k] * p.r_g_up[(size_t)k * RW + c];
                GG[(size_t)r * RW + c] = (bf16_t)f2bf(g);
            }
        }
        __syncthreads();
    }
}

__device__ __forceinline__ void phase_prep(const P& p, int bid, int nb) {
    const bf16_t* PROJ = (const bf16_t*)(p.ws + WS_PROJ);
    bf16_t* QC = (bf16_t*)(p.ws + WS_QC); bf16_t* KC = (bf16_t*)(p.ws + WS_KC);
    float* GATES = (float*)(p.ws + WS_GATES);
    const int tid = threadIdx.x, rl = tid >> 7, c0 = (tid & 127) * 8;
    float cw[3][8], cb[8];
#pragma unroll
    for (int k = 0; k < 3; ++k) { *(f32x4*)&cw[k][0] = *(const f32x4*)(p.m_conv_w + k * 1024 + c0); *(f32x4*)&cw[k][4] = *(const f32x4*)(p.m_conv_w + k * 1024 + c0 + 4); }
    *(f32x4*)&cb[0] = *(const f32x4*)(p.m_conv_b + c0); *(f32x4*)&cb[4] = *(const f32x4*)(p.m_conv_b + c0 + 4);
    for (int r = bid * 4 + rl; r < NROW; r += nb * 4) {
        int base, t, len; row_seq(r, base, t, len);
        const bf16_t* pr = PROJ + (size_t)r * LDP;
        const bool hp = t > 0, hn = t + 1 < len;
        float cur[8], prv[8], nxt[8];
        unpack8(*(const u32x4*)(pr + c0), cur); unpack8(*(const u32x4*)(pr - (hp ? LDP : 0) + c0), prv); unpack8(*(const u32x4*)(pr + (hn ? LDP : 0) + c0), nxt);
        const float mp = hp ? 1.f : 0.f, mn = hn ? 1.f : 0.f, sc = c0 < 512 ? 0.08838834764831845f : 1.f;
        float o[8];
#pragma unroll
        for (int j = 0; j < 8; ++j) o[j] = (prv[j] * (cw[0][j] * mp) + cur[j] * cw[1][j] + nxt[j] * (cw[2][j] * mn) + cb[j]) * sc;
        u32x4 w; w.x = pk2(o[0], o[1]); w.y = pk2(o[2], o[3]); w.z = pk2(o[4], o[5]); w.w = pk2(o[6], o[7]);
        if (c0 < 512) *(u32x4*)(QC + (size_t)r * 512 + c0) = w; else *(u32x4*)(KC + (size_t)r * 512 + c0 - 512) = w;
        if ((tid & 127) < 16) {
            const int j = tid & 127;
            float v = bf2f(pr[C_G + j]) + p.m_gate_b[j];
            if (j >= 8) v = -softplusf_(-v);
            GATES[(size_t)r * 16 + j] = v;
        }
    }
}

__device__ void rwkv_ref_task(const P& p, int gw, int lane) {
    const bf16_t* PROJ = (const bf16_t*)(p.ws + WS_PROJ); const bf16_t* KK = (const bf16_t*)(p.ws + WS_KK);
    const int stream = gw >> 6, vrow = gw & 63, dir = stream >> 5, b = (stream >> 4) & 1, h = stream & 15;
    const bf16_t* LW = (const bf16_t*)(p.ws + (dir ? WS_LWB : WS_LWF)); const bf16_t* AA = (const bf16_t*)(p.ws + (dir ? WS_AB : WS_AF));
    bf16_t* Y = (bf16_t*)(p.ws + (dir ? WS_YB : WS_YF));
    const int c = h * 64 + lane; const float rka = p.r_k_a[c];
    float s = 0.f;
    for (int st = 0; st < NSTEP; ++st) {
        const int r = step_row(st, b, dir);
        const float w = __expf(bf2f(LW[(size_t)r * RW + c])), a = bf2f(AA[(size_t)r * RW + c]), kk = bf2f(KK[(size_t)r * RW + c]);
        const float kr = bf2f(PROJ[(size_t)r * LDP + C_KR + c]), rr = bf2f(PROJ[(size_t)r * LDP + C_R + c]), vv = bf2f(PROJ[(size_t)r * LDP + C_VR + h * 64 + vrow]);
        const float kd = kr * (1.f + (a - 1.f) * rka);
        const float sa = wave_sum(s * kk);
        s = s * w - sa * (kk * a) + vv * kd;
        const float y = wave_sum(s * rr);
        if (st >= LC && lane == 0) Y[(size_t)r * RW + h * 64 + vrow] = (bf16_t)f2bf(y);
    }
}
__device__ void mlstm_ref_task(const P& p, int gw, int lane) {
    const bf16_t* PROJ = (const bf16_t*)(p.ws + WS_PROJ); const bf16_t* QC = (const bf16_t*)(p.ws + WS_QC); const bf16_t* KC = (const bf16_t*)(p.ws + WS_KC);
    const float* GATES = (const float*)(p.ws + WS_GATES);
    const int stream = gw >> 8, vrow = gw & 255, dir = stream >> 3, b = (stream >> 2) & 1, h = stream & 3;
    bf16_t* H = (bf16_t*)(p.ws + (dir ? WS_HB : WS_HF));
    float c0 = 0.f, c1 = 0.f, n0 = 0.f, n1 = 0.f;
    for (int st = 0; st < NSTEP; ++st) {
        const int r = step_row(st, b, dir);
        const float ig = GATES[(size_t)r * 16 + dir * 4 + h], lf = GATES[(size_t)r * 16 + 8 + dir * 4 + h];
        const float f = __expf(lf), ei = __expf(ig);
        const float k0 = bf2f(KC[(size_t)r * 512 + h * 128 + lane]), k1 = bf2f(KC[(size_t)r * 512 + h * 128 + 64 + lane]);
        const float q0 = bf2f(QC[(size_t)r * 512 + h * 128 + lane]), q1 = bf2f(QC[(size_t)r * 512 + h * 128 + 64 + lane]);
        const float v = bf2f(PROJ[(size_t)r * LDP + C_VM + h * 256 + vrow]);
        c0 = f * c0 + ei * v * k0; c1 = f * c1 + ei * v * k1; n0 = f * n0 + ei * k0; n1 = f * n1 + ei * k1;
        const float num = wave_sum(c0 * q0 + c1 * q1), den = wave_sum(n0 * q0 + n1 * q1);
        if (st >= LC && lane == 0) H[(size_t)r * RW + h * 256 + vrow] = (bf16_t)f2bf(num / fmaxf(fabsf(den), 1.f));
    }
}

__device__ __forceinline__ void phase_post(const P& p, int gw, int ngw, int lane) {
    const bf16_t* PROJ = (const bf16_t*)(p.ws + WS_PROJ);
    const bf16_t* YF = (const bf16_t*)(p.ws + WS_YF); const bf16_t* YB = (const bf16_t*)(p.ws + WS_YB);
    const bf16_t* HF = (const bf16_t*)(p.ws + WS_HF); const bf16_t* HB = (const bf16_t*)(p.ws + WS_HB);
    const bf16_t* GG = (const bf16_t*)(p.ws + WS_GG); const float* BONUS = (const float*)(p.ws + WS_BONUS); const float* BONUSB = (const float*)(p.ws + WS_BONUS_B);
    bf16_t* MIX = (bf16_t*)(p.ws + WS_MIX);
    for (int it = gw; it < NTOK * 4; it += ngw) {
        const int r = it >> 2, qt = it & 3, c0 = (qt & 1) * 512 + lane * 8;
        const bf16_t* pr = PROJ + (size_t)r * LDP;
        float o[8];
        if (qt < 2) {
            float a[8], b[8], om[8], gn[8];
            unpack8(*(const u32x4*)(HF + (size_t)r * RW + c0), a); unpack8(*(const u32x4*)(HB + (size_t)r * RW + c0), b); unpack8(*(const u32x4*)(pr + C_OM + c0), om);
            *(f32x4*)&gn[0] = *(const f32x4*)(p.m_norm_g + c0); *(f32x4*)&gn[4] = *(const f32x4*)(p.m_norm_g + c0 + 4);
            float ss = 0.f;
#pragma unroll
            for (int j = 0; j < 8; ++j) { a[j] += b[j]; ss += a[j] * a[j]; }
#pragma unroll
            for (int o2 = 1; o2 < 32; o2 <<= 1) ss += __shfl_xor(ss, o2);
            const float rs = rsqrtf(ss * (1.f / 256.f) + 1e-6f);
#pragma unroll
            for (int j = 0; j < 8; ++j) o[j] = a[j] * rs * gn[j] * __builtin_amdgcn_rcpf(1.f + __expf(-om[j]));
            u32x4 w; w.x = pk2(o[0], o[1]); w.y = pk2(o[2], o[3]); w.z = pk2(o[4], o[5]); w.w = pk2(o[6], o[7]);
            *(u32x4*)(MIX + (size_t)r * D + c0) = w;
        } else {
            float a[8], b[8], vr[8], gg[8], gw_[8], gb[8];
            unpack8(*(const u32x4*)(YF + (size_t)r * RW + c0), a); unpack8(*(const u32x4*)(YB + (size_t)r * RW + c0), b);
            unpack8(*(const u32x4*)(pr + C_VR + c0), vr); unpack8(*(const u32x4*)(GG + (size_t)r * RW + c0), gg);
            *(f32x4*)&gw_[0] = *(const f32x4*)(p.r_gn_w + c0); *(f32x4*)&gw_[4] = *(const f32x4*)(p.r_gn_w + c0 + 4);
            *(f32x4*)&gb[0] = *(const f32x4*)(p.r_gn_b + c0); *(f32x4*)&gb[4] = *(const f32x4*)(p.r_gn_b + c0 + 4);
            const int hd = c0 >> 6;
            const float bn = BONUS[(size_t)r * 16 + hd] + BONUSB[(size_t)r * 16 + hd];
            float sm = 0.f;
#pragma unroll
            for (int j = 0; j < 8; ++j) { a[j] += b[j]; sm += a[j]; }
            sm += __shfl_xor(sm, 1); sm += __shfl_xor(sm, 2); sm += __shfl_xor(sm, 4);
            const float mu = sm * (1.f / 64.f);
            float sv = 0.f;
#pragma unroll
            for (int j = 0; j < 8; ++j) { a[j] -= mu; sv += a[j] * a[j]; }
            sv += __shfl_xor(sv, 1); sv += __shfl_xor(sv, 2); sv += __shfl_xor(sv, 4);
            const float rs = rsqrtf(sv * (1.f / 64.f) + 64e-5f);
#pragma unroll
            for (int j = 0; j < 8; ++j) o[j] = (a[j] * rs * gw_[j] + gb[j] + bn * vr[j]) * gg[j];
            u32x4 w; w.x = pk2(o[0], o[1]); w.y = pk2(o[2], o[3]); w.z = pk2(o[4], o[5]); w.w = pk2(o[6], o[7]);
            *(u32x4*)(MIX + (size_t)r * D + 1024 + c0) = w;
        }
    }
}

__device__ __forceinline__ void phase_convact(const P& p, int gw, int lane) {
    const bf16_t* UG = (const bf16_t*)(p.ws + WS_UG); bf16_t* ACT = (bf16_t*)(p.ws + WS_ACT);
    constexpr int NCGW = FF / 8 / 64, NSTRIPE = 186, TPS = 45;
    const int cgw = gw % NCGW, stripe = gw / NCGW;
    if (stripe >= NSTRIPE) return;
    const int f = (cgw * 64 + lane) * 8;
    float cw[9][8], cb[8];
#pragma unroll
    for (int k = 0; k < 9; ++k) { *(f32x4*)&cw[k][0] = *(const f32x4*)(p.f_conv_w + (size_t)k * FF + f); *(f32x4*)&cw[k][4] = *(const f32x4*)(p.f_conv_w + (size_t)k * FF + f + 4); }
    *(f32x4*)&cb[0] = *(const f32x4*)(p.f_conv_b + f); *(f32x4*)&cb[4] = *(const f32x4*)(p.f_conv_b + f + 4);
    const int r1 = min(NTOK, (stripe + 1) * TPS);
    for (int r = stripe * TPS; r < r1; r += 2) {
        u32x4 ld[2][10]; float msk[2][9]; bool have[2];
#pragma unroll
        for (int tk = 0; tk < 2; ++tk) {
            const int rr_ = min(r + tk, NTOK - 1); have[tk] = (r + tk) < r1;
            const int b = rr_ >> 12, t = rr_ & 4095, gr = t >> 6, gc = t & 63;
#pragma unroll
            for (int dr = 0; dr < 3; ++dr)
#pragma unroll
                for (int dc = 0; dc < 3; ++dc) {
                    const int rr = gr + dr - 1, cc = gc + dc - 1;
                    const bool ok = rr >= 0 && rr < 64 && cc >= 0 && cc < 64;
                    const int nb_ = ok ? (b * 4096 + rr * 64 + cc) : rr_; msk[tk][dr * 3 + dc] = ok ? 1.f : 0.f;
                    ld[tk][dr * 3 + dc] = *(const u32x4*)(UG + (size_t)nb_ * (2 * FF) + f);
                }
            ld[tk][9] = *(const u32x4*)(UG + (size_t)rr_ * (2 * FF) + FF + f);
        }
#pragma unroll
        for (int tk = 0; tk < 2; ++tk) {
            float acc[8];
#pragma unroll
            for (int j = 0; j < 8; ++j) acc[j] = cb[j];
#pragma unroll
            for (int k = 0; k < 9; ++k) { float u[8]; unpack8(ld[tk][k], u);
#pragma unroll
                for (int j = 0; j < 8; ++j) acc[j] += u[j] * (cw[k][j] * msk[tk][k]); }
            float gt[8]; unpack8(ld[tk][9], gt);
            float o[8];
#pragma unroll
            for (int j = 0; j < 8; ++j) { const float u = acc[j], z2 = 1.5957691216057308f * (u + 0.044715f * u * u * u); o[j] = u * __builtin_amdgcn_rcpf(1.f + __expf(-z2)) * gt[j]; }
            u32x4 w; w.x = pk2(o[0], o[1]); w.y = pk2(o[2], o[3]); w.z = pk2(o[4], o[5]); w.w = pk2(o[6], o[7]);
            if (have[tk]) *(u32x4*)(ACT + (size_t)(r + tk) * FF + f) = w;
        }
    }
}

__device__ __forceinline__ void phase_final(const P& p, int gw, int ngw, int lane) {
    for (int r = gw; r < NTOK; r += ngw) {
        float* row = p.out + (size_t)r * D;
        f32x4 v[8]; float s = 0.f;
#pragma unroll
        for (int j = 0; j < 8; ++j) { v[j] = *((const f32x4*)row + lane + 64 * j); s += (v[j].x * v[j].x + v[j].y * v[j].y) + (v[j].z * v[j].z + v[j].w * v[j].w); }
        const float rs = rsqrtf(wave_sum(s) * (1.f / D) + 1e-6f);
#pragma unroll
        for (int j = 0; j < 8; ++j) { const f32x4 g = *((const f32x4*)p.g_final + lane + 64 * j); f32x4 o; o.x = v[j].x * rs * g.x; o.y = v[j].y * rs * g.y; o.z = v[j].z * rs * g.z; o.w = v[j].w * rs * g.w; *((f32x4*)row + lane + 64 * j) = o; }
    }
}

typedef short s16x4 __attribute__((ext_vector_type(4)));
__device__ __forceinline__ bf16x8 tr8(const LAS unsigned char* p0, int rstride4) {
    const s16x4 lo = __builtin_amdgcn_ds_read_tr16_b64_v4i16((LAS s16x4*)p0);
    const s16x4 hi = __builtin_amdgcn_ds_read_tr16_b64_v4i16((LAS s16x4*)(p0 + rstride4));
    return (bf16x8){lo[0], lo[1], lo[2], lo[3], hi[0], hi[1], hi[2], hi[3]};
}
template <int CTRL, int RM, bool BC> __device__ __forceinline__ float dppf(float oldv, float src) { return __int_as_float(__builtin_amdgcn_update_dpp(__float_as_int(oldv), __float_as_int(src), CTRL, RM, 0xF, BC)); }
__device__ __forceinline__ float wave_scan_add(float x) {
    x += dppf<0x111, 0xF, true>(0.f, x); x += dppf<0x112, 0xF, true>(0.f, x); x += dppf<0x114, 0xF, true>(0.f, x); x += dppf<0x118, 0xF, true>(0.f, x);
    x += dppf<0x142, 0xA, false>(0.f, x); x += dppf<0x143, 0xC, false>(0.f, x);
    return x;
}
__device__ __forceinline__ float wave_scan_max(float x) {
    const float ni = -__builtin_inff();
    x = fmaxf(x, dppf<0x111, 0xF, false>(ni, x)); x = fmaxf(x, dppf<0x112, 0xF, false>(ni, x)); x = fmaxf(x, dppf<0x114, 0xF, false>(ni, x)); x = fmaxf(x, dppf<0x118, 0xF, false>(ni, x));
    x = fmaxf(x, dppf<0x142, 0xA, false>(ni, x)); x = fmaxf(x, dppf<0x143, 0xC, false>(ni, x));
    return x;
}
__device__ __forceinline__ float lane_bcast63(float x) { return __int_as_float(__builtin_amdgcn_readlane(__float_as_int(x), 63)); }
constexpr int MI_QS = 0, MI_KS = 17408, MI_VS = 34816, MI_PS = 68608, MI_SC = 77824, MI_END = 78336;
constexpr int MI_RS = 272, MI_VRS = 528, MI_PRS = 144;
constexpr int NTASK_MI = 16 * (L / 64);
__device__ __forceinline__ void phase_mintra(const P& p, LAS unsigned char* L3, int bid, int nb) {
    int tid_ = threadIdx.x; asm volatile("" : "+v"(tid_));
    const int tid = tid_, lane = tid & 63, w = __builtin_amdgcn_readfirstlane(tid >> 6), g = lane >> 4, li = lane & 15, q4 = li >> 2, p4 = li & 3;
    const bf16_t* PROJ = (const bf16_t*)(p.ws + WS_PROJ); const bf16_t* QC = (const bf16_t*)(p.ws + WS_QC); const bf16_t* KC = (const bf16_t*)(p.ws + WS_KC);
    const float* GATES = (const float*)(p.ws + WS_GATES);
    const int mt = w >> 1, nh = w & 1;
    for (int task = bid; task < NTASK_MI; task += nb) {
        const int stream = task & 15, c = LC / 64 + (task >> 4), dir = stream >> 3, b = (stream >> 2) & 1, h = stream & 3;
        bf16_t* NUMS = (bf16_t*)(p.ws + (dir ? WS_HB : WS_HF)); float* DENS = (float*)(p.ws + WS_DENS) + dir * (NTOK * 4);
        {
            u32x4 qv[2], kv[2], vv[4];
#pragma unroll
            for (int i = 0; i < 2; ++i) { const int pc = tid + 512 * i, j = pc >> 4, dp = pc & 15; const int r = step_row(64 * c + j, b, dir);
                qv[i] = *(const u32x4*)(QC + (size_t)r * 512 + h * 128 + dp * 8); kv[i] = *(const u32x4*)(KC + (size_t)r * 512 + h * 128 + dp * 8); }
#pragma unroll
            for (int i = 0; i < 4; ++i) { const int pc = tid + 512 * i, j = pc >> 5, dp = pc & 31; const int r = step_row(64 * c + j, b, dir); vv[i] = *(const u32x4*)(PROJ + (size_t)r * LDP + C_VM + h * 256 + dp * 8); }
            if (w == 0) {
                const int r = step_row(64 * c + lane, b, dir);
                const float gi = GATES[(size_t)r * 16 + dir * 4 + h], gf = GATES[(size_t)r * 16 + 8 + dir * 4 + h];
                const float bc = wave_scan_add(gf), av = gi - bc, pml = wave_scan_max(av);
                LAS float* sc = (LAS float*)(L3 + MI_SC); sc[lane] = av; sc[64 + lane] = pml;
            }
#pragma unroll
            for (int i = 0; i < 2; ++i) { const int pc = tid + 512 * i, j = pc >> 4, dp = pc & 15; *(LAS u32x4*)(L3 + MI_QS + j * MI_RS + dp * 16) = qv[i]; *(LAS u32x4*)(L3 + MI_KS + j * MI_RS + dp * 16) = kv[i]; }
#pragma unroll
            for (int i = 0; i < 4; ++i) { const int pc = tid + 512 * i, j = pc >> 5, dp = pc & 31; *(LAS u32x4*)(L3 + MI_VS + j * MI_VRS + dp * 16) = vv[i]; }
        }
        __syncthreads();
        {
            const LAS float* sc = (const LAS float*)(L3 + MI_SC);
            bf16x8 aq[4];
#pragma unroll
            for (int ks = 0; ks < 4; ++ks) aq[ks] = *(const LAS bf16x8*)(L3 + MI_QS + (16 * mt + li) * MI_RS + (32 * ks + 8 * g) * 2);
            const f32x4 pmv = *(const LAS f32x4*)(sc + 64 + 16 * mt + 4 * g);
#pragma unroll
            for (int n = 0; n < 2; ++n) {
                const int nt = 2 * nh + n;
                f32x4 sv = (f32x4){0.f, 0.f, 0.f, 0.f};
                if (nt <= mt) {
#pragma unroll
                    for (int ks = 0; ks < 4; ++ks) { const bf16x8 bk = *(const LAS bf16x8*)(L3 + MI_KS + (16 * nt + li) * MI_RS + (32 * ks + 8 * g) * 2); sv = __builtin_amdgcn_mfma_f32_16x16x32_bf16(aq[ks], bk, sv, 0, 0, 0); }
                    const float av = sc[16 * nt + li];
#pragma unroll
                    for (int r = 0; r < 4; ++r) { const int j = 16 * mt + 4 * g + r, ss = 16 * nt + li; sv[r] = (ss <= j) ? sv[r] * __expf(av - pmv[r]) : 0.f; }
                }
#pragma unroll
                for (int r = 0; r < 4; ++r) *(LAS bf16_t*)(L3 + MI_PS + (16 * mt + 4 * g + r) * MI_PRS + (16 * nt + li) * 2) = (bf16_t)f2bf(sv[r]);
            }
        }
        __syncthreads();
        {
            bf16x8 ap[2];
#pragma unroll
            for (int ks = 0; ks < 2; ++ks) ap[ks] = *(const LAS bf16x8*)(L3 + MI_PS + (16 * mt + li) * MI_PRS + (32 * ks + 8 * g) * 2);
            f32x4 acc[8];
#pragma unroll
            for (int x = 0; x < 8; ++x) acc[x] = (f32x4){0.f, 0.f, 0.f, 0.f};
#pragma unroll
            for (int ks = 0; ks < 2; ++ks)
#pragma unroll
                for (int x = 0; x < 8; ++x) { const bf16x8 bv = tr8(L3 + MI_VS + (32 * ks + 8 * g + q4) * MI_VRS + 32 * (8 * nh + x) + 8 * p4, 4 * MI_VRS); acc[x] = __builtin_amdgcn_mfma_f32_16x16x32_bf16(ap[ks], bv, acc[x], 0, 0, 0); }
            if (nh == 0) {
                const short one = li == 0 ? (short)0x3F80 : (short)0;
                const bf16x8 ones = (bf16x8){one, one, one, one, one, one, one, one};
                f32x4 dn = (f32x4){0.f, 0.f, 0.f, 0.f};
                dn = __builtin_amdgcn_mfma_f32_16x16x32_bf16(ap[0], ones, dn, 0, 0, 0); dn = __builtin_amdgcn_mfma_f32_16x16x32_bf16(ap[1], ones, dn, 0, 0, 0);
                if (li == 0) {
                    const int row0 = step_row(64 * c + 16 * mt + 4 * g, b, dir);
#pragma unroll
                    for (int r = 0; r < 4; ++r) st_b32(DENS + (size_t)(row0 + (dir ? -r : r)) * 4 + h, dn[r]);
                }
            }
#pragma unroll
            for (int x = 0; x < 8; ++x)
#pragma unroll
                for (int r = 0; r < 4; ++r) *(LAS bf16_t*)(L3 + MI_QS + (16 * mt + 4 * g + r) * MI_VRS + (16 * (8 * nh + x) + li) * 2) = (bf16_t)f2bf(acc[x][r]);
        }
        __syncthreads();
#pragma unroll
        for (int i = 0; i < 4; ++i) { const int pc = tid + 512 * i, j = pc >> 5, dp = pc & 31; const int r = step_row(64 * c + j, b, dir); st_b128(NUMS + (size_t)r * RW + h * 256 + dp * 8, *(const LAS u32x4*)(L3 + MI_QS + j * MI_VRS + dp * 16)); }
        __syncthreads();
    }
}

constexpr int ML_QS = 0, ML_KS = 17408, ML_VW = 34816, ML_OFFB = 41984, ML_CS = 83968, ML_CSB = 13056, ML_SC = 110080, ML_SCB = 2048, ML_END = 116224;
constexpr int ML_RS = 272, ML_VRS = 112, NCHUNK = NSTEP / 64;

__device__ __forceinline__ void phase_mlstm(const P& p, LAS unsigned char* L3, int task, unsigned pflags) {
    int tid_ = threadIdx.x; asm volatile("" : "+v"(tid_));
    const int tid = tid_, lane = tid & 63, w = __builtin_amdgcn_readfirstlane(tid >> 6), g = lane >> 4, li = lane & 15, q4 = li >> 2, p4 = li & 3;
    const int stream = task >> 3, sl = task & 7, dir = stream >> 3, b = (stream >> 2) & 1, h = stream & 3;
    const bf16_t* PROJ = (const bf16_t*)(p.ws + WS_PROJ); const bf16_t* QC = (const bf16_t*)(p.ws + WS_QC); const bf16_t* KC = (const bf16_t*)(p.ws + WS_KC);
    const float* GATES = (const float*)(p.ws + WS_GATES); const float* DENS = (const float*)(p.ws + WS_DENS) + dir * (NTOK * 4);
    bf16_t* H = (bf16_t*)(p.ws + (dir ? WS_HB : WS_HF));
    const int mt = w >> 1, nh = w & 1;
    for (int i = tid; i < 2 * ML_CSB / 4; i += 512) ((LAS unsigned*)(L3 + ML_CS))[i] = 0u;
    auto rlow = [&](int c) -> int { const int r0 = step_row(64 * c, b, dir); return dir ? r0 - 63 : r0; };
    unsigned offQ[2], offV = 0u, offNS[4], offGt, offDn;
#pragma unroll
    for (int i = 0; i < 2; ++i) { const int pc = tid + 512 * i, j = pc >> 4, dp = pc & 15; offQ[i] = (unsigned)((dir ? 63 - j : j) * 1024 + dp * 16); }
    if (tid < 256) { const int j = tid >> 2, pc = tid & 3; offV = (unsigned)((dir ? 63 - j : j) * (LDP * 2) + pc * 16); }
#pragma unroll
    for (int r = 0; r < 4; ++r) { const int j = 16 * mt + 4 * g + r; offNS[r] = (unsigned)((dir ? 63 - j : j) * (RW * 2) + (16 * nh + li) * 2); }
    offGt = (unsigned)((dir ? 63 - lane : lane) * 64); offDn = (unsigned)((dir ? 63 - lane : lane) * 16);
    const unsigned char* QCb = (const unsigned char*)QC + h * 256; const unsigned char* KCb = (const unsigned char*)KC + h * 256;
    const unsigned char* PVb = (const unsigned char*)PROJ + (C_VM + h * 256 + sl * 32) * 2; unsigned char* Hb = (unsigned char*)H + (h * 256 + sl * 32) * 2;
    const unsigned char* GTb = (const unsigned char*)GATES + (dir * 4 + h) * 4; const unsigned char* DNb = (const unsigned char*)DENS + h * 4;
    struct Stg { u32x4 q[2], k[2], v; };
    Stg S; float g_i = 0.f, g_f = 0.f, g_d = 0.f; float m_old = 0.f;
    auto load_chunk = [&](int c) {
        const size_t rl = (size_t)rlow(c);
#pragma unroll
        for (int i = 0; i < 2; ++i) { S.q[i] = *(const u32x4*)(QCb + rl * 1024 + offQ[i]); S.k[i] = *(const u32x4*)(KCb + rl * 1024 + offQ[i]); }
        if (tid < 256) S.v = *(const u32x4*)(PVb + rl * (LDP * 2) + offV);
    };
    auto load_ns = [&](int c, bf16_t (&ns)[4]) {
        if (c >= LC / 64) { const unsigned char* hb = Hb + (size_t)rlow(c) * (RW * 2);
#pragma unroll
            for (int r = 0; r < 4; ++r) ns[r] = *(const bf16_t*)(hb + offNS[r]); }
    };
    auto load_gates = [&](int c) { if (w == 0) { const size_t rl = (size_t)rlow(c); g_i = *(const float*)(GTb + rl * 64 + offGt); g_f = *(const float*)(GTb + rl * 64 + 32 + offGt); g_d = c >= LC / 64 ? *(const float*)(DNb + rl * 16 + offDn) : 0.f; } };
    auto scalars = [&](int buf) {
        const float bc = wave_scan_add(g_f);
        const float a = g_i - bc; const float pml = wave_scan_max(a);
        const float pm = fmaxf(pml, m_old);
        const float pmL = lane_bcast63(pm), bl = lane_bcast63(bc);
        LAS float* sc = (LAS float*)(L3 + ML_SC + buf * ML_SCB);
        sc[lane] = __expf(pml - pm); sc[64 + lane] = __expf(m_old - pm); sc[128 + lane] = __expf(-(bc + pm)); sc[192 + lane] = __expf(a - pmL); sc[256 + lane] = g_d;
        if (lane == 0) sc[320] = __expf(m_old - pmL);
        m_old = bl + pmL;
    };
    auto write_stage = [&](int buf, int scb) {
        LAS unsigned char* B = L3 + buf * ML_OFFB; const LAS float* sc = (const LAS float*)(L3 + ML_SC + scb * ML_SCB);
#pragma unroll
        for (int i = 0; i < 2; ++i) { const int pc = tid + 512 * i, j = pc >> 4, dp = pc & 15; *(LAS u32x4*)(B + ML_QS + j * ML_RS + dp * 16) = S.q[i]; *(LAS u32x4*)(B + ML_KS + j * ML_RS + dp * 16) = S.k[i]; }
        if (tid < 256) { const int j = tid >> 2, pc = tid & 3; const float wk = sc[192 + j]; const u32x4 vreg = S.v;
            u32x4 o; o.x = pk2(bflo(vreg.x) * wk, bfhi(vreg.x) * wk); o.y = pk2(bflo(vreg.y) * wk, bfhi(vreg.y) * wk); o.z = pk2(bflo(vreg.z) * wk, bfhi(vreg.z) * wk); o.w = pk2(bflo(vreg.w) * wk, bfhi(vreg.w) * wk);
            *(LAS u32x4*)(B + ML_VW + j * ML_VRS + pc * 16) = o; }
        else if (tid < 320) { const int j = tid - 256; LAS u32x4* d = (LAS u32x4*)(B + ML_VW + j * ML_VRS + 64); d[0] = (u32x4){f2bf(sc[192 + j]), 0u, 0u, 0u}; d[1] = (u32x4){0u, 0u, 0u, 0u}; }
    };
    load_chunk(0); load_gates(0);
    if (w == 0) scalars(0);
    load_gates(1);
    __syncthreads();
    write_stage(0, 0);
    if (w == 0) scalars(1);
    load_chunk(1); load_gates(2);
    bf16_t nsA[4], nsB[4]; load_ns(0, nsA); load_ns(1, nsB);
    __syncthreads();
    f32x4 accC[3];
#pragma unroll
    for (int i = 0; i < 3; ++i) accC[i] = (f32x4){0.f, 0.f, 0.f, 0.f};
    auto mstep = [&](int c, bf16_t (&nsCur)[4]) {
        const int cur = c & 1, nxt = cur ^ 1;
        LAS unsigned char* B = L3 + cur * ML_OFFB; const LAS float* sc = (const LAS float*)(L3 + ML_SC + (c % 3) * ML_SCB);
        float hv[4];
        if (c >= LC / 64 && !(pflags & 512u)) {
            const LAS unsigned char* CSc = L3 + ML_CS + cur * ML_CSB;
            f32x4 nC[2] = {(f32x4){0.f, 0.f, 0.f, 0.f}, (f32x4){0.f, 0.f, 0.f, 0.f}};
#pragma unroll
            for (int ks = 0; ks < 4; ++ks) {
                const bf16x8 aq = *(const LAS bf16x8*)(B + ML_QS + (16 * mt + li) * ML_RS + (32 * ks + 8 * g) * 2);
#pragma unroll
                for (int x = 0; x < 2; ++x) { const int vt = x ? 2 : nh; const bf16x8 bc = *(const LAS bf16x8*)(CSc + (16 * vt + li) * ML_RS + (32 * ks + 8 * g) * 2); nC[x] = __builtin_amdgcn_mfma_f32_16x16x32_bf16(aq, bc, nC[x], 0, 0, 0); }
            }
            const f32x4 resc = *(const LAS f32x4*)(sc + 16 * mt + 4 * g), inter = *(const LAS f32x4*)(sc + 64 + 16 * mt + 4 * g), emj = *(const LAS f32x4*)(sc + 128 + 16 * mt + 4 * g), dns = *(const LAS f32x4*)(sc + 256 + 16 * mt + 4 * g);
#pragma unroll
            for (int r = 0; r < 4; ++r) {
                const float denC = __shfl(nC[1][r], lane & 48);
                const float den = resc[r] * dns[r] + inter[r] * denC;
                hv[r] = (resc[r] * bf2f(nsCur[r]) + inter[r] * nC[0][r]) * __builtin_amdgcn_rcpf(fmaxf(fabsf(den), emj[r]));
            }
        }
        if (!(pflags & 1024u)) {
            const float decay = sc[320];
            bf16x8 bkT[2];
#pragma unroll
            for (int ks = 0; ks < 2; ++ks) bkT[ks] = tr8(B + ML_KS + (32 * ks + 8 * g + q4) * ML_RS + 32 * w + 8 * p4, 4 * ML_RS);
#pragma unroll
            for (int vt = 0; vt < 3; ++vt) {
                accC[vt] = accC[vt] * decay;
#pragma unroll
                for (int ks = 0; ks < 2; ++ks) { const bf16x8 av = tr8(B + ML_VW + (32 * ks + 8 * g + q4) * ML_VRS + 32 * vt + 8 * p4, 4 * ML_VRS); accC[vt] = __builtin_amdgcn_mfma_f32_16x16x32_bf16(av, bkT[ks], accC[vt], 0, 0, 0); }
            }
            LAS unsigned char* CSn = L3 + ML_CS + nxt * ML_CSB;
#pragma unroll
            for (int vt = 0; vt < 3; ++vt)
#pragma unroll
                for (int r = 0; r < 4; ++r) *(LAS bf16_t*)(CSn + (16 * vt + 4 * g + r) * ML_RS + (16 * w + li) * 2) = (bf16_t)f2bf(accC[vt][r]);
        }
        if (w == 0 && c + 2 < NCHUNK) scalars((c + 2) % 3);
        if (c + 1 < NCHUNK && !(pflags & 2048u)) write_stage(nxt, (c + 1) % 3);
        if (c >= LC / 64 && !(pflags & 512u)) {
            unsigned char* hb = Hb + (size_t)rlow(c) * (RW * 2);
#pragma unroll
            for (int r = 0; r < 4; ++r) st_b16(hb + offNS[r], f2bf(hv[r]));
        }
        if (c + 2 < NCHUNK) { load_chunk(c + 2); load_ns(c + 2, nsCur); }
        if (c + 3 < NCHUNK) load_gates(c + 3);
        __syncthreads();
    };
    for (int c = 0; c < NCHUNK; c += 2) { mstep(c, nsA); mstep(c + 1, nsB); }
}
template <bool ATR, bool BTR>
__device__ __forceinline__ void mm_tiles(const LAS unsigned char* A, int a_rs, const LAS unsigned char* Bm, int b_rs, int ksteps, f32x4 (&acc)[2], int mt, int nt0, int g, int li) {
    const int q4 = li >> 2, p4 = li & 3;
    for (int ks = 0; ks < ksteps; ++ks) {
        const bf16x8 a = ATR ? tr8(A + (32 * ks + 8 * g + q4) * a_rs + 32 * mt + 8 * p4, 4 * a_rs) : *(const LAS bf16x8*)(A + (16 * mt + li) * a_rs + (32 * ks + 8 * g) * 2);
#pragma unroll
        for (int n = 0; n < 2; ++n) {
            const bf16x8 b = BTR ? tr8(Bm + (32 * ks + 8 * g + q4) * b_rs + 32 * (nt0 + n) + 8 * p4, 4 * b_rs) : *(const LAS bf16x8*)(Bm + (16 * (nt0 + n) + li) * b_rs + (32 * ks + 8 * g) * 2);
            acc[n] = __builtin_amdgcn_mfma_f32_16x16x32_bf16(a, b, acc[n], 0, 0, 0);
        }
    }
}
constexpr int R1_TLW = 0, R1_LA = 9216, R1_SG = 18432, R1_FW = 39936, R1_FA = 57344;
constexpr int R1_AK = 0, R1_ABO = 9216, R1_BK = 18432, R1_BB = 27648, R1_ABF = 36864, R1_AKV = 40960, R1_TINV = 50176, R1_LP = 54272;
constexpr int R1_WT = 74752, R1_ELC = R1_WT + 2048, R1_KAP = 77056, R1_KT = 86272, R1_BT = 95488, R1_RHO = 104704, R1_VV = 113920, R1_XB = 123136, R1_END = 140544;
constexpr int R1_PAR = R1_END;
constexpr int R1_RS = 144, R1_SGRS = 336, R1_FRS = 272, R1_RHRS = 528, R1_XRS = 272;
constexpr int NTASK_R1 = 64 * NCHUNK;
constexpr int CH_M = 0, CH_G = 8192, CH_N = 16384, CH_E = 24576, CH_REC = 24832;
__device__ __forceinline__ int afrag_off(int row, int k) { return ((((row >> 4) * 2 + (k >> 5)) * 64 + ((k >> 3) & 3) * 16 + (row & 15)) * 8 + (k & 7)) * 2; }

__device__ __forceinline__ float fsig(float x) { return __builtin_amdgcn_rcpf(1.f + __expf(-x)); }
__device__ __forceinline__ float ftanh(float x) { return 1.f - 2.f * __builtin_amdgcn_rcpf(1.f + __expf(2.f * x)); }
__device__ __forceinline__ u32x4 map8_tanh(const u32x4 v) { u32x4 o; o.x = pk2(ftanh(bflo(v.x)), ftanh(bfhi(v.x))); o.y = pk2(ftanh(bflo(v.y)), ftanh(bfhi(v.y))); o.z = pk2(ftanh(bflo(v.z)), ftanh(bfhi(v.z))); o.w = pk2(ftanh(bflo(v.w)), ftanh(bfhi(v.w))); return o; }
__device__ __forceinline__ u32x4 map8_sig(const u32x4 v) { u32x4 o; o.x = pk2(fsig(bflo(v.x)), fsig(bfhi(v.x))); o.y = pk2(fsig(bflo(v.y)), fsig(bfhi(v.y))); o.z = pk2(fsig(bflo(v.z)), fsig(bfhi(v.z))); o.w = pk2(fsig(bflo(v.w)), fsig(bfhi(v.w))); return o; }
__device__ __forceinline__ u32x4 pack8(const float (&x)[8]) { u32x4 o; o.x = pk2(x[0], x[1]); o.y = pk2(x[2], x[3]); o.z = pk2(x[4], x[5]); o.w = pk2(x[6], x[7]); return o; }

__device__ __forceinline__ void phase_r1(const P& p, LAS unsigned char* L3, int bid, int nb, unsigned pflags) {
    int tid_ = threadIdx.x; asm volatile("" : "+v"(tid_));
    const int tid = tid_, lane = tid & 63, w = __builtin_amdgcn_readfirstlane(tid >> 6);
#define R1_LANES int lz_ = tid; asm volatile("" : "+v"(lz_)); const int g = (lz_ >> 4) & 3, li = lz_ & 15, q4 = li >> 2, p4 = li & 3, t = lz_ >> 3, c8 = (lz_ & 7) * 8; (void)g; (void)li; (void)q4; (void)p4; (void)t; (void)c8;
    const int mt = w >> 1, nt0 = 2 * (w & 1);
    const bf16_t* PROJ = (const bf16_t*)(p.ws + WS_PROJ);
    const bf16_t* WUPT = (const bf16_t*)(p.ws + WS_WUPT); const bf16_t* AUPT = (const bf16_t*)(p.ws + WS_AUPT); const bf16_t* GUPT = (const bf16_t*)(p.ws + WS_GUPT);
    bf16_t* GG = (bf16_t*)(p.ws + WS_GG);
    if (bid >= NTASK_R1) return;
    const int stream = bid & 63, dir = stream >> 5, b = (stream >> 4) & 1, h = stream & 15;
    float* BON = (float*)(p.ws + (dir ? WS_BONUS_B : WS_BONUS));
    bf16_t* Yo = (bf16_t*)(p.ws + (dir ? WS_YB : WS_YF));
    bf16x8 wfr[2][2], afr[2][2];
    {
        R1_LANES
#pragma unroll
        for (int ks = 0; ks < 2; ++ks)
#pragma unroll
            for (int n = 0; n < 2; ++n) { const size_t wo = ((size_t)(dir * 1024 + 64 * h + 16 * (nt0 + n) + li) * 64 + 32 * ks + 8 * g); wfr[ks][n] = *(const bf16x8*)(WUPT + wo); afr[ks][n] = *(const bf16x8*)(AUPT + wo); }
    }
    if (tid < 64) {
        const int ch = 64 * h + tid; LAS float* pp = (LAS float*)(L3 + R1_PAR);
        pp[tid] = p.r_w0[dir * RW + ch]; pp[64 + tid] = p.r_a0[dir * RW + ch]; pp[128 + tid] = p.r_k_k[ch]; pp[192 + tid] = p.r_k_a[ch]; pp[256 + tid] = p.r_r_k[ch];
    }
    struct Ld { u32x4 rr, kr, vr, lw, la, lg[3]; int row; };
    auto load_task = [&](int task, Ld& X) {
        int lz0_ = tid; asm volatile("" : "+v"(lz0_)); const int t0 = lz0_ >> 3, c80 = (lz0_ & 7) * 8;
        X.row = step_row(64 * (task >> 6) + t0, b, dir);
        const bf16_t* pr = PROJ + (size_t)X.row * LDP;
        X.rr = *(const u32x4*)(pr + C_R + 64 * h + c80); X.kr = *(const u32x4*)(pr + C_KR + 64 * h + c80); X.vr = *(const u32x4*)(pr + C_VR + 64 * h + c80);
        X.lw = *(const u32x4*)(pr + C_LW + 64 * dir + c80); X.la = *(const u32x4*)(pr + C_LA + 64 * dir + c80);
        if (dir == 0 && (task >> 6) >= LC / 64) {
#pragma unroll
            for (int i = 0; i < 3; ++i) { const int pc = lz0_ + 512 * i; if (pc < 64 * 20) { const int tt = pc / 20, q = pc % 20; X.lg[i] = *(const u32x4*)(PROJ + (size_t)step_row(64 * (task >> 6) + tt, b, dir) * LDP + C_LG + q * 8); } }
        }
    };
    Ld cur; load_task(bid, cur);
    for (int task = bid; task < NTASK_R1; task += nb) {
        const int c = task >> 6;
        const bool lat = c >= LC / 64, do_g = lat && dir == 0;
        unsigned char* rec = p.ws + WS_CHD + (size_t)(stream * NCHUNK + c) * CH_REC;
        const u32x4 rr = cur.rr, kr = cur.kr, vr = cur.vr; const int row = cur.row;
        bf16x8 gb[5][2];
        if (do_g) {
            R1_LANES
#pragma unroll
            for (int ks = 0; ks < 5; ++ks)
#pragma unroll
                for (int n = 0; n < 2; ++n) gb[ks][n] = *(const bf16x8*)(GUPT + (size_t)(64 * h + 16 * (nt0 + n) + li) * 160 + 32 * ks + 8 * g);
        }
        {
            R1_LANES
            *(LAS u32x4*)(L3 + R1_TLW + t * R1_RS + c8 * 2) = map8_tanh(cur.lw);
            *(LAS u32x4*)(L3 + R1_LA + t * R1_RS + c8 * 2) = cur.la;
            if (do_g) {
#pragma unroll
                for (int i = 0; i < 3; ++i) { const int pc = lz_ + 512 * i; if (pc < 64 * 20) { const int tt = pc / 20, q = pc % 20; *(LAS u32x4*)(L3 + R1_SG + tt * R1_SGRS + q * 16) = map8_sig(cur.lg[i]); } }
            }
        }
        __syncthreads();
        {
            R1_LANES
            f32x4 aw[2], aa[2];
#pragma unroll
            for (int n = 0; n < 2; ++n) { aw[n] = (f32x4){0.f, 0.f, 0.f, 0.f}; aa[n] = (f32x4){0.f, 0.f, 0.f, 0.f}; }
#pragma unroll
            for (int ks = 0; ks < 2; ++ks) {
                const bf16x8 a1 = *(const LAS bf16x8*)(L3 + R1_TLW + (16 * mt + li) * R1_RS + (32 * ks + 8 * g) * 2);
                const bf16x8 a2 = *(const LAS bf16x8*)(L3 + R1_LA + (16 * mt + li) * R1_RS + (32 * ks + 8 * g) * 2);
#pragma unroll
                for (int n = 0; n < 2; ++n) { aw[n] = __builtin_amdgcn_mfma_f32_16x16x32_bf16(a1, wfr[ks][n], aw[n], 0, 0, 0); aa[n] = __builtin_amdgcn_mfma_f32_16x16x32_bf16(a2, afr[ks][n], aa[n], 0, 0, 0); }
            }
#pragma unroll
            for (int n = 0; n < 2; ++n)
#pragma unroll
                for (int r = 0; r < 4; ++r) {
                    *(LAS float*)(L3 + R1_FW + (16 * mt + 4 * g + r) * R1_FRS + (16 * (nt0 + n) + li) * 4) = aw[n][r];
                    *(LAS float*)(L3 + R1_FA + (16 * mt + 4 * g + r) * R1_FRS + (16 * (nt0 + n) + li) * 4) = aa[n][r];
                }
            if (do_g) {
                f32x4 ag[2] = {(f32x4){0.f, 0.f, 0.f, 0.f}, (f32x4){0.f, 0.f, 0.f, 0.f}};
#pragma unroll
                for (int ks = 0; ks < 5; ++ks) {
                    const bf16x8 a3 = *(const LAS bf16x8*)(L3 + R1_SG + (16 * mt + li) * R1_SGRS + (32 * ks + 8 * g) * 2);
#pragma unroll
                    for (int n = 0; n < 2; ++n) ag[n] = __builtin_amdgcn_mfma_f32_16x16x32_bf16(a3, gb[ks][n], ag[n], 0, 0, 0);
                }
#pragma unroll
                for (int n = 0; n < 2; ++n)
#pragma unroll
                    for (int r = 0; r < 4; ++r) *(LAS bf16_t*)(L3 + R1_XB + (16 * mt + 4 * g + r) * R1_RS + (16 * (nt0 + n) + li) * 2) = (bf16_t)f2bf(ag[n][r]);
            }
        }
        __syncthreads();
        {
            float kap[8];
            R1_LANES
            const int ch = 64 * h + c8;
            if (do_g) st_b128(GG + (size_t)row * RW + ch, *(const LAS u32x4*)(L3 + R1_XB + t * R1_RS + c8 * 2));
            float fw[8], fa[8], w0[8], a0[8], rkk[8], rka[8], rrk[8];
            *(f32x4*)&fw[0] = *(const LAS f32x4*)(L3 + R1_FW + t * R1_FRS + c8 * 4); *(f32x4*)&fw[4] = *(const LAS f32x4*)(L3 + R1_FW + t * R1_FRS + c8 * 4 + 16);
            *(f32x4*)&fa[0] = *(const LAS f32x4*)(L3 + R1_FA + t * R1_FRS + c8 * 4); *(f32x4*)&fa[4] = *(const LAS f32x4*)(L3 + R1_FA + t * R1_FRS + c8 * 4 + 16);
#pragma unroll
            for (int i = 0; i < 2; ++i) {
                *(f32x4*)&w0[4 * i] = *(const LAS f32x4*)(L3 + R1_PAR + (c8 + 4 * i) * 4); *(f32x4*)&a0[4 * i] = *(const LAS f32x4*)(L3 + R1_PAR + (64 + c8 + 4 * i) * 4);
                *(f32x4*)&rkk[4 * i] = *(const LAS f32x4*)(L3 + R1_PAR + (128 + c8 + 4 * i) * 4); *(f32x4*)&rka[4 * i] = *(const LAS f32x4*)(L3 + R1_PAR + (192 + c8 + 4 * i) * 4); *(f32x4*)&rrk[4 * i] = *(const LAS f32x4*)(L3 + R1_PAR + (256 + c8 + 4 * i) * 4);
            }
            float krf[8], rf[8]; unpack8(kr, krf); unpack8(rr, rf);
            float wl[8], av[8], kkv[8], lam[8]; float ss = 0.f, bs = 0.f;
#pragma unroll
            for (int i = 0; i < 8; ++i) {
                wl[i] = -0.6065306597126334f * fsig(w0[i] + fw[i]);
                av[i] = fsig(a0[i] + fa[i]);
                kkv[i] = krf[i] * rkk[i]; ss += kkv[i] * kkv[i];
                bs += rf[i] * krf[i] * rrk[i] * (1.f - rka[i] + rka[i] * av[i]);
                lam[i] = wl[i];
            }
            ss += __shfl_xor(ss, 1); ss += __shfl_xor(ss, 2); ss += __shfl_xor(ss, 4);
            bs += __shfl_xor(bs, 1); bs += __shfl_xor(bs, 2); bs += __shfl_xor(bs, 4);
            const float rn = rsqrtf(ss + 1e-12f);
            if ((tid & 7) == 0) st_b32(BON + (size_t)row * 16 + h, bs);
#pragma unroll
            for (int o = 8; o < 64; o <<= 1)
#pragma unroll
                for (int i = 0; i < 8; ++i) { const float tv = __shfl_up(lam[i], o); if (lane >= o) lam[i] += tv; }
            if ((lane >> 3) == 7) { *(LAS f32x4*)(L3 + R1_WT + w * 256 + c8 * 4) = *(f32x4*)&lam[0]; *(LAS f32x4*)(L3 + R1_WT + w * 256 + c8 * 4 + 16) = *(f32x4*)&lam[4]; }
            __syncthreads();
            float lc[8];
#pragma unroll
            for (int i = 0; i < 8; ++i) lc[i] = 0.f;
#pragma unroll
            for (int ww = 0; ww < 8; ++ww) {
                float tv[8]; *(f32x4*)&tv[0] = *(const LAS f32x4*)(L3 + R1_WT + ww * 256 + c8 * 4); *(f32x4*)&tv[4] = *(const LAS f32x4*)(L3 + R1_WT + ww * 256 + c8 * 4 + 16);
#pragma unroll
                for (int i = 0; i < 8; ++i) { lc[i] += tv[i]; if (ww < w) lam[i] += tv[i]; }
            }
            float kt8[8], bt8[8], rho8[8];
#pragma unroll
            for (int i = 0; i < 8; ++i) {
                const float e_cur = __expf(lam[i]), e_prev = e_cur * __expf(-wl[i]), e_inv = __expf(-lam[i]);
                const float kk = kkv[i] * rn, kd = krf[i] * (1.f + (av[i] - 1.f) * rka[i]);
                kap[i] = kk * e_prev; rho8[i] = rf[i] * e_cur; kt8[i] = kd * e_inv; bt8[i] = kk * av[i] * e_inv;
            }
            *(LAS u32x4*)(L3 + R1_KAP + t * R1_RS + c8 * 2) = pack8(kap);
            *(LAS u32x4*)(L3 + R1_KT + t * R1_RS + c8 * 2) = pack8(kt8);
            *(LAS u32x4*)(L3 + R1_BT + t * R1_RS + c8 * 2) = pack8(bt8);
            *(LAS u32x4*)(L3 + R1_RHO + t * R1_RS + c8 * 2) = pack8(rho8);
            *(LAS u32x4*)(L3 + R1_VV + t * R1_RS + c8 * 2) = vr;
            if (t == 63) {
                f32x4 e0, e1; e0.x = __expf(lc[0]); e0.y = __expf(lc[1]); e0.z = __expf(lc[2]); e0.w = __expf(lc[3]); e1.x = __expf(lc[4]); e1.y = __expf(lc[5]); e1.z = __expf(lc[6]); e1.w = __expf(lc[7]);
                *(LAS f32x4*)(L3 + R1_ELC + c8 * 4) = e0; *(LAS f32x4*)(L3 + R1_ELC + c8 * 4 + 16) = e1;
                st_f128(rec + CH_E + c8 * 4, e0); st_f128(rec + CH_E + c8 * 4 + 16, e1);
            }
        }
        if (task + nb < NTASK_R1) load_task(task + nb, cur);
        __syncthreads();
        if (pflags & 32u) continue;
        {
            R1_LANES
            for (int i = tid; i < 64 * R1_XRS / 16; i += 512) *(LAS u32x4*)(L3 + R1_XB + i * 16) = (u32x4){0u, 0u, 0u, 0u};
            for (int i = tid; i < (4096 + 9216) / 16; i += 512) *(LAS u32x4*)(L3 + R1_TINV + i * 16) = (u32x4){0u, 0u, 0u, 0u};
            f32x4 ak[2], ab[2], bk[2], bb[2];
#pragma unroll
            for (int n = 0; n < 2; ++n) { ak[n] = (f32x4){0.f, 0.f, 0.f, 0.f}; ab[n] = ak[n]; bk[n] = ak[n]; bb[n] = ak[n]; }
            if (nt0 <= mt) {
                mm_tiles<false, false>(L3 + R1_KAP, R1_RS, L3 + R1_KT, R1_RS, 2, ak, mt, nt0, g, li);
                mm_tiles<false, false>(L3 + R1_KAP, R1_RS, L3 + R1_BT, R1_RS, 2, ab, mt, nt0, g, li);
                mm_tiles<false, false>(L3 + R1_RHO, R1_RS, L3 + R1_KT, R1_RS, 2, bk, mt, nt0, g, li);
                mm_tiles<false, false>(L3 + R1_RHO, R1_RS, L3 + R1_BT, R1_RS, 2, bb, mt, nt0, g, li);
            }
#pragma unroll
            for (int n = 0; n < 2; ++n)
#pragma unroll
                for (int r = 0; r < 4; ++r) {
                    const int tt = 16 * mt + 4 * g + r, ii = 16 * (nt0 + n) + li; const bool sl = ii < tt, le = ii <= tt, dg = (nt0 + n) == mt;
                    const int o = tt * R1_RS + ii * 2;
                    *(LAS bf16_t*)(L3 + R1_AK + o) = (bf16_t)f2bf(sl ? ak[n][r] : 0.f);
                    *(LAS bf16_t*)(L3 + R1_ABO + o) = (bf16_t)f2bf((sl && !dg) ? ab[n][r] : 0.f);
                    *(LAS bf16_t*)(L3 + R1_BK + o) = (bf16_t)f2bf(le ? bk[n][r] : 0.f);
                    *(LAS bf16_t*)(L3 + R1_BB + o) = (bf16_t)f2bf(le ? bb[n][r] : 0.f);
                    if (dg) *(LAS float*)(L3 + R1_ABF + (mt * 256 + (4 * g + r) * 16 + li) * 4) = sl ? ab[n][r] : 0.f;
                }
        }
        __syncthreads();
        f32x4 y0a[2], na[2];
        {
            R1_LANES
            f32x4 akv[2];
#pragma unroll
            for (int n = 0; n < 2; ++n) { akv[n] = (f32x4){0.f, 0.f, 0.f, 0.f}; y0a[n] = akv[n]; na[n] = akv[n]; }
            mm_tiles<false, true>(L3 + R1_AK, R1_RS, L3 + R1_VV, R1_RS, 2, akv, mt, nt0, g, li);
            mm_tiles<false, true>(L3 + R1_BK, R1_RS, L3 + R1_VV, R1_RS, 2, y0a, mt, nt0, g, li);
            mm_tiles<true, true>(L3 + R1_KT, R1_RS, L3 + R1_VV, R1_RS, 2, na, mt, nt0, g, li);
#pragma unroll
            for (int n = 0; n < 2; ++n)
#pragma unroll
                for (int r = 0; r < 4; ++r) *(LAS bf16_t*)(L3 + R1_AKV + (16 * mt + 4 * g + r) * R1_RS + (16 * (nt0 + n) + li) * 2) = (bf16_t)f2bf(akv[n][r]);
            if (w == 0) {
                const int blk = lz_ >> 4, col = lz_ & 15;
                float tv[16];
#pragma unroll
                for (int i = 0; i < 16; ++i) tv[i] = (i == col) ? 1.f : 0.f;
#pragma unroll
                for (int i = 1; i < 16; ++i) {
                    const LAS float* lrow = (const LAS float*)(L3 + R1_ABF + (blk * 256 + i * 16) * 4);
                    float lv[16];
#pragma unroll
                    for (int j4 = 0; j4 < (i + 3) / 4; ++j4) *(f32x4*)&lv[4 * j4] = *(const LAS f32x4*)(lrow + 4 * j4);
#pragma unroll
                    for (int j = 0; j < i; ++j) tv[i] -= lv[j] * tv[j];
                    asm volatile("" ::: "memory");
                }
#pragma unroll
                for (int i = 0; i < 16; ++i) *(LAS bf16_t*)(L3 + R1_TINV + ((blk * 16 + i) * 32 + col) * 2) = (bf16_t)f2bf(tv[i]);
            }
        }
        __syncthreads();
        {
            R1_LANES
            const int g1 = g & 1;
            const LAS unsigned char* Rsrc = (w < 4) ? (L3 + R1_KAP + 32 * w) : (L3 + R1_AKV + 32 * (w - 4));
            f32x4 xr[4];
#pragma unroll
            for (int bi = 0; bi < 4; ++bi) {
                const bf16x8 ta = *(const LAS bf16x8*)(L3 + R1_TINV + ((bi * 16 + li) * 32 + 8 * g) * 2);
                const bf16x8 rb = tr8(Rsrc + (16 * bi + 8 * g1 + q4) * R1_RS + 8 * p4, 4 * R1_RS);
                xr[bi] = __builtin_amdgcn_mfma_f32_16x16x32_bf16(ta, rb, (f32x4){0.f, 0.f, 0.f, 0.f}, 0, 0, 0);
            }
            if (w < 6) {
                const int bi = w < 1 ? 1 : (w < 3 ? 2 : 3), bj = w < 1 ? 0 : (w < 3 ? w - 1 : w - 3);
                const bf16x8 ta = *(const LAS bf16x8*)(L3 + R1_TINV + ((bi * 16 + li) * 32 + 8 * g) * 2);
                const bf16x8 lb = tr8(L3 + R1_ABO + (16 * bi + 8 * g1 + q4) * R1_RS + 32 * bj + 8 * p4, 4 * R1_RS);
                const f32x4 lp = __builtin_amdgcn_mfma_f32_16x16x32_bf16(ta, lb, (f32x4){0.f, 0.f, 0.f, 0.f}, 0, 0, 0);
#pragma unroll
                for (int r = 0; r < 4; ++r) *(LAS bf16_t*)(L3 + R1_LP + (16 * bi + 4 * g + r) * R1_RS + (16 * bj + li) * 2) = (bf16_t)f2bf(lp[r]);
            }
            __syncthreads();
#pragma unroll
            for (int bi = 0; bi < 4; ++bi) {
                if (bi > 0) {
                    f32x4 acc = (f32x4){0.f, 0.f, 0.f, 0.f};
#pragma unroll
                    for (int ks = 0; ks < (bi + 1) / 2; ++ks) {
                        const bf16x8 a = *(const LAS bf16x8*)(L3 + R1_LP + (16 * bi + li) * R1_RS + (32 * ks + 8 * g) * 2);
                        const bf16x8 bx = tr8(L3 + R1_XB + (32 * ks + 8 * g + q4) * R1_XRS + 32 * w + 8 * p4, 4 * R1_XRS);
                        acc = __builtin_amdgcn_mfma_f32_16x16x32_bf16(a, bx, acc, 0, 0, 0);
                    }
                    xr[bi] = xr[bi] - acc;
                }
#pragma unroll
                for (int r = 0; r < 4; ++r) *(LAS bf16_t*)(L3 + R1_XB + (16 * bi + 4 * g + r) * R1_XRS + (16 * w + li) * 2) = (bf16_t)f2bf(xr[bi][r]);
                asm volatile("s_waitcnt lgkmcnt(0)" ::: "memory");
            }
        }
        __syncthreads();
        {
            R1_LANES
            f32x4 gx[2], yx[2], mx[2], nx[2];
#pragma unroll
            for (int n = 0; n < 2; ++n) { gx[n] = (f32x4){0.f, 0.f, 0.f, 0.f}; yx[n] = gx[n]; mx[n] = gx[n]; nx[n] = gx[n]; }
            mm_tiles<false, true>(L3 + R1_BB, R1_RS, L3 + R1_XB, R1_XRS, 2, gx, mt, nt0, g, li);
            mm_tiles<false, true>(L3 + R1_BB, R1_RS, L3 + R1_XB + 128, R1_XRS, 2, yx, mt, nt0, g, li);
            mm_tiles<true, true>(L3 + R1_BT, R1_RS, L3 + R1_XB, R1_XRS, 2, mx, mt, nt0, g, li);
            mm_tiles<true, true>(L3 + R1_BT, R1_RS, L3 + R1_XB + 128, R1_XRS, 2, nx, mt, nt0, g, li);
            const f32x4 elc = *(const LAS f32x4*)(L3 + R1_ELC + (16 * mt + 4 * g) * 4);
#pragma unroll
            for (int n = 0; n < 2; ++n) {
                const int col = 16 * (nt0 + n) + li;
                float nv[4];
#pragma unroll
                for (int r = 0; r < 4; ++r) {
                    const int rw = 16 * mt + 4 * g + r, o = rw * R1_RS + col * 2;
                    const float rho = bf2f(*(const LAS bf16_t*)(L3 + R1_RHO + o));
                    *(LAS bf16_t*)(L3 + R1_AK + o) = (bf16_t)f2bf(rho - gx[n][r]);
                    *(LAS bf16_t*)(L3 + R1_ABO + o) = (bf16_t)f2bf(-elc[r] * mx[n][r]);
                    *(LAS bf16_t*)(L3 + R1_BK + o) = (bf16_t)f2bf(y0a[n][r] - yx[n][r]);
                    nv[r] = elc[r] * (na[n][r] - nx[n][r]);
                }
                u32x2 nf; nf.x = pk2(nv[0], nv[1]); nf.y = pk2(nv[2], nv[3]);
                st_b64(rec + CH_N + ((mt * 4 + nt0 + n) * 64 + lane) * 8, nf);
            }
        }
        __syncthreads();
        {
            R1_LANES
            const int fo = (16 * (w >> 1) + li) * R1_RS + (32 * (w & 1) + 8 * g) * 2;
            st_b128(rec + CH_G + (w * 64 + lane) * 16, *(const LAS u32x4*)(L3 + R1_AK + fo));
            st_b128(rec + CH_M + (w * 64 + lane) * 16, *(const LAS u32x4*)(L3 + R1_ABO + fo));
            if (lat) st_b128(Yo + (size_t)row * RW + 64 * h + c8, *(const LAS u32x4*)(L3 + R1_BK + t * R1_RS + c8 * 2));
        }
        __syncthreads();
    }
#undef R1_LANES
}

constexpr int R2_SB = 0, R2_SRS = 80, R2_SBB = 64 * R2_SRS;
struct R2Regs { bf16x8 am[2], ag[2]; u32x2 nf; f32x4 el; bf16_t y0[4]; };
__device__ __forceinline__ void phase_r2(const P& p, LAS unsigned char* L3, int task, unsigned pflags) {
    int tid_ = threadIdx.x; asm volatile("" : "+v"(tid_));
    const int tid = tid_, lane = tid & 63, w = __builtin_amdgcn_readfirstlane(tid >> 6), g = lane >> 4, li = lane & 15, q4 = li >> 2, p4 = li & 3;
    const int stream = task >> 1, vh = task & 1, dir = stream >> 5, b = (stream >> 4) & 1, h = stream & 15;
    const int kt = w >> 1, vt = w & 1, vtg = 2 * vh + vt;
    bf16_t* Yo = (bf16_t*)(p.ws + (dir ? WS_YB : WS_YF));
    const unsigned char* rec0 = p.ws + WS_CHD + (size_t)stream * NCHUNK * CH_REC;
    auto rlow = [&](int c) -> int { const int r0 = step_row(64 * c, b, dir); return dir ? r0 - 63 : r0; };
    unsigned offY[4];
#pragma unroll
    for (int r = 0; r < 4; ++r) { const int j = 16 * kt + 4 * g + r; offY[r] = (unsigned)((dir ? 63 - j : j) * (RW * 2) + (16 * vtg + li) * 2); }
    unsigned char* Yb = (unsigned char*)Yo + 64 * h * 2;
    const unsigned offA0 = (unsigned)(((kt * 2 + 0) * 64 + lane) * 16), offA1 = (unsigned)(((kt * 2 + 1) * 64 + lane) * 16), offN = (unsigned)(CH_N + ((kt * 4 + vtg) * 64 + lane) * 8), offE = (unsigned)(CH_E + (16 * kt + 4 * g) * 4);
    auto loadstep = [&](int c, R2Regs& R) {
        if (pflags & 128u) return;
        const unsigned char* rec = rec0 + (size_t)c * CH_REC;
        R.am[0] = *(const bf16x8*)(rec + CH_M + offA0); R.am[1] = *(const bf16x8*)(rec + CH_M + offA1); R.ag[0] = *(const bf16x8*)(rec + CH_G + offA0); R.ag[1] = *(const bf16x8*)(rec + CH_G + offA1);
        R.nf = *(const u32x2*)(rec + offN);
        R.el = *(const f32x4*)(rec + offE);
        if (c >= LC / 64) {
            const unsigned char* yb = Yb + (size_t)rlow(c) * (RW * 2);
#pragma unroll
            for (int r = 0; r < 4; ++r) R.y0[r] = *(const bf16_t*)(yb + offY[r]);
        }
    };
    f32x4 S = (f32x4){0.f, 0.f, 0.f, 0.f};
    auto step = [&](int c, const R2Regs& R) {
        LAS unsigned char* SB = L3 + R2_SB + (c & 1) * R2_SBB;
        bf16x8 bs[2] = {(bf16x8){0, 0, 0, 0, 0, 0, 0, 0}, (bf16x8){0, 0, 0, 0, 0, 0, 0, 0}};
        if (!(pflags & 256u)) {
#pragma unroll
        for (int r = 0; r < 4; ++r) *(LAS bf16_t*)(SB + (16 * kt + 4 * g + r) * R2_SRS + (16 * vt + li) * 2) = (bf16_t)f2bf(S[r]);
        __syncthreads();
#pragma unroll
        for (int ks = 0; ks < 2; ++ks) bs[ks] = tr8(SB + (32 * ks + 8 * g + q4) * R2_SRS + 32 * vt + 8 * p4, 4 * R2_SRS);
        }
        f32x4 ns; ns[0] = R.el[0] * S[0] + bflo(R.nf.x); ns[1] = R.el[1] * S[1] + bfhi(R.nf.x); ns[2] = R.el[2] * S[2] + bflo(R.nf.y); ns[3] = R.el[3] * S[3] + bfhi(R.nf.y);
        f32x4 ya = (f32x4){0.f, 0.f, 0.f, 0.f};
        const bool lat = c >= LC / 64;
        if (lat) { ya[0] = bf2f(R.y0[0]); ya[1] = bf2f(R.y0[1]); ya[2] = bf2f(R.y0[2]); ya[3] = bf2f(R.y0[3]); }
#pragma unroll
        for (int ks = 0; ks < 2; ++ks) { ns = __builtin_amdgcn_mfma_f32_16x16x32_bf16(R.am[ks], bs[ks], ns, 0, 0, 0); ya = __builtin_amdgcn_mfma_f32_16x16x32_bf16(R.ag[ks], bs[ks], ya, 0, 0, 0); }
        if (lat) {
            unsigned char* yb = Yb + (size_t)rlow(c) * (RW * 2);
#pragma unroll
            for (int r = 0; r < 4; ++r) st_b16(yb + offY[r], f2bf(ya[r]));
        }
        S = ns;
    };
    R2Regs Q0, Q1, Q2, Q3, Q4, Q5;
    loadstep(0, Q0); loadstep(1, Q1); loadstep(2, Q2); loadstep(3, Q3); loadstep(4, Q4);
#define R2_STEP(k, QL, QS) { if (c + (k) + 5 < NCHUNK) loadstep(c + (k) + 5, QL); if (c + (k) < NCHUNK) step(c + (k), QS); }
    for (int c = 0; c < NCHUNK; c += 6) {
        R2_STEP(0, Q5, Q0) R2_STEP(1, Q0, Q1) R2_STEP(2, Q1, Q2) R2_STEP(3, Q2, Q3) R2_STEP(4, Q3, Q4) R2_STEP(5, Q4, Q5)
    }
#undef R2_STEP
    __syncthreads();
}
constexpr int TR_SCR = 64 * 65 * 4;
__device__ __forceinline__ void transpose_item(const float* W, int K, int N, int Npad, bf16_t* WT, int row_off, LAS float* scr, int item, int lane) {
    const int nblk = Npad / 64, kb = item / nblk, nb = item % nblk, k0 = 64 * kb, n0 = 64 * nb;
    const int n4 = (lane & 15) * 4, kq = lane >> 4;
    f32x4 v[16];
#pragma unroll
    for (int i = 0; i < 16; ++i) v[i] = (n0 + n4 < N) ? *(const f32x4*)(W + (size_t)(k0 + 4 * i + kq) * N + n0 + n4) : (f32x4){0.f, 0.f, 0.f, 0.f};
#pragma unroll
    for (int i = 0; i < 16; ++i) { LAS float* d = scr + (4 * i + kq) * 65 + n4; d[0] = v[i].x; d[1] = v[i].y; d[2] = v[i].z; d[3] = v[i].w; }
    LDS_WAIT(); asm volatile("" ::: "memory");
    const int c = lane & 7;
#pragma unroll
    for (int j = 0; j < 8; ++j) { const int n = (lane >> 3) + 8 * j; const LAS float* s = scr + (8 * c) * 65 + n;
        v4u o; o.x = pk2(s[0 * 65], s[1 * 65]); o.y = pk2(s[2 * 65], s[3 * 65]); o.z = pk2(s[4 * 65], s[5 * 65]); o.w = pk2(s[6 * 65], s[7 * 65]);
        *(GAS v4u*)(WT + (size_t)(row_off + n0 + n) * K + k0 + 8 * c) = o; }
    LDS_WAIT(); asm volatile("" ::: "memory");
}

constexpr int RING_OFF = 0, RING_BYTES = 131072;
constexpr int LDS_BYTES = 147456;
constexpr int LDSCTL_OFF = LDS_BYTES - 512, MISC_OFF = LDSCTL_OFF + 320, PARAM_OFF = LDS_BYTES - 1024;
__device__ __forceinline__ P load_params(const LAS unsigned* src) {
    P q; void** d = (void**)&q;
#pragma unroll
    for (int i = 0; i < 32; ++i) {
        const unsigned long long v = (unsigned long long)(unsigned)__builtin_amdgcn_readfirstlane((int)src[2 * i]) | ((unsigned long long)(unsigned)__builtin_amdgcn_readfirstlane((int)src[2 * i + 1]) << 32);
        d[i] = (void*)(GAS void*)v;
    }
    q.mask = 0u; q.pad = 0u;
    return q;
}
static_assert(8 * TR_SCR <= PARAM_OFF && ML_END <= PARAM_OFF && MI_END <= PARAM_OFF && R1_PAR + 1280 <= PARAM_OFF && sizeof(P) == 264, "LDS map");
constexpr int CW_BAR = 4096;
constexpr size_t CTL_ZERO_BYTES = 1 * MiB;
constexpr int NWAVES = 8;

__global__ void __launch_bounds__(NWAVES * 64, 2) mega_fwd(P p_arg) {
    extern __shared__ __attribute__((aligned(16))) unsigned char lds[];
    LAS unsigned char* L3 = (LAS unsigned char*)lds;
    volatile LAS unsigned* MISC = (volatile LAS unsigned*)(L3 + MISC_OFF);
    const int tid = threadIdx.x, lane = tid & 63, wave = __builtin_amdgcn_readfirstlane(tid >> 6);
    const int G = gridDim.x, bx = blockIdx.x;
    const int vcu = (G % 8 == 0) ? (bx % 8) * (G / 8) + bx / 8 : bx;
    for (int u = tid; u < (LDS_BYTES - LDSCTL_OFF) / 4; u += NWAVES * 64) ((LAS unsigned*)(L3 + LDSCTL_OFF))[u] = 0u;
    const LAS unsigned* PRM = (const LAS unsigned*)(L3 + PARAM_OFF);
    if (tid < 66) ((LAS unsigned*)(L3 + PARAM_OFF))[tid] = ((const unsigned*)__builtin_amdgcn_kernarg_segment_ptr())[tid];
    __syncthreads();
    XcdBarrier bar;
    { const P p = load_params(PRM); const unsigned region = (unsigned)__builtin_amdgcn_readfirstlane((int)PRM[65]); bar = xcd_barrier_post((unsigned*)(p.ws + WS_CTL) + CW_BAR + region * XCD_BAR_WORDS, MISC + 8); }
    const int gw = vcu * NWAVES + wave, ngw = G * NWAVES;
    const unsigned pflags = (unsigned)__builtin_amdgcn_readfirstlane((int)PRM[65]);
    const unsigned pmask = (unsigned)__builtin_amdgcn_readfirstlane((int)PRM[64]);
    int ph_idx_ = 0;
#define PH_BEGIN if ((pmask >> ph_idx_) & 1u) { const P p = load_params(PRM); unsigned char* ws = p.ws; const float* MOD = (const float*)(ws + WS_MOD); (void)MOD;
#define PH_END }
#define PH_BAR if ((pmask >> ph_idx_) & 1u) xcd_barrier(bar); ++ph_idx_;

    PH_BEGIN
    phase_mod(p, bx, G, (float*)lds);
    {
        LAS float* scr = (LAS float*)(L3 + RING_OFF + wave * TR_SCR);
        constexpr int I_IN = (D / 64) * (LDP / 64), I_OUT = (D / 64) * (D / 64);
        for (int it = gw; it < I_IN + I_OUT; it += ngw) {
            if (it < I_IN) transpose_item(p.w_in, D, NIN, LDP, (bf16_t*)(ws + WS_WIN_T), 0, scr, it, lane);
            else transpose_item(p.w_out, D, D, D, (bf16_t*)(ws + WS_WOUT_T), 0, scr, it - I_IN, lane);
        }
    }
    {
        bf16_t* WUPT = (bf16_t*)(ws + WS_WUPT); bf16_t* AUPT = (bf16_t*)(ws + WS_AUPT); bf16_t* GUPT = (bf16_t*)(ws + WS_GUPT);
        const int gt = bx * (NWAVES * 64) + tid, ngt = G * NWAVES * 64;
        for (int o = gt; o < 2 * 1024 * 64; o += ngt) { const int r = o & 63, c = (o >> 6) & 1023, d = o >> 16; const size_t si = (size_t)(d * 64 + r) * RW + c; WUPT[o] = (bf16_t)f2bf(p.r_w_up[si]); AUPT[o] = (bf16_t)f2bf(p.r_a_up[si]); }
        for (int o = gt; o < 1024 * 160; o += ngt) { const int i = o % 160, c = o / 160; GUPT[o] = (bf16_t)f2bf(p.r_g_up[(size_t)i * RW + c]); }
    }
    PH_END
    PH_BAR
    PH_BEGIN
    phase_normmod(p, 0, gw, ngw, lane);
    PH_END
    PH_BAR
    PH_BEGIN
    {
        pg8::Gemm g{(const bf16_t*)(ws + WS_HX), (const bf16_t*)(ws + WS_WIN_T), NROW, LDP, D}; pg8::StaticOrder S; S.init(NROW, LDP, G, bx);
        pg8::EpiBf16<0> E{(bf16_t*)(ws + WS_PROJ), LDP, nullptr, 0, 0, 1.f};
        pg8::gemm_phase<pg8::EpiBf16<0>, pg8::StaticOrder, true, true>(L3 + RING_OFF, g, S, E);
    }
    PH_END
    PH_BAR
    PH_BEGIN
    if (!(pflags & 8u)) phase_prep(p, bx, G);
    if (!(pflags & 16u)) phase_r1(p, L3, bx, G, pflags);
    PH_END
    PH_BAR
    PH_BEGIN
    phase_mintra(p, L3, bx, G);
    PH_END
    PH_BAR
    PH_BEGIN
    if (bx < 128) { if (!(pflags & 2u)) phase_mlstm(p, L3, bx, pflags); } else if (bx < 256) { if (!(pflags & 4u)) phase_r2(p, L3, bx - 128, pflags); }
    PH_END
    PH_BAR
    PH_BEGIN
    phase_post(p, gw, ngw, lane);
    PH_END
    PH_BAR
    PH_BEGIN
    {
        pg8::Gemm g{(const bf16_t*)(ws + WS_MIX), (const bf16_t*)(ws + WS_WOUT_T), NTOK, D, D}; pg8::StaticOrder S; S.init(NTOK, D, G, bx);
        pg8::EpiResid E{p.x, p.out, D, MOD + 2 * 2048, NMOD};
        pg8::gemm_phase<pg8::EpiResid, pg8::StaticOrder, true, true>(L3 + RING_OFF, g, S, E);
    }
    PH_END
    PH_BAR
    PH_BEGIN
    phase_normmod(p, 1, gw, ngw, lane);
    {
        LAS float* scr = (LAS float*)(L3 + RING_OFF + wave * TR_SCR);
        constexpr int I_UP = (D / 64) * (FF / 64), I_DN = (FF / 64) * (D / 64);
        for (int it = gw; it < 2 * I_UP + I_DN; it += ngw) {
            if (it < I_UP) transpose_item(p.f_w_up, D, FF, FF, (bf16_t*)(ws + WS_WUG_T), 0, scr, it, lane);
            else if (it < 2 * I_UP) transpose_item(p.f_w_gate, D, FF, FF, (bf16_t*)(ws + WS_WUG_T), FF, scr, it - I_UP, lane);
            else transpose_item(p.f_w_down, FF, D, D, (bf16_t*)(ws + WS_WDN_T), 0, scr, it - 2 * I_UP, lane);
        }
    }
    PH_END
    PH_BAR
    PH_BEGIN
    {
        pg8::Gemm g{(const bf16_t*)(ws + WS_HX2), (const bf16_t*)(ws + WS_WUG_T), NTOK, 2 * FF, D}; pg8::StaticOrder S; S.init(NTOK, 2 * FF, G, bx);
        pg8::EpiBf16<0> E{(bf16_t*)(ws + WS_UG), 2 * FF, nullptr, 0, 0, 1.f};
        pg8::gemm_phase<pg8::EpiBf16<0>, pg8::StaticOrder, true, true>(L3 + RING_OFF, g, S, E);
    }
    PH_END
    PH_BAR
    PH_BEGIN
    phase_convact(p, gw, lane);
    PH_END
    PH_BAR
    PH_BEGIN
    {
        pg8::Gemm g{(const bf16_t*)(ws + WS_ACT), (const bf16_t*)(ws + WS_WDN_T), NTOK, D, FF}; pg8::StaticOrder S; S.init(NTOK, D, G, bx);
        pg8::EpiResid E{p.out, p.out, D, MOD + 5 * 2048, NMOD};
        pg8::gemm_phase<pg8::EpiResid, pg8::StaticOrder, true, true>(L3 + RING_OFF, g, S, E);
    }
    PH_END
    PH_BAR
    PH_BEGIN
    phase_final(p, gw, ngw, lane);
    PH_END
#undef PH_BEGIN
#undef PH_END
#undef PH_BAR
}

extern "C" void kernel_launch(void* const* d_in, const int* in_sizes, int n_in, void* d_out, int out_size, void* d_ws, size_t ws_size, hipStream_t stream) {
    static int grid = 0;
    if (grid == 0) {
        if (n_in != 30 || out_size != NTOK * D || ws_size < WS_END) { fprintf(stderr, "kernel_launch: unexpected n_in %d / out %d / ws %zu\n", n_in, out_size, ws_size); grid = -1; return; }
        int dev = 0, cus = 0, per_cu = 0;
        if (hipGetDevice(&dev) != hipSuccess || hipDeviceGetAttribute(&cus, hipDeviceAttributeMultiprocessorCount, dev) != hipSuccess) { grid = -1; return; }
        if (hipFuncSetAttribute((const void*)mega_fwd, hipFuncAttributeMaxDynamicSharedMemorySize, LDS_BYTES) != hipSuccess) { fprintf(stderr, "kernel_launch: hipFuncSetAttribute failed\n"); grid = -1; return; }
        if (hipOccupancyMaxActiveBlocksPerMultiprocessor(&per_cu, (const void*)mega_fwd, NWAVES * 64, LDS_BYTES) != hipSuccess || per_cu < 1) fprintf(stderr, "kernel_launch: occupancy query reports %d\n", per_cu);
        (void)hipGetLastError();
        grid = cus;
    }
    if (grid < 0) return;
    if (hipMemsetAsync((char*)d_ws + WS_CTL, 0, CTL_ZERO_BYTES, stream) != hipSuccess) { fprintf(stderr, "kernel_launch: memset failed\n"); return; }
    P p{};
    const float** f = (const float**)&p;
    for (int i = 0; i < 30; ++i) f[i] = (const float*)d_in[i];
    p.out = (float*)d_out; p.ws = (unsigned char*)d_ws; p.mask = 0x1FFFu;
    hipLaunchKernelGGL(mega_fwd, dim3(grid), dim3(NWAVES * 64), LDS_BYTES, stream, p);
#ifdef PROBE_PHASE
#ifndef PROBE_FLAGS
#define PROBE_FLAGS 0u
#endif
    { P q = p; q.mask = PROBE_PHASE; q.pad = 1u | (PROBE_FLAGS); hipLaunchKernelGGL(mega_fwd, dim3(grid), dim3(NWAVES * 64), LDS_BYTES, stream, q); }
#endif
}
```

```cpp
#include <hip/hip_runtime.h>
#include <cstdint>
#include <cstdio>
namespace pg8 {
#define PG8_LAS __attribute__((address_space(3)))
typedef unsigned short bf16_t;
typedef short bf16x8 __attribute__((ext_vector_type(8)));
typedef float f32x4 __attribute__((ext_vector_type(4)));
typedef unsigned u32x4 __attribute__((ext_vector_type(4)));
constexpr int BM = 256, BK = 64, HALF = 128, HTB = HALF * BK * 2  , STAGE_BYTES = 8 * HTB, NXCD = 8, WGM = 8;

__host__ __device__ __forceinline__ int lds_byte(int r, int c) { const int st = (r >> 4) * 2 + (c >> 5), rr = r & 15, cc = c & 31, ob = rr * 64 + cc * 2; return st * 1024 + (ob ^ (((ob >> 9) & 1) << 5)); }
__host__ __device__ __forceinline__ void stage_rc(int b, int& R, int& C) { const int st = b / 1024, sb = b % 1024, swz = sb ^ (((sb >> 9) & 1) << 5); R = (st >> 1) * 16 + swz / 64; C = (st & 1) * 32 + (swz % 64) / 2; }
__host__ __device__ __forceinline__ int perm32(int rho) { const int n = rho >> 4, i = rho & 15; return 8 * (i >> 2) + 4 * n + (i & 3); }

struct Unit { int pm, pn; };
struct Gemm { const bf16_t* A; const bf16_t* Bt; int M, N, K; };

struct StaticOrder {
    int nM, nN, nwg, G, c;
    __host__ __device__ void init(int M, int N, int G_, int c_) { nM = M / BM; nN = N / BM; nwg = nM * nN; G = G_; c = c_; }
    __host__ __device__ bool next(int i, Unit& u) const {
        const long L = (long)i * G + c; if (L >= nwg) return false;
        int wgid = (int)L; { const int q = nwg / NXCD, r = nwg % NXCD, xcd = wgid % NXCD, off = wgid / NXCD; wgid = (xcd < r ? xcd * (q + 1) : r * (q + 1) + (xcd - r) * q) + off; }
        const int nig = WGM * nN, gid = wgid / nig, fm = gid * WGM, gsz = (nM - fm) < WGM ? (nM - fm) : WGM;
        u.pm = fm + ((wgid % nig) % gsz); u.pn = (wgid % nig) / gsz; return true;
    }
    __device__ __forceinline__ void a_ready(const Unit&) const {}
    __device__ __forceinline__ void done(const Unit&) const {}
};

__device__ __forceinline__ unsigned cvt_pk_bf16(float lo, float hi) { unsigned r; asm volatile("v_cvt_pk_bf16_f32 %0, %1, %2" : "=v"(r) : "v"(lo), "v"(hi)); return r; }
typedef float f32x2 __attribute__((ext_vector_type(2)));
__device__ __forceinline__ f32x2 gelu_pk(f32x2 v) {
    const f32x2 av = __builtin_elementwise_abs(v), d = av * 0.2316418882f + 1.0f;
    f32x2 t; t.x = __builtin_amdgcn_rcpf(d.x); t.y = __builtin_amdgcn_rcpf(d.y);
    f32x2 q = t * 0.5307027145f + (-0.7265760135f); q = q * t + 0.7107068705f; q = q * t + (-0.142248368f); q = q * t + 0.127414796f; q = q * t;
    const f32x2 s = (v * v) * (-0.72134752044f);
    f32x2 e; e.x = __builtin_amdgcn_exp2f(s.x); e.y = __builtin_amdgcn_exp2f(s.y);
    const f32x2 m = v * (q * e), r = v - m;
    f32x2 o; o.x = v.x < 0.f ? m.x : r.x; o.y = v.y < 0.f ? m.y : r.y; return o;
}

template <int ACT  > struct EpiBf16 {
    static constexpr bool PERM = true, AFTER_DRAIN = false; static_assert(ACT == 0 || ACT == 1, "EpiBf16: ACT is 0 (none) or 1 (gelu_pk)");
    bf16_t* O; int ldc; const float* bias; int split_cols; size_t split_stride; float scale0;
    __device__ __forceinline__ void operator()(const f32x4 (&acc)[2][2][4][2], const Unit& u, int wr, int wc, int fr, int fq) const {
        const int row0 = u.pm * BM + wr * 64 + fr; int colt = u.pn * BM; bf16_t* base = O;
        float sc = 1.f; if (split_cols) { const int t = colt / split_cols; base += (size_t)t * split_stride; colt -= t * split_cols; if (t == 0) sc = scale0; }
        const int col0 = colt + wc * 32 + 8 * fq, bcol0 = u.pn * BM + wc * 32 + 8 * fq;
        f32x4 bv[2][2];
#pragma unroll
        for (int bj = 0; bj < 2; ++bj)
#pragma unroll
            for (int n = 0; n < 2; ++n) bv[bj][n] = bias ? *(const f32x4*)(bias + bcol0 + bj * HALF + 4 * n) : (f32x4){0.f, 0.f, 0.f, 0.f};
#pragma unroll
        for (int ai = 0; ai < 2; ++ai)
#pragma unroll
            for (int m = 0; m < 4; ++m) { bf16_t* rowp = base + (size_t)(row0 + ai * HALF + m * 16) * ldc + col0;
#pragma unroll
                for (int bj = 0; bj < 2; ++bj) { f32x4 v0 = acc[ai][bj][m][0] + bv[bj][0], v1 = acc[ai][bj][m][1] + bv[bj][1];
                    if (ACT == 1) { f32x2 a = gelu_pk((f32x2){v0[0], v0[1]}), b = gelu_pk((f32x2){v0[2], v0[3]}), c = gelu_pk((f32x2){v1[0], v1[1]}), d = gelu_pk((f32x2){v1[2], v1[3]});
                        v0 = (f32x4){a.x, a.y, b.x, b.y}; v1 = (f32x4){c.x, c.y, d.x, d.y}; }
                    v0 = v0 * sc; v1 = v1 * sc; u32x4 w; w.x = cvt_pk_bf16(v0[0], v0[1]); w.y = cvt_pk_bf16(v0[2], v0[3]); w.z = cvt_pk_bf16(v1[0], v1[1]); w.w = cvt_pk_bf16(v1[2], v1[3]);
                    *(u32x4*)(rowp + bj * HALF) = w; } }
    }
};
struct EpiResid {
    static constexpr bool PERM = false, AFTER_DRAIN = false;
    const float* base; float* out; int ldc; const float* gate; int gstride;
    __device__ __forceinline__ void operator()(const f32x4 (&acc)[2][2][4][2], const Unit& u, int wr, int wc, int fr, int fq) const {
        const int row0 = u.pm * BM + wr * 64 + fr, col0 = u.pn * BM + wc * 32 + 4 * fq;
        const float* g = gate + (size_t)((u.pm * BM) >> 12) * gstride + col0;
        f32x4 gv[2][2];
#pragma unroll
        for (int bj = 0; bj < 2; ++bj)
#pragma unroll
            for (int n = 0; n < 2; ++n) gv[bj][n] = *(const f32x4*)(g + bj * HALF + n * 16);
#pragma unroll
        for (int ai = 0; ai < 2; ++ai)
#pragma unroll
            for (int m = 0; m < 4; ++m) { const size_t off = (size_t)(row0 + ai * HALF + m * 16) * ldc + col0;
#pragma unroll
                for (int bj = 0; bj < 2; ++bj)
#pragma unroll
                    for (int n = 0; n < 2; ++n) { const f32x4 bs = *(const f32x4*)(base + off + bj * HALF + n * 16); *(f32x4*)(out + off + bj * HALF + n * 16) = bs + gv[bj][n] * acc[ai][bj][m][n]; } }
    }
};
template <class Epi, class Sched, bool ALIGN_EPI = false, bool SP2 = false>
__device__ __forceinline__ void gemm_phase(PG8_LAS unsigned char* lds, const Gemm g, const Sched& S, const Epi& E) {
    const int tid = threadIdx.x, wid = __builtin_amdgcn_readfirstlane(tid >> 6), lane = tid & 63, wr = wid >> 2, wc = wid & 3, fr = lane & 15, fq = lane >> 4;
    const int K = g.K, nt = K / BK;
    unsigned voffA[2], voffB[2];
#pragma unroll
    for (int i = 0; i < 2; ++i) { int R, C; stage_rc(tid * 16 + i * 8192, R, C); const int Rb = Epi::PERM ? ((R & ~31) + perm32(R & 31)) : R;
        voffA[i] = (unsigned)(R * K + C) * 2u; voffB[i] = (unsigned)(Rb * K + C) * 2u; }
    const size_t kstep = (size_t)(BK * 2);
    const size_t hstep = (size_t)HALF * K * 2;
    const size_t tstep = 2 * hstep;
    const unsigned ldsw = (unsigned)wid * 1024u;
    const int aoff = lds_byte(wr * 64 + fr, fq * 8), boff = lds_byte(wc * 32 + fr, fq * 8);
#define PG8_SA(b, h) (((b) * 2 + (h)) * HTB)
#define PG8_SB(b, h) ((4 + (b) * 2 + (h)) * HTB)
#define PG8_STAGE(bufoff, gbase, voff) do { _Pragma("unroll") for (int _i = 0; _i < 2; ++_i) \
        __builtin_amdgcn_global_load_lds((const unsigned*)((const char*)(gbase) + (voff)[_i]), (PG8_LAS unsigned*)(lds + (bufoff) + ldsw + _i * 8192), 16, 0, 0); } while (0)
#define PG8_LDA(dst, b, h) do { _Pragma("unroll") for (int m = 0; m < 4; ++m) _Pragma("unroll") for (int k = 0; k < 2; ++k) dst[m][k] = *(const PG8_LAS bf16x8*)(lds + PG8_SA(b, h) + aoff + m * 2048 + k * 1024); } while (0)
#define PG8_LDB(dst, b, h) do { _Pragma("unroll") for (int n = 0; n < 2; ++n) _Pragma("unroll") for (int k = 0; k < 2; ++k) dst[n][k] = *(const PG8_LAS bf16x8*)(lds + PG8_SB(b, h) + boff + n * 2048 + k * 1024); } while (0)
#define PG8_MMA(ai, bj, At, Bt) do { __builtin_amdgcn_s_setprio(1); _Pragma("unroll") for (int m = 0; m < 4; ++m) _Pragma("unroll") for (int n = 0; n < 2; ++n) _Pragma("unroll") for (int k = 0; k < 2; ++k) \
        acc[ai][bj][m][n] = __builtin_amdgcn_mfma_f32_16x16x32_bf16(Bt[n][k], At[m][k], acc[ai][bj][m][n], 0, 0, 0); __builtin_amdgcn_s_setprio(0); } while (0)
#define PG8_WAIT_V(n) asm volatile("s_waitcnt vmcnt(" #n ")" ::: "memory")
#define PG8_WAIT_L(n) asm volatile("s_waitcnt lgkmcnt(" #n ")" ::: "memory")
#define PG8_BAR __builtin_amdgcn_s_barrier()
#define PG8_SCHED __builtin_amdgcn_sched_barrier(0)
    Unit cur, nxt; int ui = 0;
    if (!S.next(0, cur)) return;
    f32x4 acc[2][2][4][2];
#pragma unroll
    for (int a = 0; a < 2; ++a)
#pragma unroll
        for (int b = 0; b < 2; ++b)
#pragma unroll
            for (int m = 0; m < 4; ++m)
#pragma unroll
                for (int n = 0; n < 2; ++n) acc[a][b][m][n] = (f32x4){0.f, 0.f, 0.f, 0.f};
    bf16x8 At[4][2], B0[2][2], B1[2][2];
    const char* cA = (const char*)g.A + (size_t)cur.pm * tstep; const char* cB = (const char*)g.Bt + (size_t)cur.pn * tstep;
    S.a_ready(cur);
    if constexpr (SP2) {
        PG8_STAGE(PG8_SB(0, 0), cB, voffB); PG8_STAGE(PG8_SB(0, 1), cB + hstep, voffB); PG8_STAGE(PG8_SA(0, 0), cA, voffA); PG8_STAGE(PG8_SA(0, 1), cA + hstep, voffA);
        if (wr == 1) PG8_BAR;
        PG8_WAIT_V(2); PG8_BAR;
        PG8_STAGE(PG8_SB(1, 0), cB + kstep, voffB); PG8_STAGE(PG8_SA(1, 0), cA + kstep, voffA); PG8_STAGE(PG8_SB(1, 1), cB + hstep + kstep, voffB);
        PG8_WAIT_V(6); PG8_BAR;
    } else {
        PG8_STAGE(PG8_SB(0, 0), cB, voffB); PG8_STAGE(PG8_SA(0, 0), cA, voffA); PG8_STAGE(PG8_SB(0, 1), cB + hstep, voffB); PG8_STAGE(PG8_SA(0, 1), cA + hstep, voffA);
        if (wr == 1) PG8_BAR;
        PG8_WAIT_V(4); PG8_BAR;
        PG8_STAGE(PG8_SB(1, 0), cB + kstep, voffB); PG8_STAGE(PG8_SA(1, 0), cA + kstep, voffA); PG8_STAGE(PG8_SB(1, 1), cB + hstep + kstep, voffB);
        PG8_WAIT_V(6); PG8_BAR;
    }
    for (;;) {
        const bool has_next = S.next(ui + 1, nxt);
        const char* nA = has_next ? (const char*)g.A + (size_t)nxt.pm * tstep : cA; const char* nB = has_next ? (const char*)g.Bt + (size_t)nxt.pn * tstep : cB;
        for (int t = 0; t < nt; t += 2) {
            const bool last = (t == nt - 2);
            const char* a1 = cA + (size_t)(t + 1) * kstep;
            const char* a2 = last ? nA : cA + (size_t)(t + 2) * kstep; const char* b2 = last ? nB : cB + (size_t)(t + 2) * kstep;
            const char* a3 = a2 + kstep; const char* b3 = b2 + kstep;
            if (last && has_next) S.a_ready(nxt);
            if constexpr (SP2) {
            PG8_LDB(B0, 0, 0); PG8_LDB(B1, 0, 1); PG8_SCHED; PG8_LDA(At, 0, 0); PG8_STAGE(PG8_SA(1, 1), a1 + hstep, voffA);
            PG8_WAIT_V(8); PG8_WAIT_L(0); PG8_BAR; PG8_MMA(0, 0, At, B0); PG8_MMA(0, 1, At, B1); PG8_BAR; PG8_SCHED;
            PG8_LDA(At, 0, 1); PG8_STAGE(PG8_SB(0, 0), b2, voffB); PG8_STAGE(PG8_SB(0, 1), b2 + hstep, voffB); PG8_STAGE(PG8_SA(0, 0), a2, voffA);
            PG8_WAIT_V(8); PG8_WAIT_L(0); PG8_BAR; PG8_MMA(1, 0, At, B0); PG8_MMA(1, 1, At, B1); PG8_BAR; PG8_SCHED;
            PG8_LDB(B0, 1, 0); PG8_LDB(B1, 1, 1); PG8_SCHED; PG8_LDA(At, 1, 0); PG8_STAGE(PG8_SA(0, 1), a2 + hstep, voffA);
            PG8_WAIT_V(8); PG8_WAIT_L(0); PG8_BAR; PG8_MMA(0, 0, At, B0); PG8_MMA(0, 1, At, B1); PG8_BAR; PG8_SCHED;
            PG8_LDA(At, 1, 1); PG8_STAGE(PG8_SB(1, 0), b3, voffB); PG8_STAGE(PG8_SB(1, 1), b3 + hstep, voffB); PG8_STAGE(PG8_SA(1, 0), a3, voffA);
            PG8_WAIT_V(8); PG8_WAIT_L(0); PG8_BAR; PG8_MMA(1, 0, At, B0); PG8_MMA(1, 1, At, B1); PG8_BAR; PG8_SCHED;
            } else {
            PG8_LDB(B0, 0, 0); PG8_SCHED; PG8_LDA(At, 0, 0); PG8_STAGE(PG8_SA(1, 1), a1 + hstep, voffA);
            PG8_WAIT_L(8); PG8_BAR; PG8_WAIT_L(0); PG8_MMA(0, 0, At, B0); PG8_BAR; PG8_SCHED;
            PG8_LDB(B1, 0, 1); PG8_STAGE(PG8_SB(0, 0), b2, voffB);
            PG8_BAR; PG8_WAIT_L(0); PG8_MMA(0, 1, At, B1); PG8_BAR;
            PG8_LDA(At, 0, 1); PG8_STAGE(PG8_SA(0, 0), a2, voffA);
            PG8_BAR; PG8_WAIT_L(0); PG8_MMA(1, 0, At, B0); PG8_BAR; PG8_SCHED;
            PG8_STAGE(PG8_SB(0, 1), b2 + hstep, voffB);
            PG8_WAIT_V(6); PG8_BAR; PG8_MMA(1, 1, At, B1); PG8_BAR;
            PG8_LDB(B0, 1, 0); PG8_SCHED; PG8_LDA(At, 1, 0); PG8_STAGE(PG8_SA(0, 1), a2 + hstep, voffA);
            PG8_WAIT_L(8); PG8_BAR; PG8_WAIT_L(0); PG8_MMA(0, 0, At, B0); PG8_BAR; PG8_SCHED;
            PG8_LDB(B1, 1, 1); PG8_STAGE(PG8_SB(1, 0), b3, voffB);
            PG8_BAR; PG8_WAIT_L(0); PG8_MMA(0, 1, At, B1); PG8_BAR;
            PG8_LDA(At, 1, 1); PG8_STAGE(PG8_SA(1, 0), a3, voffA);
            PG8_BAR; PG8_WAIT_L(0); PG8_MMA(1, 0, At, B0); PG8_BAR; PG8_SCHED;
            PG8_STAGE(PG8_SB(1, 1), b3 + hstep, voffB);
            PG8_WAIT_V(6); PG8_BAR; PG8_MMA(1, 1, At, B1); PG8_BAR;
            }
        }
        if constexpr (ALIGN_EPI) { if (wr == 0) PG8_BAR; }
        if constexpr (!Epi::AFTER_DRAIN) { E(acc, cur, wr, wc, fr, fq); S.done(cur); }
        if (!has_next) break;
#pragma unroll
        for (int a = 0; a < 2; ++a)
#pragma unroll
            for (int b = 0; b < 2; ++b)
#pragma unroll
                for (int m = 0; m < 4; ++m)
#pragma unroll
                    for (int n = 0; n < 2; ++n) acc[a][b][m][n] = (f32x4){0.f, 0.f, 0.f, 0.f};
        cur = nxt; cA = nA; cB = nB; ++ui;
        if constexpr (ALIGN_EPI) { if (wr == 1) PG8_BAR; }
    }
    PG8_WAIT_V(0);
    if constexpr (!ALIGN_EPI) { if (wr == 0) PG8_BAR; }
    PG8_BAR;
    if constexpr (Epi::AFTER_DRAIN) { E.fused(acc, cur, wr, wc, fr, fq, lds, wid, lane); S.done(cur); }
#undef PG8_SA
#undef PG8_SB
#undef PG8_STAGE
#undef PG8_LDA
#undef PG8_LDB
#undef PG8_MMA
#undef PG8_WAIT_V
#undef PG8_WAIT_L
#undef PG8_BAR
#undef PG8_SCHED
}
}
#define GAS __attribute__((address_space(1)))
#define LAS __attribute__((address_space(3)))
typedef unsigned short bf16;
typedef unsigned v4u __attribute__((ext_vector_type(4)));
typedef float f32x4 __attribute__((ext_vector_type(4)));
typedef short bf16x8 __attribute__((ext_vector_type(8)));
typedef GAS unsigned gu32;
typedef GAS unsigned long long gu64;
#define RLX_AGENT __ATOMIC_RELAXED, __HIP_MEMORY_SCOPE_AGENT
#define LDS_WAIT() asm volatile("s_waitcnt lgkmcnt(0)" ::: "memory")
#define VM_WAIT() asm volatile("s_waitcnt vmcnt(0)" ::: "memory")
__device__ __forceinline__ unsigned long long rt() { return __builtin_amdgcn_s_memrealtime(); }
typedef float f32x2_cv __attribute__((ext_vector_type(2))); typedef __bf16 bf16x2_cv __attribute__((ext_vector_type(2)));
__device__ __forceinline__ unsigned pk2(float lo, float hi) { f32x2_cv v = {lo, hi}; bf16x2_cv b = __builtin_convertvector(v, bf16x2_cv); return __builtin_bit_cast(unsigned, b); }
__device__ __forceinline__ unsigned f2bf(float f) { return pk2(f, 0.f) & 0xffffu; }

#define XB_TMO      128
#define XB_XCNT(j)  (256  + 64 * (j))
#define XB_XSUB(j)  (1280 + 64 * (j))
#define XB_XGEN(j)  (2304 + 64 * (j))
#define XB_TOP      3328
#define XB_TOPGEN   3392
#define XCD_BAR_WORDS 3456
#define XB_SPIN_CAP (1u << 18)

__device__ __forceinline__ unsigned xb_ld(unsigned* p)              { return __hip_atomic_load(p, __ATOMIC_RELAXED, __HIP_MEMORY_SCOPE_AGENT); }
__device__ __forceinline__ unsigned xb_add(unsigned* p, unsigned v) { return __hip_atomic_fetch_add(p, v, __ATOMIC_RELAXED, __HIP_MEMORY_SCOPE_AGENT); }
__device__ __forceinline__ unsigned xb_xcc_id() { return (unsigned)__builtin_amdgcn_s_getreg((3 << 11) | 20) & 0xFu; }
#define XB_SPIN(cond, bar) do { unsigned _sp = 0; while (cond) { __builtin_amdgcn_s_sleep(1); \
    if ((++_sp & 255u) == 0u) { if (xb_ld(&(bar)[XB_TMO])) break; if (_sp > XB_SPIN_CAP) { atomicAdd(&(bar)[XB_TMO], 1u); break; } } } } while (0)

struct XcdBarrier {
    unsigned* bar; unsigned x;
    volatile LAS unsigned* st;
};

__device__ __forceinline__ XcdBarrier xcd_barrier_post(unsigned* bar, volatile LAS unsigned* st) {
    XcdBarrier b; b.bar = bar; b.x = xb_xcc_id(); b.st = st;
    if (threadIdx.x == 0) (void)xb_add(&bar[XB_XCNT(b.x)], 1u);
    return b;
}
__device__ __forceinline__ void xcd_barrier_complete(unsigned* bar, unsigned x, unsigned& nloc, unsigned& nx) {
    const unsigned G = gridDim.x * gridDim.y * gridDim.z;
    unsigned sum, cnt, mine, sp = 0u;
    for (;;) {
        sum = 0u; cnt = 0u; mine = 0u;
#pragma unroll
        for (unsigned j = 0; j < 16; ++j) { const unsigned c = xb_ld(&bar[XB_XCNT(j)]); sum += c; cnt += (c > 0u) ? 1u : 0u; mine = (j == x) ? c : mine; }
        if (sum == G) break;
        __builtin_amdgcn_s_sleep(1);
        if ((++sp & 255u) == 0u) { if (xb_ld(&bar[XB_TMO])) break; if (sp > XB_SPIN_CAP) { atomicAdd(&bar[XB_TMO], 1u); break; } }
    }
    nloc = mine > 0u ? mine : 1u; nx = cnt > 0u ? cnt : 1u;
}

__device__ __forceinline__ void xcd_barrier(const XcdBarrier& b) {
    asm volatile("s_waitcnt vmcnt(0)" ::: "memory");
    __syncthreads();
    if (threadIdx.x == 0) {
        unsigned* bar = b.bar;
        __builtin_amdgcn_s_waitcnt(0);
        unsigned nloc = b.st[0], nx = b.st[1];
        if (nloc == 0u) { xcd_barrier_complete(bar, b.x, nloc, nx); b.st[0] = nloc; b.st[1] = nx; }
        const unsigned old = xb_add(&bar[XB_XSUB(b.x)], 1u);
        const unsigned gen = old / nloc;
        if (old + 1u == (gen + 1u) * nloc) {
            __builtin_amdgcn_fence(__ATOMIC_RELEASE, "agent");
            asm volatile("s_waitcnt vmcnt(0)" ::: "memory");
            const unsigned og = xb_add(&bar[XB_TOP], 1u);
            const unsigned tg = og / nx;
            if (og + 1u == (tg + 1u) * nx) xb_add(&bar[XB_TOPGEN], 1u);
            else XB_SPIN(xb_ld(&bar[XB_TOPGEN]) == tg, bar);
            __builtin_amdgcn_fence(__ATOMIC_ACQUIRE, "agent");
            xb_add(&bar[XB_XGEN(b.x)], 1u);
            asm volatile("s_waitcnt vmcnt(0)" ::: "memory");
        } else {
            XB_SPIN(xb_ld(&bar[XB_XGEN(b.x)]) == gen, bar);
            __builtin_amdgcn_fence(__ATOMIC_ACQUIRE, "agent");
            asm volatile("s_waitcnt vmcnt(0)" ::: "memory");
        }
    }
    __syncthreads();
}
typedef unsigned short bf16_t;
typedef float f32x2 __attribute__((ext_vector_type(2)));
typedef unsigned u32x4 __attribute__((ext_vector_type(4)));
typedef unsigned u32x2 __attribute__((ext_vector_type(2)));
__device__ __forceinline__ float bf2f(bf16_t v) { return __uint_as_float(((unsigned)v) << 16); }
__device__ __forceinline__ float bflo(unsigned w) { return __uint_as_float(w << 16); }
__device__ __forceinline__ float bfhi(unsigned w) { return __uint_as_float(w & 0xffff0000u); }
__device__ __forceinline__ void st_b16(void* ptr, unsigned v) { asm volatile("global_store_short %0, %1, off" :: "v"(ptr), "v"(v) : "memory"); }
__device__ __forceinline__ void st_b32(void* ptr, float v) { asm volatile("global_store_dword %0, %1, off" :: "v"(ptr), "v"(v) : "memory"); }
__device__ __forceinline__ void st_b64(void* ptr, u32x2 v) { asm volatile("global_store_dwordx2 %0, %1, off" :: "v"(ptr), "v"(v) : "memory"); }
__device__ __forceinline__ void st_b128(void* ptr, u32x4 v) { asm volatile("global_store_dwordx4 %0, %1, off\n\ts_nop 1" :: "v"(ptr), "v"(v) : "memory"); }
__device__ __forceinline__ void st_f128(void* ptr, f32x4 v) { asm volatile("global_store_dwordx4 %0, %1, off\n\ts_nop 1" :: "v"(ptr), "v"(v) : "memory"); }
__device__ __forceinline__ void unpack8(const u32x4 v, float (&o)[8]) { o[0] = bflo(v.x); o[1] = bfhi(v.x); o[2] = bflo(v.y); o[3] = bfhi(v.y); o[4] = bflo(v.z); o[5] = bfhi(v.z); o[6] = bflo(v.w); o[7] = bfhi(v.w); }
constexpr int D = 2048, NB = 2, L = 4096, LC = 256;
constexpr int NTOK = NB * L, NCTX = NB * LC, NROW = NTOK + NCTX;
constexpr int NIN = 6576, LDP = 6656;
constexpr int C_Q = 0, C_K = 512, C_VM = 1024, C_OM = 2048, C_G = 3072, C_R = 3088, C_KR = 4112, C_VR = 5136, C_LW = 6160, C_LA = 6288, C_LG = 6416;
constexpr int FF = 5632, NMOD = 12288;
constexpr int RW = 1024;
constexpr int NSTEP = LC + L;

constexpr size_t MiB = 1u << 20;
constexpr size_t WS_CTL = 0;
constexpr size_t WS_MOD = 1 * MiB;
constexpr size_t WS_GATES = 2 * MiB;
constexpr size_t WS_BONUS = 3 * MiB;
constexpr size_t WS_BONUS_B = 4 * MiB;
constexpr size_t WS_DENS = 7 * MiB;
constexpr size_t WS_WUPT = 5 * MiB;
constexpr size_t WS_AUPT = 5 * MiB + 256 * 1024;
constexpr size_t WS_GUPT = 5 * MiB + 512 * 1024;
constexpr size_t WS_WOUT_T = 8 * MiB;
constexpr size_t WS_WIN_T = 16 * MiB;
constexpr size_t WS_HX = 42 * MiB;
constexpr size_t WS_KK = 16 * MiB;
constexpr size_t WS_QC = 33 * MiB;
constexpr size_t WS_KC = 42 * MiB;
constexpr size_t WS_GG = 51 * MiB;
constexpr size_t WS_PROJ = 76 * MiB;
constexpr size_t WS_LWF = 187 * MiB;
constexpr size_t WS_LWB = 204 * MiB;
constexpr size_t WS_AF = 221 * MiB;
constexpr size_t WS_AB = 238 * MiB;
constexpr size_t WS_CHD = 187 * MiB;
constexpr size_t WS_YF = 291 * MiB;
constexpr size_t WS_YB = 307 * MiB;
constexpr size_t WS_HF = 323 * MiB;
constexpr size_t WS_HB = 339 * MiB;
constexpr size_t WS_MIX = 187 * MiB;
constexpr size_t WS_HX2 = 8 * MiB;
constexpr size_t WS_WUG_T = 40 * MiB;
constexpr size_t WS_WDN_T = 84 * MiB;
constexpr size_t WS_UG = 106 * MiB;
constexpr size_t WS_ACT = 282 * MiB;
constexpr size_t WS_END = 370 * MiB;

struct P {
    const float *x, *c, *ctx, *c_ctx, *w_mod, *b_mod, *g_norm1, *g_norm2, *w_in, *m_conv_w, *m_conv_b, *m_gate_b, *m_norm_g;
    const float *r_w0, *r_w_up, *r_a0, *r_a_up, *r_g_up, *r_k_k, *r_k_a, *r_r_k, *r_gn_w, *r_gn_b, *w_out, *f_w_up, *f_w_gate, *f_conv_w, *f_conv_b, *f_w_down, *g_final;
    float* out; unsigned char* ws; unsigned mask, pad;
};

__device__ __forceinline__ float wave_sum(float v) {
#pragma unroll
    for (int o = 1; o < 64; o <<= 1) v += __shfl_xor(v, o);
    return v;
}
__device__ __forceinline__ float sigmoidf_(float x) { return 1.f / (1.f + __expf(-x)); }
__device__ __forceinline__ float softplusf_(float x) { return fmaxf(x, 0.f) + log1pf(__expf(-fabsf(x))); }

__device__ __forceinline__ void row_seq(int r, int& base, int& t, int& len) {
    if (r < NTOK) { base = r & ~(L - 1); t = r & (L - 1); len = L; } else { const int q = r - NTOK; base = NTOK + (q & ~(LC - 1)); t = q & (LC - 1); len = LC; }
}
__device__ __forceinline__ int step_row(int s, int b, int dir) {
    if (s < LC) { const int t = dir ? (LC - 1 - s) : s; return NTOK + b * LC + t; }
    const int u = s - LC; const int t = dir ? (L - 1 - u) : u; return b * L + t;
}

__device__ __forceinline__ void phase_mod(const P& p, int bid, int nb, float* lds) {
    float* sc = lds;
    float* red = lds + 3 * 2048;
    const int tid = threadIdx.x;
    for (int i = tid; i < 3 * 2048; i += blockDim.x) { const int v = i >> 11, k = i & 2047; const float xv = v < 2 ? p.c[v * 2048 + k] : p.c_ctx[k]; sc[i] = xv / (1.f + __expf(-xv)); }
    __syncthreads();
    float* MOD = (float*)(p.ws + WS_MOD);
    for (int cb = bid; cb < NMOD / 48; cb += nb) {
        const int cg = tid % 12, kl = tid / 12;
        float a[3][4];
#pragma unroll
        for (int v = 0; v < 3; ++v)
#pragma unroll
            for (int j = 0; j < 4; ++j) a[v][j] = 0.f;
        if (kl < 42) {
            for (int k = kl; k < 2048; k += 42) {
                const f32x4 w = *(const f32x4*)(p.w_mod + (size_t)k * NMOD + cb * 48 + cg * 4);
#pragma unroll
                for (int v = 0; v < 3; ++v) { const float s = sc[v * 2048 + k]; a[v][0] += s * w.x; a[v][1] += s * w.y; a[v][2] += s * w.z; a[v][3] += s * w.w; }
            }
#pragma unroll
            for (int v = 0; v < 3; ++v)
#pragma unroll
                for (int j = 0; j < 4; ++j) red[kl * 144 + v * 48 + cg * 4 + j] = a[v][j];
        }
        __syncthreads();
        if (tid < 144) {
            float s = 0.f;
            for (int k = 0; k < 42; ++k) s += red[k * 144 + tid];
            const int v = tid / 48, cc = tid % 48;
            MOD[v * NMOD + cb * 48 + cc] = s + p.b_mod[cb * 48 + cc];
        }
        __syncthreads();
    }
}

__device__ __forceinline__ void normmod_row(const float* src, const float* g, const float* sh, const float* sc, bf16_t* dst, int lane) {
    f32x4 v[8]; float s = 0.f;
#pragma unroll
    for (int j = 0; j < 8; ++j) { v[j] = *((const f32x4*)src + lane + 64 * j); s += (v[j].x * v[j].x + v[j].y * v[j].y) + (v[j].z * v[j].z + v[j].w * v[j].w); }
    const float rs = rsqrtf(wave_sum(s) * (1.f / D) + 1e-6f);
#pragma unroll
    for (int j = 0; j < 8; ++j) {
        const f32x4 gg = *((const f32x4*)g + lane + 64 * j), a = *((const f32x4*)sc + lane + 64 * j), b = *((const f32x4*)sh + lane + 64 * j);
        const float o0 = v[j].x * rs * gg.x * (1.f + a.x) + b.x, o1 = v[j].y * rs * gg.y * (1.f + a.y) + b.y, o2 = v[j].z * rs * gg.z * (1.f + a.z) + b.z, o3 = v[j].w * rs * gg.w * (1.f + a.w) + b.w;
        u32x2 w; w.x = pk2(o0, o1); w.y = pk2(o2, o3);
        *((u32x2*)dst + lane + 64 * j) = w;
    }
}
__device__ __forceinline__ void phase_normmod(const P& p, int which, int gw, int ngw, int lane) {
    const float* MOD = (const float*)(p.ws + WS_MOD);
    if (which == 0) {
        bf16_t* HX = (bf16_t*)(p.ws + WS_HX);
        for (int r = gw; r < NROW; r += ngw) {
            const float* src = r < NTOK ? p.x + (size_t)r * D : p.ctx + (size_t)(r - NTOK) * D;
            const int v = r < NTOK ? (r >> 12) : 2;
            normmod_row(src, p.g_norm1, MOD + v * NMOD + 0, MOD + v * NMOD + 2048, HX + (size_t)r * D, lane);
        }
    } else {
        bf16_t* HX2 = (bf16_t*)(p.ws + WS_HX2);
        for (int r = gw; r < NTOK; r += ngw) {
            const int v = r >> 12;
            normmod_row(p.out + (size_t)r * D, p.g_norm2, MOD + v * NMOD + 3 * 2048, MOD + v * NMOD + 4 * 2048, HX2 + (size_t)r * D, lane);
        }
    }
}

__device__ __forceinline__ void phase_lora_ref(const P& p, int bid, int nb, float* lds) {
    float* tl = lds;
    float* la = lds + 128;
    float* sg = lds + 256;
    const bf16_t* PROJ = (const bf16_t*)(p.ws + WS_PROJ);
    bf16_t* LW[2] = {(bf16_t*)(p.ws + WS_LWF), (bf16_t*)(p.ws + WS_LWB)};
    bf16_t* AA[2] = {(bf16_t*)(p.ws + WS_AF), (bf16_t*)(p.ws + WS_AB)};
    bf16_t* GG = (bf16_t*)(p.ws + WS_GG);
    const int tid = threadIdx.x;
    for (int r = bid; r < NROW; r += nb) {
        const bf16_t* pr = PROJ + (size_t)r * LDP;
        if (tid < 128) tl[tid] = tanhf(bf2f(pr[C_LW + tid]));
        else if (tid < 256) la[tid - 128] = bf2f(pr[C_LA + tid - 128]);
        else if (tid < 416) sg[tid - 256] = sigmoidf_(bf2f(pr[C_LG + tid - 256]));
        __syncthreads();
        for (int c = tid; c < RW; c += blockDim.x) {
#pragma unroll
            for (int d = 0; d < 2; ++d) {
                float aw = p.r_w0[d * RW + c], aa = p.r_a0[d * RW + c];
                for (int k = 0; k < 64; ++k) { aw += tl[d * 64 + k] * p.r_w_up[(size_t)(d * 64 + k) * RW + c]; aa += la[d * 64 + k] * p.r_a_up[(size_t)(d * 64 + k) * RW + c]; }
                const float wlog = -softplusf_(-aw) - 0.5f;
                LW[d][(size_t)r * RW + c] = (bf16_t)f2bf(-__expf(wlog));
                AA[d][(size_t)r * RW + c] = (bf16_t)f2bf(sigmoidf_(aa));
            }
            if (r < NTOK) {
                float g = 0.f;
                for (int k = 0; k < 160; ++k) g += sg[k] * p.r_g_up[(size_t)k * RW + c];
                GG[(size_t)r * RW + c] = (bf16_t)f2bf(g);
            }
        }
        __syncthreads();
    }
}

__device__ __forceinline__ void phase_prep(const P& p, int bid, int nb) {
    const bf16_t* PROJ = (const bf16_t*)(p.ws + WS_PROJ);
    bf16_t* QC = (bf16_t*)(p.ws + WS_QC); bf16_t* KC = (bf16_t*)(p.ws + WS_KC);
    float* GATES = (float*)(p.ws + WS_GATES);
    const int tid = threadIdx.x, rl = tid >> 7, c0 = (tid & 127) * 8;
    float cw[3][8], cb[8];
#pragma unroll
    for (int k = 0; k < 3; ++k) { *(f32x4*)&cw[k][0] = *(const f32x4*)(p.m_conv_w + k * 1024 + c0); *(f32x4*)&cw[k][4] = *(const f32x4*)(p.m_conv_w + k * 1024 + c0 + 4); }
    *(f32x4*)&cb[0] = *(const f32x4*)(p.m_conv_b + c0); *(f32x4*)&cb[4] = *(const f32x4*)(p.m_conv_b + c0 + 4);
    for (int r = bid * 4 + rl; r < NROW; r += nb * 4) {
        int base, t, len; row_seq(r, base, t, len);
        const bf16_t* pr = PROJ + (size_t)r * LDP;
        const bool hp = t > 0, hn = t + 1 < len;
        float cur[8], prv[8], nxt[8];
        unpack8(*(const u32x4*)(pr + c0), cur); unpack8(*(const u32x4*)(pr - (hp ? LDP : 0) + c0), prv); unpack8(*(const u32x4*)(pr + (hn ? LDP : 0) + c0), nxt);
        const float mp = hp ? 1.f : 0.f, mn = hn ? 1.f : 0.f, sc = c0 < 512 ? 0.08838834764831845f : 1.f;
        float o[8];
#pragma unroll
        for (int j = 0; j < 8; ++j) o[j] = (prv[j] * (cw[0][j] * mp) + cur[j] * cw[1][j] + nxt[j] * (cw[2][j] * mn) + cb[j]) * sc;
        u32x4 w; w.x = pk2(o[0], o[1]); w.y = pk2(o[2], o[3]); w.z = pk2(o[4], o[5]); w.w = pk2(o[6], o[7]);
        if (c0 < 512) *(u32x4*)(QC + (size_t)r * 512 + c0) = w; else *(u32x4*)(KC + (size_t)r * 512 + c0 - 512) = w;
        if ((tid & 127) < 16) {
            const int j = tid & 127;
            float v = bf2f(pr[C_G + j]) + p.m_gate_b[j];
            if (j >= 8) v = -softplusf_(-v);
            GATES[(size_t)r * 16 + j] = v;
        }
    }
}

__device__ void rwkv_ref_task(const P& p, int gw, int lane) {
    const bf16_t* PROJ = (const bf16_t*)(p.ws + WS_PROJ); const bf16_t* KK = (const bf16_t*)(p.ws + WS_KK);
    const int stream = gw >> 6, vrow = gw & 63, dir = stream >> 5, b = (stream >> 4) & 1, h = stream & 15;
    const bf16_t* LW = (const bf16_t*)(p.ws + (dir ? WS_LWB : WS_LWF)); const bf16_t* AA = (const bf16_t*)(p.ws + (dir ? WS_AB : WS_AF));
    bf16_t* Y = (bf16_t*)(p.ws + (dir ? WS_YB : WS_YF));
    const int c = h * 64 + lane; const float rka = p.r_k_a[c];
    float s = 0.f;
    for (int st = 0; st < NSTEP; ++st) {
        const int r = step_row(st, b, dir);
        const float w = __expf(bf2f(LW[(size_t)r * RW + c])), a = bf2f(AA[(size_t)r * RW + c]), kk = bf2f(KK[(size_t)r * RW + c]);
        const float kr = bf2f(PROJ[(size_t)r * LDP + C_KR + c]), rr = bf2f(PROJ[(size_t)r * LDP + C_R + c]), vv = bf2f(PROJ[(size_t)r * LDP + C_VR + h * 64 + vrow]);
        const float kd = kr * (1.f + (a - 1.f) * rka);
        const float sa = wave_sum(s * kk);
        s = s * w - sa * (kk * a) + vv * kd;
        const float y = wave_sum(s * rr);
        if (st >= LC && lane == 0) Y[(size_t)r * RW + h * 64 + vrow] = (bf16_t)f2bf(y);
    }
}
__device__ void mlstm_ref_task(const P& p, int gw, int lane) {
    const bf16_t* PROJ = (const bf16_t*)(p.ws + WS_PROJ); const bf16_t* QC = (const bf16_t*)(p.ws + WS_QC); const bf16_t* KC = (const bf16_t*)(p.ws + WS_KC);
    const float* GATES = (const float*)(p.ws + WS_GATES);
    const int stream = gw >> 8, vrow = gw & 255, dir = stream >> 3, b = (stream >> 2) & 1, h = stream & 3;
    bf16_t* H = (bf16_t*)(p.ws + (dir ? WS_HB : WS_HF));
    float c0 = 0.f, c1 = 0.f, n0 = 0.f, n1 = 0.f;
    for (int st = 0; st < NSTEP; ++st) {
        const int r = step_row(st, b, dir);
        const float ig = GATES[(size_t)r * 16 + dir * 4 + h], lf = GATES[(size_t)r * 16 + 8 + dir * 4 + h];
        const float f = __expf(lf), ei = __expf(ig);
        const float k0 = bf2f(KC[(size_t)r * 512 + h * 128 + lane]), k1 = bf2f(KC[(size_t)r * 512 + h * 128 + 64 + lane]);
        const float q0 = bf2f(QC[(size_t)r * 512 + h * 128 + lane]), q1 = bf2f(QC[(size_t)r * 512 + h * 128 + 64 + lane]);
        const float v = bf2f(PROJ[(size_t)r * LDP + C_VM + h * 256 + vrow]);
        c0 = f * c0 + ei * v * k0; c1 = f * c1 + ei * v * k1; n0 = f * n0 + ei * k0; n1 = f * n1 + ei * k1;
        const float num = wave_sum(c0 * q0 + c1 * q1), den = wave_sum(n0 * q0 + n1 * q1);
        if (st >= LC && lane == 0) H[(size_t)r * RW + h * 256 + vrow] = (bf16_t)f2bf(num / fmaxf(fabsf(den), 1.f));
    }
}

__device__ __forceinline__ void phase_post(const P& p, int gw, int ngw, int lane) {
    const bf16_t* PROJ = (const bf16_t*)(p.ws + WS_PROJ);
    const bf16_t* YF = (const bf16_t*)(p.ws + WS_YF); const bf16_t* YB = (const bf16_t*)(p.ws + WS_YB);
    const bf16_t* HF = (const bf16_t*)(p.ws + WS_HF); const bf16_t* HB = (const bf16_t*)(p.ws + WS_HB);
    const bf16_t* GG = (const bf16_t*)(p.ws + WS_GG); const float* BONUS = (const float*)(p.ws + WS_BONUS); const float* BONUSB = (const float*)(p.ws + WS_BONUS_B);
    bf16_t* MIX = (bf16_t*)(p.ws + WS_MIX);
    for (int it = gw; it < NTOK * 4; it += ngw) {
        const int r = it >> 2, qt = it & 3, c0 = (qt & 1) * 512 + lane * 8;
        const bf16_t* pr = PROJ + (size_t)r * LDP;
        float o[8];
        if (qt < 2) {
            float a[8], b[8], om[8], gn[8];
            unpack8(*(const u32x4*)(HF + (size_t)r * RW + c0), a); unpack8(*(const u32x4*)(HB + (size_t)r * RW + c0), b); unpack8(*(const u32x4*)(pr + C_OM + c0), om);
            *(f32x4*)&gn[0] = *(const f32x4*)(p.m_norm_g + c0); *(f32x4*)&gn[4] = *(const f32x4*)(p.m_norm_g + c0 + 4);
            float ss = 0.f;
#pragma unroll
            for (int j = 0; j < 8; ++j) { a[j] += b[j]; ss += a[j] * a[j]; }
#pragma unroll
            for (int o2 = 1; o2 < 32; o2 <<= 1) ss += __shfl_xor(ss, o2);
            const float rs = rsqrtf(ss * (1.f / 256.f) + 1e-6f);
#pragma unroll
            for (int j = 0; j < 8; ++j) o[j] = a[j] * rs * gn[j] * __builtin_amdgcn_rcpf(1.f + __expf(-om[j]));
            u32x4 w; w.x = pk2(o[0], o[1]); w.y = pk2(o[2], o[3]); w.z = pk2(o[4], o[5]); w.w = pk2(o[6], o[7]);
            *(u32x4*)(MIX + (size_t)r * D + c0) = w;
        } else {
            float a[8], b[8], vr[8], gg[8], gw_[8], gb[8];
            unpack8(*(const u32x4*)(YF + (size_t)r * RW + c0), a); unpack8(*(const u32x4*)(YB + (size_t)r * RW + c0), b);
            unpack8(*(const u32x4*)(pr + C_VR + c0), vr); unpack8(*(const u32x4*)(GG + (size_t)r * RW + c0), gg);
            *(f32x4*)&gw_[0] = *(const f32x4*)(p.r_gn_w + c0); *(f32x4*)&gw_[4] = *(const f32x4*)(p.r_gn_w + c0 + 4);
            *(f32x4*)&gb[0] = *(const f32x4*)(p.r_gn_b + c0); *(f32x4*)&gb[4] = *(const f32x4*)(p.r_gn_b + c0 + 4);
            const int hd = c0 >> 6;
            const float bn = BONUS[(size_t)r * 16 + hd] + BONUSB[(size_t)r * 16 + hd];
            float sm = 0.f;
#pragma unroll
            for (int j = 0; j < 8; ++j) { a[j] += b[j]; sm += a[j]; }
            sm += __shfl_xor(sm, 1); sm += __shfl_xor(sm, 2); sm += __shfl_xor(sm, 4);
            const float mu = sm * (1.f / 64.f);
            float sv = 0.f;
#pragma unroll
            for (int j = 0; j < 8; ++j) { a[j] -= mu; sv += a[j] * a[j]; }
            sv += __shfl_xor(sv, 1); sv += __shfl_xor(sv, 2); sv += __shfl_xor(sv, 4);
            const float rs = rsqrtf(sv * (1.f / 64.f) + 64e-5f);
#pragma unroll
            for (int j = 0; j < 8; ++j) o[j] = (a[j] * rs * gw_[j] + gb[j] + bn * vr[j]) * gg[j];
            u32x4 w; w.x = pk2(o[0], o[1]); w.y = pk2(o[2], o[3]); w.z = pk2(o[4], o[5]); w.w = pk2(o[6], o[7]);
            *(u32x4*)(MIX + (size_t)r * D + 1024 + c0) = w;
        }
    }
}

__device__ __forceinline__ void phase_convact(const P& p, int gw, int lane) {
    const bf16_t* UG = (const bf16_t*)(p.ws + WS_UG); bf16_t* ACT = (bf16_t*)(p.ws + WS_ACT);
    constexpr int NCGW = FF / 8 / 64, NSTRIPE = 186, TPS = 45;
    const int cgw = gw % NCGW, stripe = gw / NCGW;
    if (stripe >= NSTRIPE) return;
    const int f = (cgw * 64 + lane) * 8;
    float cw[9][8], cb[8];
#pragma unroll
    for (int k = 0; k < 9; ++k) { *(f32x4*)&cw[k][0] = *(const f32x4*)(p.f_conv_w + (size_t)k * FF + f); *(f32x4*)&cw[k][4] = *(const f32x4*)(p.f_conv_w + (size_t)k * FF + f + 4); }
    *(f32x4*)&cb[0] = *(const f32x4*)(p.f_conv_b + f); *(f32x4*)&cb[4] = *(const f32x4*)(p.f_conv_b + f + 4);
    const int r1 = min(NTOK, (stripe + 1) * TPS);
    for (int r = stripe * TPS; r < r1; r += 2) {
        u32x4 ld[2][10]; float msk[2][9]; bool have[2];
#pragma unroll
        for (int tk = 0; tk < 2; ++tk) {
            const int rr_ = min(r + tk, NTOK - 1); have[tk] = (r + tk) < r1;
            const int b = rr_ >> 12, t = rr_ & 4095, gr = t >> 6, gc = t & 63;
#pragma unroll
            for (int dr = 0; dr < 3; ++dr)
#pragma unroll
                for (int dc = 0; dc < 3; ++dc) {
                    const int rr = gr + dr - 1, cc = gc + dc - 1;
                    const bool ok = rr >= 0 && rr < 64 && cc >= 0 && cc < 64;
                    const int nb_ = ok ? (b * 4096 + rr * 64 + cc) : rr_; msk[tk][dr * 3 + dc] = ok ? 1.f : 0.f;
                    ld[tk][dr * 3 + dc] = *(const u32x4*)(UG + (size_t)nb_ * (2 * FF) + f);
                }
            ld[tk][9] = *(const u32x4*)(UG + (size_t)rr_ * (2 * FF) + FF + f);
        }
#pragma unroll
        for (int tk = 0; tk < 2; ++tk) {
            float acc[8];
#pragma unroll
            for (int j = 0; j < 8; ++j) acc[j] = cb[j];
#pragma unroll
            for (int k = 0; k < 9; ++k) { float u[8]; unpack8(ld[tk][k], u);
#pragma unroll
                for (int j = 0; j < 8; ++j) acc[j] += u[j] * (cw[k][j] * msk[tk][k]); }
            float gt[8]; unpack8(ld[tk][9], gt);
            float o[8];
#pragma unroll
            for (int j = 0; j < 8; ++j) { const float u = acc[j], z2 = 1.5957691216057308f * (u + 0.044715f * u * u * u); o[j] = u * __builtin_amdgcn_rcpf(1.f + __expf(-z2)) * gt[j]; }
            u32x4 w; w.x = pk2(o[0], o[1]); w.y = pk2(o[2], o[3]); w.z = pk2(o[4], o[5]); w.w = pk2(o[6], o[7]);
            if (have[tk]) *(u32x4*)(ACT + (size_t)(r + tk) * FF + f) = w;
        }
    }
}

__device__ __forceinline__ void phase_final(const P& p, int gw, int ngw, int lane) {
    for (int r = gw; r < NTOK; r += ngw) {
        float* row = p.out + (size_t)r * D;
        f32x4 v[8]; float s = 0.f;
#pragma unroll
        for (int j = 0; j < 8; ++j) { v[j] = *((const f32x4*)row + lane + 64 * j); s += (v[j].x * v[j].x + v[j].y * v[j].y) + (v[j].z * v[j].z + v[j].w * v[j].w); }
        const float rs = rsqrtf(wave_sum(s) * (1.f / D) + 1e-6f);
#pragma unroll
        for (int j = 0; j < 8; ++j) { const f32x4 g = *((const f32x4*)p.g_final + lane + 64 * j); f32x4 o; o.x = v[j].x * rs * g.x; o.y = v[j].y * rs * g.y; o.z = v[j].z * rs * g.z; o.w = v[j].w * rs * g.w; *((f32x4*)row + lane + 64 * j) = o; }
    }
}

typedef short s16x4 __attribute__((ext_vector_type(4)));
__device__ __forceinline__ bf16x8 tr8(const LAS unsigned char* p0, int rstride4) {
    const s16x4 lo = __builtin_amdgcn_ds_read_tr16_b64_v4i16((LAS s16x4*)p0);
    const s16x4 hi = __builtin_amdgcn_ds_read_tr16_b64_v4i16((LAS s16x4*)(p0 + rstride4));
    return (bf16x8){lo[0], lo[1], lo[2], lo[3], hi[0], hi[1], hi[2], hi[3]};
}
template <int CTRL, int RM, bool BC> __device__ __forceinline__ float dppf(float oldv, float src) { return __int_as_float(__builtin_amdgcn_update_dpp(__float_as_int(oldv), __float_as_int(src), CTRL, RM, 0xF, BC)); }
__device__ __forceinline__ float wave_scan_add(float x) {
    x += dppf<0x111, 0xF, true>(0.f, x); x += dppf<0x112, 0xF, true>(0.f, x); x += dppf<0x114, 0xF, true>(0.f, x); x += dppf<0x118, 0xF, true>(0.f, x);
    x += dppf<0x142, 0xA, false>(0.f, x); x += dppf<0x143, 0xC, false>(0.f, x);
    return x;
}
__device__ __forceinline__ float wave_scan_max(float x) {
    const float ni = -__builtin_inff();
    x = fmaxf(x, dppf<0x111, 0xF, false>(ni, x)); x = fmaxf(x, dppf<0x112, 0xF, false>(ni, x)); x = fmaxf(x, dppf<0x114, 0xF, false>(ni, x)); x = fmaxf(x, dppf<0x118, 0xF, false>(ni, x));
    x = fmaxf(x, dppf<0x142, 0xA, false>(ni, x)); x = fmaxf(x, dppf<0x143, 0xC, false>(ni, x));
    return x;
}
__device__ __forceinline__ float lane_bcast63(float x) { return __int_as_float(__builtin_amdgcn_readlane(__float_as_int(x), 63)); }
constexpr int MI_QS = 0, MI_KS = 17408, MI_VS = 34816, MI_PS = 68608, MI_SC = 77824, MI_END = 78336;
constexpr int MI_RS = 272, MI_VRS = 528, MI_PRS = 144;
constexpr int NTASK_MI = 16 * (L / 64);
__device__ __forceinline__ void phase_mintra(const P& p, LAS unsigned char* L3, int bid, int nb) {
    int tid_ = threadIdx.x; asm volatile("" : "+v"(tid_));
    const int tid = tid_, lane = tid & 63, w = __builtin_amdgcn_readfirstlane(tid >> 6), g = lane >> 4, li = lane & 15, q4 = li >> 2, p4 = li & 3;
    const bf16_t* PROJ = (const bf16_t*)(p.ws + WS_PROJ); const bf16_t* QC = (const bf16_t*)(p.ws + WS_QC); const bf16_t* KC = (const bf16_t*)(p.ws + WS_KC);
    const float* GATES = (const float*)(p.ws + WS_GATES);
    const int mt = w >> 1, nh = w & 1;
    for (int task = bid; task < NTASK_MI; task += nb) {
        const int stream = task & 15, c = LC / 64 + (task >> 4), dir = stream >> 3, b = (stream >> 2) & 1, h = stream & 3;
        bf16_t* NUMS = (bf16_t*)(p.ws + (dir ? WS_HB : WS_HF)); float* DENS = (float*)(p.ws + WS_DENS) + dir * (NTOK * 4);
        {
            u32x4 qv[2], kv[2], vv[4];
#pragma unroll
            for (int i = 0; i < 2; ++i) { const int pc = tid + 512 * i, j = pc >> 4, dp = pc & 15; const int r = step_row(64 * c + j, b, dir);
                qv[i] = *(const u32x4*)(QC + (size_t)r * 512 + h * 128 + dp * 8); kv[i] = *(const u32x4*)(KC + (size_t)r * 512 + h * 128 + dp * 8); }
#pragma unroll
            for (int i = 0; i < 4; ++i) { const int pc = tid + 512 * i, j = pc >> 5, dp = pc & 31; const int r = step_row(64 * c + j, b, dir); vv[i] = *(const u32x4*)(PROJ + (size_t)r * LDP + C_VM + h * 256 + dp * 8); }
            if (w == 0) {
                const int r = step_row(64 * c + lane, b, dir);
                const float gi = GATES[(size_t)r * 16 + dir * 4 + h], gf = GATES[(size_t)r * 16 + 8 + dir * 4 + h];
                const float bc = wave_scan_add(gf), av = gi - bc, pml = wave_scan_max(av);
                LAS float* sc = (LAS float*)(L3 + MI_SC); sc[lane] = av; sc[64 + lane] = pml;
            }
#pragma unroll
            for (int i = 0; i < 2; ++i) { const int pc = tid + 512 * i, j = pc >> 4, dp = pc & 15; *(LAS u32x4*)(L3 + MI_QS + j * MI_RS + dp * 16) = qv[i]; *(LAS u32x4*)(L3 + MI_KS + j * MI_RS + dp * 16) = kv[i]; }
#pragma unroll
            for (int i = 0; i < 4; ++i) { const int pc = tid + 512 * i, j = pc >> 5, dp = pc & 31; *(LAS u32x4*)(L3 + MI_VS + j * MI_VRS + dp * 16) = vv[i]; }
        }
        __syncthreads();
        {
            const LAS float* sc = (const LAS float*)(L3 + MI_SC);
            bf16x8 aq[4];
#pragma unroll
            for (int ks = 0; ks < 4; ++ks) aq[ks] = *(const LAS bf16x8*)(L3 + MI_QS + (16 * mt + li) * MI_RS + (32 * ks + 8 * g) * 2);
            const f32x4 pmv = *(const LAS f32x4*)(sc + 64 + 16 * mt + 4 * g);
#pragma unroll
            for (int n = 0; n < 2; ++n) {
                const int nt = 2 * nh + n;
                f32x4 sv = (f32x4){0.f, 0.f, 0.f, 0.f};
                if (nt <= mt) {
#pragma unroll
                    for (int ks = 0; ks < 4; ++ks) { const bf16x8 bk = *(const LAS bf16x8*)(L3 + MI_KS + (16 * nt + li) * MI_RS + (32 * ks + 8 * g) * 2); sv = __builtin_amdgcn_mfma_f32_16x16x32_bf16(aq[ks], bk, sv, 0, 0, 0); }
                    const float av = sc[16 * nt + li];
#pragma unroll
                    for (int r = 0; r < 4; ++r) { const int j = 16 * mt + 4 * g + r, ss = 16 * nt + li; sv[r] = (ss <= j) ? sv[r] * __expf(av - pmv[r]) : 0.f; }
                }
#pragma unroll
                for (int r = 0; r < 4; ++r) *(LAS bf16_t*)(L3 + MI_PS + (16 * mt + 4 * g + r) * MI_PRS + (16 * nt + li) * 2) = (bf16_t)f2bf(sv[r]);
            }
        }
        __syncthreads();
        {
            bf16x8 ap[2];
#pragma unroll
            for (int ks = 0; ks < 2; ++ks) ap[ks] = *(const LAS bf16x8*)(L3 + MI_PS + (16 * mt + li) * MI_PRS + (32 * ks + 8 * g) * 2);
            f32x4 acc[8];
#pragma unroll
            for (int x = 0; x < 8; ++x) acc[x] = (f32x4){0.f, 0.f, 0.f, 0.f};
#pragma unroll
            for (int ks = 0; ks < 2; ++ks)
#pragma unroll
                for (int x = 0; x < 8; ++x) { const bf16x8 bv = tr8(L3 + MI_VS + (32 * ks + 8 * g + q4) * MI_VRS + 32 * (8 * nh + x) + 8 * p4, 4 * MI_VRS); acc[x] = __builtin_amdgcn_mfma_f32_16x16x32_bf16(ap[ks], bv, acc[x], 0, 0, 0); }
            if (nh == 0) {
                const short one = li == 0 ? (short)0x3F80 : (short)0;
                const bf16x8 ones = (bf16x8){one, one, one, one, one, one, one, one};
                f32x4 dn = (f32x4){0.f, 0.f, 0.f, 0.f};
                dn = __builtin_amdgcn_mfma_f32_16x16x32_bf16(ap[0], ones, dn, 0, 0, 0); dn = __builtin_amdgcn_mfma_f32_16x16x32_bf16(ap[1], ones, dn, 0, 0, 0);
                if (li == 0) {
                    const int row0 = step_row(64 * c + 16 * mt + 4 * g, b, dir);
#pragma unroll
                    for (int r = 0; r < 4; ++r) st_b32(DENS + (size_t)(row0 + (dir ? -r : r)) * 4 + h, dn[r]);
                }
            }
#pragma unroll
            for (int x = 0; x < 8; ++x)
#pragma unroll
                for (int r = 0; r < 4; ++r) *(LAS bf16_t*)(L3 + MI_QS + (16 * mt + 4 * g + r) * MI_VRS + (16 * (8 * nh + x) + li) * 2) = (bf16_t)f2bf(acc[x][r]);
        }
        __syncthreads();
#pragma unroll
        for (int i = 0; i < 4; ++i) { const int pc = tid + 512 * i, j = pc >> 5, dp = pc & 31; const int r = step_row(64 * c + j, b, dir); st_b128(NUMS + (size_t)r * RW + h * 256 + dp * 8, *(const LAS u32x4*)(L3 + MI_QS + j * MI_VRS + dp * 16)); }
        __syncthreads();
    }
}

constexpr int ML_QS = 0, ML_KS = 17408, ML_VW = 34816, ML_OFFB = 41984, ML_CS = 83968, ML_CSB = 13056, ML_SC = 110080, ML_SCB = 2048, ML_END = 116224;
constexpr int ML_RS = 272, ML_VRS = 112, NCHUNK = NSTEP / 64;

__device__ __forceinline__ void phase_mlstm(const P& p, LAS unsigned char* L3, int task) {
    int tid_ = threadIdx.x; asm volatile("" : "+v"(tid_));
    const int tid = tid_, lane = tid & 63, w = __builtin_amdgcn_readfirstlane(tid >> 6), g = lane >> 4, li = lane & 15, q4 = li >> 2, p4 = li & 3;
    const int stream = task >> 3, sl = task & 7, dir = stream >> 3, b = (stream >> 2) & 1, h = stream & 3;
    const bf16_t* PROJ = (const bf16_t*)(p.ws + WS_PROJ); const bf16_t* QC = (const bf16_t*)(p.ws + WS_QC); const bf16_t* KC = (const bf16_t*)(p.ws + WS_KC);
    const float* GATES = (const float*)(p.ws + WS_GATES); const float* DENS = (const float*)(p.ws + WS_DENS) + dir * (NTOK * 4);
    bf16_t* H = (bf16_t*)(p.ws + (dir ? WS_HB : WS_HF));
    const int mt = w >> 1, nh = w & 1;
    for (int i = tid; i < 2 * ML_CSB / 4; i += 512) ((LAS unsigned*)(L3 + ML_CS))[i] = 0u;
    auto rlow = [&](int c) -> int { const int r0 = step_row(64 * c, b, dir); return dir ? r0 - 63 : r0; };
    unsigned offQ[2], offV = 0u, offNS[4], offGt, offDn;
#pragma unroll
    for (int i = 0; i < 2; ++i) { const int pc = tid + 512 * i, j = pc >> 4, dp = pc & 15; offQ[i] = (unsigned)((dir ? 63 - j : j) * 1024 + dp * 16); }
    if (tid < 256) { const int j = tid >> 2, pc = tid & 3; offV = (unsigned)((dir ? 63 - j : j) * (LDP * 2) + pc * 16); }
#pragma unroll
    for (int r = 0; r < 4; ++r) { const int j = 16 * mt + 4 * g + r; offNS[r] = (unsigned)((dir ? 63 - j : j) * (RW * 2) + (16 * nh + li) * 2); }
    offGt = (unsigned)((dir ? 63 - lane : lane) * 64); offDn = (unsigned)((dir ? 63 - lane : lane) * 16);
    const unsigned char* QCb = (const unsigned char*)QC + h * 256; const unsigned char* KCb = (const unsigned char*)KC + h * 256;
    const unsigned char* PVb = (const unsigned char*)PROJ + (C_VM + h * 256 + sl * 32) * 2; unsigned char* Hb = (unsigned char*)H + (h * 256 + sl * 32) * 2;
    const unsigned char* GTb = (const unsigned char*)GATES + (dir * 4 + h) * 4; const unsigned char* DNb = (const unsigned char*)DENS + h * 4;
    struct Stg { u32x4 q[2], k[2], v; };
    Stg S; float g_i = 0.f, g_f = 0.f, g_d = 0.f; float m_old = 0.f;
    auto load_chunk = [&](int c) {
        const size_t rl = (size_t)rlow(c);
#pragma unroll
        for (int i = 0; i < 2; ++i) { S.q[i] = *(const u32x4*)(QCb + rl * 1024 + offQ[i]); S.k[i] = *(const u32x4*)(KCb + rl * 1024 + offQ[i]); }
        if (tid < 256) S.v = *(const u32x4*)(PVb + rl * (LDP * 2) + offV);
    };
    auto load_ns = [&](int c, bf16_t (&ns)[4]) {
        if (c >= LC / 64) { const unsigned char* hb = Hb + (size_t)rlow(c) * (RW * 2);
#pragma unroll
            for (int r = 0; r < 4; ++r) ns[r] = *(const bf16_t*)(hb + offNS[r]); }
    };
    auto load_gates = [&](int c) { if (w == 0) { const size_t rl = (size_t)rlow(c); g_i = *(const float*)(GTb + rl * 64 + offGt); g_f = *(const float*)(GTb + rl * 64 + 32 + offGt); g_d = c >= LC / 64 ? *(const float*)(DNb + rl * 16 + offDn) : 0.f; } };
    auto scalars = [&](int buf) {
        const float bc = wave_scan_add(g_f);
        const float a = g_i - bc; const float pml = wave_scan_max(a);
        const float pm = fmaxf(pml, m_old);
        const float pmL = lane_bcast63(pm), bl = lane_bcast63(bc);
        LAS float* sc = (LAS float*)(L3 + ML_SC + buf * ML_SCB);
        sc[lane] = __expf(pml - pm); sc[64 + lane] = __expf(m_old - pm); sc[128 + lane] = __expf(-(bc + pm)); sc[192 + lane] = __expf(a - pmL); sc[256 + lane] = g_d;
        if (lane == 0) sc[320] = __expf(m_old - pmL);
        m_old = bl + pmL;
    };
    auto write_stage = [&](int buf, int scb) {
        LAS unsigned char* B = L3 + buf * ML_OFFB; const LAS float* sc = (const LAS float*)(L3 + ML_SC + scb * ML_SCB);
#pragma unroll
        for (int i = 0; i < 2; ++i) { const int pc = tid + 512 * i, j = pc >> 4, dp = pc & 15; *(LAS u32x4*)(B + ML_QS + j * ML_RS + dp * 16) = S.q[i]; *(LAS u32x4*)(B + ML_KS + j * ML_RS + dp * 16) = S.k[i]; }
        if (tid < 256) { const int j = tid >> 2, pc = tid & 3; const float wk = sc[192 + j]; const u32x4 vreg = S.v;
            u32x4 o; o.x = pk2(bflo(vreg.x) * wk, bfhi(vreg.x) * wk); o.y = pk2(bflo(vreg.y) * wk, bfhi(vreg.y) * wk); o.z = pk2(bflo(vreg.z) * wk, bfhi(vreg.z) * wk); o.w = pk2(bflo(vreg.w) * wk, bfhi(vreg.w) * wk);
            *(LAS u32x4*)(B + ML_VW + j * ML_VRS + pc * 16) = o; }
        else if (tid < 320) { const int j = tid - 256; LAS u32x4* d = (LAS u32x4*)(B + ML_VW + j * ML_VRS + 64); d[0] = (u32x4){f2bf(sc[192 + j]), 0u, 0u, 0u}; d[1] = (u32x4){0u, 0u, 0u, 0u}; }
    };
    load_chunk(0); load_gates(0);
    if (w == 0) scalars(0);
    load_gates(1);
    __syncthreads();
    write_stage(0, 0);
    if (w == 0) scalars(1);
    load_chunk(1); load_gates(2);
    bf16_t nsA[4], nsB[4]; load_ns(0, nsA); load_ns(1, nsB);
    __syncthreads();
    f32x4 accC[3];
#pragma unroll
    for (int i = 0; i < 3; ++i) accC[i] = (f32x4){0.f, 0.f, 0.f, 0.f};
    auto mstep = [&](int c, bf16_t (&nsCur)[4]) {
        const int cur = c & 1, nxt = cur ^ 1;
        LAS unsigned char* B = L3 + cur * ML_OFFB; const LAS float* sc = (const LAS float*)(L3 + ML_SC + (c % 3) * ML_SCB);
        float hv[4];
        if (c >= LC / 64) {
            const LAS unsigned char* CSc = L3 + ML_CS + cur * ML_CSB;
            f32x4 nC[2] = {(f32x4){0.f, 0.f, 0.f, 0.f}, (f32x4){0.f, 0.f, 0.f, 0.f}};
#pragma unroll
            for (int ks = 0; ks < 4; ++ks) {
                const bf16x8 aq = *(const LAS bf16x8*)(B + ML_QS + (16 * mt + li) * ML_RS + (32 * ks + 8 * g) * 2);
#pragma unroll
                for (int x = 0; x < 2; ++x) { const int vt = x ? 2 : nh; const bf16x8 bc = *(const LAS bf16x8*)(CSc + (16 * vt + li) * ML_RS + (32 * ks + 8 * g) * 2); nC[x] = __builtin_amdgcn_mfma_f32_16x16x32_bf16(aq, bc, nC[x], 0, 0, 0); }
            }
            const f32x4 resc = *(const LAS f32x4*)(sc + 16 * mt + 4 * g), inter = *(const LAS f32x4*)(sc + 64 + 16 * mt + 4 * g), emj = *(const LAS f32x4*)(sc + 128 + 16 * mt + 4 * g), dns = *(const LAS f32x4*)(sc + 256 + 16 * mt + 4 * g);
#pragma unroll
            for (int r = 0; r < 4; ++r) {
                const float denC = __shfl(nC[1][r], lane & 48);
                const float den = resc[r] * dns[r] + inter[r] * denC;
                hv[r] = (resc[r] * bf2f(nsCur[r]) + inter[r] * nC[0][r]) * __builtin_amdgcn_rcpf(fmaxf(fabsf(den), emj[r]));
            }
        }
        {
            const float decay = sc[320];
            bf16x8 bkT[2];
#pragma unroll
            for (int ks = 0; ks < 2; ++ks) bkT[ks] = tr8(B + ML_KS + (32 * ks + 8 * g + q4) * ML_RS + 32 * w + 8 * p4, 4 * ML_RS);
#pragma unroll
            for (int vt = 0; vt < 3; ++vt) {
                accC[vt] = accC[vt] * decay;
#pragma unroll
                for (int ks = 0; ks < 2; ++ks) { const bf16x8 av = tr8(B + ML_VW + (32 * ks + 8 * g + q4) * ML_VRS + 32 * vt + 8 * p4, 4 * ML_VRS); accC[vt] = __builtin_amdgcn_mfma_f32_16x16x32_bf16(av, bkT[ks], accC[vt], 0, 0, 0); }
            }
            LAS unsigned char* CSn = L3 + ML_CS + nxt * ML_CSB;
#pragma unroll
            for (int vt = 0; vt < 3; ++vt)
#pragma unroll
                for (int r = 0; r < 4; ++r) *(LAS bf16_t*)(CSn + (16 * vt + 4 * g + r) * ML_RS + (16 * w + li) * 2) = (bf16_t)f2bf(accC[vt][r]);
        }
        if (w == 0 && c + 2 < NCHUNK) scalars((c + 2) % 3);
        if (c + 1 < NCHUNK) write_stage(nxt, (c + 1) % 3);
        if (c >= LC / 64) {
            unsigned char* hb = Hb + (size_t)rlow(c) * (RW * 2);
#pragma unroll
            for (int r = 0; r < 4; ++r) st_b16(hb + offNS[r], f2bf(hv[r]));
        }
        if (c + 2 < NCHUNK) { load_chunk(c + 2); load_ns(c + 2, nsCur); }
        if (c + 3 < NCHUNK) load_gates(c + 3);
        __syncthreads();
    };
    for (int c = 0; c < NCHUNK; c += 2) { mstep(c, nsA); mstep(c + 1, nsB); }
}
template <bool ATR, bool BTR>
__device__ __forceinline__ void mm_tiles(const LAS unsigned char* A, int a_rs, const LAS unsigned char* Bm, int b_rs, int ksteps, f32x4 (&acc)[2], int mt, int nt0, int g, int li) {
    const int q4 = li >> 2, p4 = li & 3;
    for (int ks = 0; ks < ksteps; ++ks) {
        const bf16x8 a = ATR ? tr8(A + (32 * ks + 8 * g + q4) * a_rs + 32 * mt + 8 * p4, 4 * a_rs) : *(const LAS bf16x8*)(A + (16 * mt + li) * a_rs + (32 * ks + 8 * g) * 2);
#pragma unroll
        for (int n = 0; n < 2; ++n) {
            const bf16x8 b = BTR ? tr8(Bm + (32 * ks + 8 * g + q4) * b_rs + 32 * (nt0 + n) + 8 * p4, 4 * b_rs) : *(const LAS bf16x8*)(Bm + (16 * (nt0 + n) + li) * b_rs + (32 * ks + 8 * g) * 2);
            acc[n] = __builtin_amdgcn_mfma_f32_16x16x32_bf16(a, b, acc[n], 0, 0, 0);
        }
    }
}
constexpr int R1_TLW = 0, R1_LA = 9216, R1_SG = 18432, R1_FW = 39936, R1_FA = 57344;
constexpr int R1_AK = 0, R1_ABO = 9216, R1_BK = 18432, R1_BB = 27648, R1_ABF = 36864, R1_AKV = 40960, R1_TINV = 50176, R1_LP = 54272;
constexpr int R1_WT = 74752, R1_ELC = R1_WT + 2048, R1_KAP = 77056, R1_KT = 86272, R1_BT = 95488, R1_RHO = 104704, R1_VV = 113920, R1_XB = 123136, R1_END = 140544;
constexpr int R1_PAR = R1_END;
constexpr int R1_RS = 144, R1_SGRS = 336, R1_FRS = 272, R1_RHRS = 528, R1_XRS = 272;
constexpr int NTASK_R1 = 64 * NCHUNK;
constexpr int CH_M = 0, CH_G = 8192, CH_N = 16384, CH_E = 24576, CH_REC = 24832;
__device__ __forceinline__ int afrag_off(int row, int k) { return ((((row >> 4) * 2 + (k >> 5)) * 64 + ((k >> 3) & 3) * 16 + (row & 15)) * 8 + (k & 7)) * 2; }

__device__ __forceinline__ float fsig(float x) { return __builtin_amdgcn_rcpf(1.f + __expf(-x)); }
__device__ __forceinline__ float ftanh(float x) { return 1.f - 2.f * __builtin_amdgcn_rcpf(1.f + __expf(2.f * x)); }
__device__ __forceinline__ u32x4 map8_tanh(const u32x4 v) { u32x4 o; o.x = pk2(ftanh(bflo(v.x)), ftanh(bfhi(v.x))); o.y = pk2(ftanh(bflo(v.y)), ftanh(bfhi(v.y))); o.z = pk2(ftanh(bflo(v.z)), ftanh(bfhi(v.z))); o.w = pk2(ftanh(bflo(v.w)), ftanh(bfhi(v.w))); return o; }
__device__ __forceinline__ u32x4 map8_sig(const u32x4 v) { u32x4 o; o.x = pk2(fsig(bflo(v.x)), fsig(bfhi(v.x))); o.y = pk2(fsig(bflo(v.y)), fsig(bfhi(v.y))); o.z = pk2(fsig(bflo(v.z)), fsig(bfhi(v.z))); o.w = pk2(fsig(bflo(v.w)), fsig(bfhi(v.w))); return o; }
__device__ __forceinline__ u32x4 pack8(const float (&x)[8]) { u32x4 o; o.x = pk2(x[0], x[1]); o.y = pk2(x[2], x[3]); o.z = pk2(x[4], x[5]); o.w = pk2(x[6], x[7]); return o; }

__device__ __forceinline__ void phase_r1(const P& p, LAS unsigned char* L3, int bid, int nb, unsigned pflags) {
    int tid_ = threadIdx.x; asm volatile("" : "+v"(tid_));
    const int tid = tid_, lane = tid & 63, w = __builtin_amdgcn_readfirstlane(tid >> 6);
#define R1_LANES int lz_ = tid; asm volatile("" : "+v"(lz_)); const int g = (lz_ >> 4) & 3, li = lz_ & 15, q4 = li >> 2, p4 = li & 3, t = lz_ >> 3, c8 = (lz_ & 7) * 8; (void)g; (void)li; (void)q4; (void)p4; (void)t; (void)c8;
    const int mt = w >> 1, nt0 = 2 * (w & 1);
    const bf16_t* PROJ = (const bf16_t*)(p.ws + WS_PROJ);
    const bf16_t* WUPT = (const bf16_t*)(p.ws + WS_WUPT); const bf16_t* AUPT = (const bf16_t*)(p.ws + WS_AUPT); const bf16_t* GUPT = (const bf16_t*)(p.ws + WS_GUPT);
    bf16_t* GG = (bf16_t*)(p.ws + WS_GG);
    if (bid >= NTASK_R1) return;
    const int stream = bid & 63, dir = stream >> 5, b = (stream >> 4) & 1, h = stream & 15;
    float* BON = (float*)(p.ws + (dir ? WS_BONUS_B : WS_BONUS));
    bf16_t* Yo = (bf16_t*)(p.ws + (dir ? WS_YB : WS_YF));
    bf16x8 wfr[2][2], afr[2][2];
    {
        R1_LANES
#pragma unroll
        for (int ks = 0; ks < 2; ++ks)
#pragma unroll
            for (int n = 0; n < 2; ++n) { const size_t wo = ((size_t)(dir * 1024 + 64 * h + 16 * (nt0 + n) + li) * 64 + 32 * ks + 8 * g); wfr[ks][n] = *(const bf16x8*)(WUPT + wo); afr[ks][n] = *(const bf16x8*)(AUPT + wo); }
    }
    if (tid < 64) {
        const int ch = 64 * h + tid; LAS float* pp = (LAS float*)(L3 + R1_PAR);
        pp[tid] = p.r_w0[dir * RW + ch]; pp[64 + tid] = p.r_a0[dir * RW + ch]; pp[128 + tid] = p.r_k_k[ch]; pp[192 + tid] = p.r_k_a[ch]; pp[256 + tid] = p.r_r_k[ch];
    }
    struct Ld { u32x4 rr, kr, vr, lw, la, lg[3]; int row; };
    auto load_task = [&](int task, Ld& X) {
        int lz0_ = tid; asm volatile("" : "+v"(lz0_)); const int t0 = lz0_ >> 3, c80 = (lz0_ & 7) * 8;
        X.row = step_row(64 * (task >> 6) + t0, b, dir);
        const bf16_t* pr = PROJ + (size_t)X.row * LDP;
        X.rr = *(const u32x4*)(pr + C_R + 64 * h + c80); X.kr = *(const u32x4*)(pr + C_KR + 64 * h + c80); X.vr = *(const u32x4*)(pr + C_VR + 64 * h + c80);
        X.lw = *(const u32x4*)(pr + C_LW + 64 * dir + c80); X.la = *(const u32x4*)(pr + C_LA + 64 * dir + c80);
        if (dir == 0 && (task >> 6) >= LC / 64) {
#pragma unroll
            for (int i = 0; i < 3; ++i) { const int pc = lz0_ + 512 * i; if (pc < 64 * 20) { const int tt = pc / 20, q = pc % 20; X.lg[i] = *(const u32x4*)(PROJ + (size_t)step_row(64 * (task >> 6) + tt, b, dir) * LDP + C_LG + q * 8); } }
        }
    };
    Ld cur; load_task(bid, cur);
    for (int task = bid; task < NTASK_R1; task += nb) {
        const int c = task >> 6;
        const bool lat = c >= LC / 64, do_g = lat && dir == 0;
        unsigned char* rec = p.ws + WS_CHD + (size_t)(stream * NCHUNK + c) * CH_REC;
        const u32x4 rr = cur.rr, kr = cur.kr, vr = cur.vr; const int row = cur.row;
        bf16x8 gb[5][2];
        if (do_g) {
            R1_LANES
#pragma unroll
            for (int ks = 0; ks < 5; ++ks)
#pragma unroll
                for (int n = 0; n < 2; ++n) gb[ks][n] = *(const bf16x8*)(GUPT + (size_t)(64 * h + 16 * (nt0 + n) + li) * 160 + 32 * ks + 8 * g);
        }
        {
            R1_LANES
            *(LAS u32x4*)(L3 + R1_TLW + t * R1_RS + c8 * 2) = map8_tanh(cur.lw);
            *(LAS u32x4*)(L3 + R1_LA + t * R1_RS + c8 * 2) = cur.la;
            if (do_g) {
#pragma unroll
                for (int i = 0; i < 3; ++i) { const int pc = lz_ + 512 * i; if (pc < 64 * 20) { const int tt = pc / 20, q = pc % 20; *(LAS u32x4*)(L3 + R1_SG + tt * R1_SGRS + q * 16) = map8_sig(cur.lg[i]); } }
            }
        }
        __syncthreads();
        {
            R1_LANES
            f32x4 aw[2], aa[2];
#pragma unroll
            for (int n = 0; n < 2; ++n) { aw[n] = (f32x4){0.f, 0.f, 0.f, 0.f}; aa[n] = (f32x4){0.f, 0.f, 0.f, 0.f}; }
#pragma unroll
            for (int ks = 0; ks < 2; ++ks) {
                const bf16x8 a1 = *(const LAS bf16x8*)(L3 + R1_TLW + (16 * mt + li) * R1_RS + (32 * ks + 8 * g) * 2);
                const bf16x8 a2 = *(const LAS bf16x8*)(L3 + R1_LA + (16 * mt + li) * R1_RS + (32 * ks + 8 * g) * 2);
#pragma unroll
                for (int n = 0; n < 2; ++n) { aw[n] = __builtin_amdgcn_mfma_f32_16x16x32_bf16(a1, wfr[ks][n], aw[n], 0, 0, 0); aa[n] = __builtin_amdgcn_mfma_f32_16x16x32_bf16(a2, afr[ks][n], aa[n], 0, 0, 0); }
            }
#pragma unroll
            for (int n = 0; n < 2; ++n)
#pragma unroll
                for (int r = 0; r < 4; ++r) {
                    *(LAS float*)(L3 + R1_FW + (16 * mt + 4 * g + r) * R1_FRS + (16 * (nt0 + n) + li) * 4) = aw[n][r];
                    *(LAS float*)(L3 + R1_FA + (16 * mt + 4 * g + r) * R1_FRS + (16 * (nt0 + n) + li) * 4) = aa[n][r];
                }
            if (do_g) {
                f32x4 ag[2] = {(f32x4){0.f, 0.f, 0.f, 0.f}, (f32x4){0.f, 0.f, 0.f, 0.f}};
#pragma unroll
                for (int ks = 0; ks < 5; ++ks) {
                    const bf16x8 a3 = *(const LAS bf16x8*)(L3 + R1_SG + (16 * mt + li) * R1_SGRS + (32 * ks + 8 * g) * 2);
#pragma unroll
                    for (int n = 0; n < 2; ++n) ag[n] = __builtin_amdgcn_mfma_f32_16x16x32_bf16(a3, gb[ks][n], ag[n], 0, 0, 0);
                }
#pragma unroll
                for (int n = 0; n < 2; ++n)
#pragma unroll
                    for (int r = 0; r < 4; ++r) *(LAS bf16_t*)(L3 + R1_XB + (16 * mt + 4 * g + r) * R1_RS + (16 * (nt0 + n) + li) * 2) = (bf16_t)f2bf(ag[n][r]);
            }
        }
        __syncthreads();
        {
            float kap[8];
            R1_LANES
            const int ch = 64 * h + c8;
            if (do_g) st_b128(GG + (size_t)row * RW + ch, *(const LAS u32x4*)(L3 + R1_XB + t * R1_RS + c8 * 2));
            float fw[8], fa[8], w0[8], a0[8], rkk[8], rka[8], rrk[8];
            *(f32x4*)&fw[0] = *(const LAS f32x4*)(L3 + R1_FW + t * R1_FRS + c8 * 4); *(f32x4*)&fw[4] = *(const LAS f32x4*)(L3 + R1_FW + t * R1_FRS + c8 * 4 + 16);
            *(f32x4*)&fa[0] = *(const LAS f32x4*)(L3 + R1_FA + t * R1_FRS + c8 * 4); *(f32x4*)&fa[4] = *(const LAS f32x4*)(L3 + R1_FA + t * R1_FRS + c8 * 4 + 16);
#pragma unroll
            for (int i = 0; i < 2; ++i) {
                *(f32x4*)&w0[4 * i] = *(const LAS f32x4*)(L3 + R1_PAR + (c8 + 4 * i) * 4); *(f32x4*)&a0[4 * i] = *(const LAS f32x4*)(L3 + R1_PAR + (64 + c8 + 4 * i) * 4);
                *(f32x4*)&rkk[4 * i] = *(const LAS f32x4*)(L3 + R1_PAR + (128 + c8 + 4 * i) * 4); *(f32x4*)&rka[4 * i] = *(const LAS f32x4*)(L3 + R1_PAR + (192 + c8 + 4 * i) * 4); *(f32x4*)&rrk[4 * i] = *(const LAS f32x4*)(L3 + R1_PAR + (256 + c8 + 4 * i) * 4);
            }
            float krf[8], rf[8]; unpack8(kr, krf); unpack8(rr, rf);
            float wl[8], av[8], kkv[8], lam[8]; float ss = 0.f, bs = 0.f;
#pragma unroll
            for (int i = 0; i < 8; ++i) {
                wl[i] = -0.6065306597126334f * fsig(w0[i] + fw[i]);
                av[i] = fsig(a0[i] + fa[i]);
                kkv[i] = krf[i] * rkk[i]; ss += kkv[i] * kkv[i];
                bs += rf[i] * krf[i] * rrk[i] * (1.f - rka[i] + rka[i] * av[i]);
                lam[i] = wl[i];
            }
            ss += __shfl_xor(ss, 1); ss += __shfl_xor(ss, 2); ss += __shfl_xor(ss, 4);
            bs += __shfl_xor(bs, 1); bs += __shfl_xor(bs, 2); bs += __shfl_xor(bs, 4);
            const float rn = rsqrtf(ss + 1e-12f);
            if ((tid & 7) == 0) st_b32(BON + (size_t)row * 16 + h, bs);
#pragma unroll
            for (int o = 8; o < 64; o <<= 1)
#pragma unroll
                for (int i = 0; i < 8; ++i) { const float tv = __shfl_up(lam[i], o); if (lane >= o) lam[i] += tv; }
            if ((lane >> 3) == 7) { *(LAS f32x4*)(L3 + R1_WT + w * 256 + c8 * 4) = *(f32x4*)&lam[0]; *(LAS f32x4*)(L3 + R1_WT + w * 256 + c8 * 4 + 16) = *(f32x4*)&lam[4]; }
            __syncthreads();
            float lc[8];
#pragma unroll
            for (int i = 0; i < 8; ++i) lc[i] = 0.f;
#pragma unroll
            for (int ww = 0; ww < 8; ++ww) {
                float tv[8]; *(f32x4*)&tv[0] = *(const LAS f32x4*)(L3 + R1_WT + ww * 256 + c8 * 4); *(f32x4*)&tv[4] = *(const LAS f32x4*)(L3 + R1_WT + ww * 256 + c8 * 4 + 16);
#pragma unroll
                for (int i = 0; i < 8; ++i) { lc[i] += tv[i]; if (ww < w) lam[i] += tv[i]; }
            }
            float kt8[8], bt8[8], rho8[8];
#pragma unroll
            for (int i = 0; i < 8; ++i) {
                const float e_cur = __expf(lam[i]), e_prev = e_cur * __expf(-wl[i]), e_inv = __expf(-lam[i]);
                const float kk = kkv[i] * rn, kd = krf[i] * (1.f + (av[i] - 1.f) * rka[i]);
                kap[i] = kk * e_prev; rho8[i] = rf[i] * e_cur; kt8[i] = kd * e_inv; bt8[i] = kk * av[i] * e_inv;
            }
            *(LAS u32x4*)(L3 + R1_KAP + t * R1_RS + c8 * 2) = pack8(kap);
            *(LAS u32x4*)(L3 + R1_KT + t * R1_RS + c8 * 2) = pack8(kt8);
            *(LAS u32x4*)(L3 + R1_BT + t * R1_RS + c8 * 2) = pack8(bt8);
            *(LAS u32x4*)(L3 + R1_RHO + t * R1_RS + c8 * 2) = pack8(rho8);
            *(LAS u32x4*)(L3 + R1_VV + t * R1_RS + c8 * 2) = vr;
            if (t == 63) {
                f32x4 e0, e1; e0.x = __expf(lc[0]); e0.y = __expf(lc[1]); e0.z = __expf(lc[2]); e0.w = __expf(lc[3]); e1.x = __expf(lc[4]); e1.y = __expf(lc[5]); e1.z = __expf(lc[6]); e1.w = __expf(lc[7]);
                *(LAS f32x4*)(L3 + R1_ELC + c8 * 4) = e0; *(LAS f32x4*)(L3 + R1_ELC + c8 * 4 + 16) = e1;
                st_f128(rec + CH_E + c8 * 4, e0); st_f128(rec + CH_E + c8 * 4 + 16, e1);
            }
        }
        if (task + nb < NTASK_R1) load_task(task + nb, cur);
        __syncthreads();
        if (pflags & 32u) continue;
        {
            R1_LANES
            for (int i = tid; i < 64 * R1_XRS / 16; i += 512) *(LAS u32x4*)(L3 + R1_XB + i * 16) = (u32x4){0u, 0u, 0u, 0u};
            for (int i = tid; i < (4096 + 9216) / 16; i += 512) *(LAS u32x4*)(L3 + R1_TINV + i * 16) = (u32x4){0u, 0u, 0u, 0u};
            f32x4 ak[2], ab[2], bk[2], bb[2];
#pragma unroll
            for (int n = 0; n < 2; ++n) { ak[n] = (f32x4){0.f, 0.f, 0.f, 0.f}; ab[n] = ak[n]; bk[n] = ak[n]; bb[n] = ak[n]; }
            if (nt0 <= mt) {
                mm_tiles<false, false>(L3 + R1_KAP, R1_RS, L3 + R1_KT, R1_RS, 2, ak, mt, nt0, g, li);
                mm_tiles<false, false>(L3 + R1_KAP, R1_RS, L3 + R1_BT, R1_RS, 2, ab, mt, nt0, g, li);
                mm_tiles<false, false>(L3 + R1_RHO, R1_RS, L3 + R1_KT, R1_RS, 2, bk, mt, nt0, g, li);
                mm_tiles<false, false>(L3 + R1_RHO, R1_RS, L3 + R1_BT, R1_RS, 2, bb, mt, nt0, g, li);
            }
#pragma unroll
            for (int n = 0; n < 2; ++n)
#pragma unroll
                for (int r = 0; r < 4; ++r) {
                    const int tt = 16 * mt + 4 * g + r, ii = 16 * (nt0 + n) + li; const bool sl = ii < tt, le = ii <= tt, dg = (nt0 + n) == mt;
                    const int o = tt * R1_RS + ii * 2;
                    *(LAS bf16_t*)(L3 + R1_AK + o) = (bf16_t)f2bf(sl ? ak[n][r] : 0.f);
                    *(LAS bf16_t*)(L3 + R1_ABO + o) = (bf16_t)f2bf((sl && !dg) ? ab[n][r] : 0.f);
                    *(LAS bf16_t*)(L3 + R1_BK + o) = (bf16_t)f2bf(le ? bk[n][r] : 0.f);
                    *(LAS bf16_t*)(L3 + R1_BB + o) = (bf16_t)f2bf(le ? bb[n][r] : 0.f);
                    if (dg) *(LAS float*)(L3 + R1_ABF + (mt * 256 + (4 * g + r) * 16 + li) * 4) = sl ? ab[n][r] : 0.f;
                }
        }
        __syncthreads();
        f32x4 y0a[2], na[2];
        {
            R1_LANES
            f32x4 akv[2];
#pragma unroll
            for (int n = 0; n < 2; ++n) { akv[n] = (f32x4){0.f, 0.f, 0.f, 0.f}; y0a[n] = akv[n]; na[n] = akv[n]; }
            mm_tiles<false, true>(L3 + R1_AK, R1_RS, L3 + R1_VV, R1_RS, 2, akv, mt, nt0, g, li);
            mm_tiles<false, true>(L3 + R1_BK, R1_RS, L3 + R1_VV, R1_RS, 2, y0a, mt, nt0, g, li);
            mm_tiles<true, true>(L3 + R1_KT, R1_RS, L3 + R1_VV, R1_RS, 2, na, mt, nt0, g, li);
#pragma unroll
            for (int n = 0; n < 2; ++n)
#pragma unroll
                for (int r = 0; r < 4; ++r) *(LAS bf16_t*)(L3 + R1_AKV + (16 * mt + 4 * g + r) * R1_RS + (16 * (nt0 + n) + li) * 2) = (bf16_t)f2bf(akv[n][r]);
            if (w == 0) {
                const int blk = lz_ >> 4, col = lz_ & 15;
                float tv[16];
#pragma unroll
                for (int i = 0; i < 16; ++i) tv[i] = (i == col) ? 1.f : 0.f;
#pragma unroll
                for (int i = 1; i < 16; ++i) {
                    const LAS float* lrow = (const LAS float*)(L3 + R1_ABF + (blk * 256 + i * 16) * 4);
                    float lv[16];
#pragma unroll
                    for (int j4 = 0; j4 < (i + 3) / 4; ++j4) *(f32x4*)&lv[4 * j4] = *(const LAS f32x4*)(lrow + 4 * j4);
#pragma unroll
                    for (int j = 0; j < i; ++j) tv[i] -= lv[j] * tv[j];
                    asm volatile("" ::: "memory");
                }
#pragma unroll
                for (int i = 0; i < 16; ++i) *(LAS bf16_t*)(L3 + R1_TINV + ((blk * 16 + i) * 32 + col) * 2) = (bf16_t)f2bf(tv[i]);
            }
        }
        __syncthreads();
        {
            R1_LANES
            const int g1 = g & 1;
            const LAS unsigned char* Rsrc = (w < 4) ? (L3 + R1_KAP + 32 * w) : (L3 + R1_AKV + 32 * (w - 4));
            f32x4 xr[4];
#pragma unroll
            for (int bi = 0; bi < 4; ++bi) {
                const bf16x8 ta = *(const LAS bf16x8*)(L3 + R1_TINV + ((bi * 16 + li) * 32 + 8 * g) * 2);
                const bf16x8 rb = tr8(Rsrc + (16 * bi + 8 * g1 + q4) * R1_RS + 8 * p4, 4 * R1_RS);
                xr[bi] = __builtin_amdgcn_mfma_f32_16x16x32_bf16(ta, rb, (f32x4){0.f, 0.f, 0.f, 0.f}, 0, 0, 0);
            }
            if (w < 6) {
                const int bi = w < 1 ? 1 : (w < 3 ? 2 : 3), bj = w < 1 ? 0 : (w < 3 ? w - 1 : w - 3);
                const bf16x8 ta = *(const LAS bf16x8*)(L3 + R1_TINV + ((bi * 16 + li) * 32 + 8 * g) * 2);
                const bf16x8 lb = tr8(L3 + R1_ABO + (16 * bi + 8 * g1 + q4) * R1_RS + 32 * bj + 8 * p4, 4 * R1_RS);
                const f32x4 lp = __builtin_amdgcn_mfma_f32_16x16x32_bf16(ta, lb, (f32x4){0.f, 0.f, 0.f, 0.f}, 0, 0, 0);
#pragma unroll
                for (int r = 0; r < 4; ++r) *(LAS bf16_t*)(L3 + R1_LP + (16 * bi + 4 * g + r) * R1_RS + (16 * bj + li) * 2) = (bf16_t)f2bf(lp[r]);
            }
            __syncthreads();
#pragma unroll
            for (int bi = 0; bi < 4; ++bi) {
                if (bi > 0) {
                    f32x4 acc = (f32x4){0.f, 0.f, 0.f, 0.f};
#pragma unroll
                    for (int ks = 0; ks < (bi + 1) / 2; ++ks) {
                        const bf16x8 a = *(const LAS bf16x8*)(L3 + R1_LP + (16 * bi + li) * R1_RS + (32 * ks + 8 * g) * 2);
                        const bf16x8 bx = tr8(L3 + R1_XB + (32 * ks + 8 * g + q4) * R1_XRS + 32 * w + 8 * p4, 4 * R1_XRS);
                        acc = __builtin_amdgcn_mfma_f32_16x16x32_bf16(a, bx, acc, 0, 0, 0);
                    }
                    xr[bi] = xr[bi] - acc;
                }
#pragma unroll
                for (int r = 0; r < 4; ++r) *(LAS bf16_t*)(L3 + R1_XB + (16 * bi + 4 * g + r) * R1_XRS + (16 * w + li) * 2) = (bf16_t)f2bf(xr[bi][r]);
                asm volatile("s_waitcnt lgkmcnt(0)" ::: "memory");
            }
        }
        __syncthreads();
        {
            R1_LANES
            f32x4 gx[2], yx[2], mx[2], nx[2];
#pragma unroll
            for (int n = 0; n < 2; ++n) { gx[n] = (f32x4){0.f, 0.f, 0.f, 0.f}; yx[n] = gx[n]; mx[n] = gx[n]; nx[n] = gx[n]; }
            mm_tiles<false, true>(L3 + R1_BB, R1_RS, L3 + R1_XB, R1_XRS, 2, gx, mt, nt0, g, li);
            mm_tiles<false, true>(L3 + R1_BB, R1_RS, L3 + R1_XB + 128, R1_XRS, 2, yx, mt, nt0, g, li);
            mm_tiles<true, true>(L3 + R1_BT, R1_RS, L3 + R1_XB, R1_XRS, 2, mx, mt, nt0, g, li);
            mm_tiles<true, true>(L3 + R1_BT, R1_RS, L3 + R1_XB + 128, R1_XRS, 2, nx, mt, nt0, g, li);
            const f32x4 elc = *(const LAS f32x4*)(L3 + R1_ELC + (16 * mt + 4 * g) * 4);
#pragma unroll
            for (int n = 0; n < 2; ++n) {
                const int col = 16 * (nt0 + n) + li;
                float nv[4];
#pragma unroll
                for (int r = 0; r < 4; ++r) {
                    const int rw = 16 * mt + 4 * g + r, o = rw * R1_RS + col * 2;
                    const float rho = bf2f(*(const LAS bf16_t*)(L3 + R1_RHO + o));
                    *(LAS bf16_t*)(L3 + R1_AK + o) = (bf16_t)f2bf(rho - gx[n][r]);
                    *(LAS bf16_t*)(L3 + R1_ABO + o) = (bf16_t)f2bf(-elc[r] * mx[n][r]);
                    *(LAS bf16_t*)(L3 + R1_BK + o) = (bf16_t)f2bf(y0a[n][r] - yx[n][r]);
                    nv[r] = elc[r] * (na[n][r] - nx[n][r]);
                }
                u32x2 nf; nf.x = pk2(nv[0], nv[1]); nf.y = pk2(nv[2], nv[3]);
                st_b64(rec + CH_N + ((mt * 4 + nt0 + n) * 64 + lane) * 8, nf);
            }
        }
        __syncthreads();
        {
            R1_LANES
            const int fo = (16 * (w >> 1) + li) * R1_RS + (32 * (w & 1) + 8 * g) * 2;
            st_b128(rec + CH_G + (w * 64 + lane) * 16, *(const LAS u32x4*)(L3 + R1_AK + fo));
            st_b128(rec + CH_M + (w * 64 + lane) * 16, *(const LAS u32x4*)(L3 + R1_ABO + fo));
            if (lat) st_b128(Yo + (size_t)row * RW + 64 * h + c8, *(const LAS u32x4*)(L3 + R1_BK + t * R1_RS + c8 * 2));
        }
        __syncthreads();
    }
#undef R1_LANES
}

constexpr int R2_SB = 0, R2_SRS = 80, R2_SBB = 64 * R2_SRS;
struct R2Regs { bf16x8 am[2], ag[2]; u32x2 nf; f32x4 el; bf16_t y0[4]; };
__device__ __forceinline__ void phase_r2(const P& p, LAS unsigned char* L3, int task, unsigned pflags) {
    int tid_ = threadIdx.x; asm volatile("" : "+v"(tid_));
    const int tid = tid_, lane = tid & 63, w = __builtin_amdgcn_readfirstlane(tid >> 6), g = lane >> 4, li = lane & 15, q4 = li >> 2, p4 = li & 3;
    const int stream = task >> 1, vh = task & 1, dir = stream >> 5, b = (stream >> 4) & 1, h = stream & 15;
    const int kt = w >> 1, vt = w & 1, vtg = 2 * vh + vt;
    bf16_t* Yo = (bf16_t*)(p.ws + (dir ? WS_YB : WS_YF));
    const unsigned char* rec0 = p.ws + WS_CHD + (size_t)stream * NCHUNK * CH_REC;
    auto rlow = [&](int c) -> int { const int r0 = step_row(64 * c, b, dir); return dir ? r0 - 63 : r0; };
    unsigned offY[4];
#pragma unroll
    for (int r = 0; r < 4; ++r) { const int j = 16 * kt + 4 * g + r; offY[r] = (unsigned)((dir ? 63 - j : j) * (RW * 2) + (16 * vtg + li) * 2); }
    unsigned char* Yb = (unsigned char*)Yo + 64 * h * 2;
    const unsigned offA0 = (unsigned)(((kt * 2 + 0) * 64 + lane) * 16), offA1 = (unsigned)(((kt * 2 + 1) * 64 + lane) * 16), offN = (unsigned)(CH_N + ((kt * 4 + vtg) * 64 + lane) * 8), offE = (unsigned)(CH_E + (16 * kt + 4 * g) * 4);
    auto loadstep = [&](int c, R2Regs& R) {
        if (pflags & 128u) return;
        const unsigned char* rec = rec0 + (size_t)c * CH_REC;
        R.am[0] = *(const bf16x8*)(rec + CH_M + offA0); R.am[1] = *(const bf16x8*)(rec + CH_M + offA1); R.ag[0] = *(const bf16x8*)(rec + CH_G + offA0); R.ag[1] = *(const bf16x8*)(rec + CH_G + offA1);
        R.nf = *(const u32x2*)(rec + offN);
        R.el = *(const f32x4*)(rec + offE);
        if (c >= LC / 64) {
            const unsigned char* yb = Yb + (size_t)rlow(c) * (RW * 2);
#pragma unroll
            for (int r = 0; r < 4; ++r) R.y0[r] = *(const bf16_t*)(yb + offY[r]);
        }
    };
    f32x4 S = (f32x4){0.f, 0.f, 0.f, 0.f};
    auto step = [&](int c, const R2Regs& R) {
        LAS unsigned char* SB = L3 + R2_SB + (c & 1) * R2_SBB;
        bf16x8 bs[2] = {(bf16x8){0, 0, 0, 0, 0, 0, 0, 0}, (bf16x8){0, 0, 0, 0, 0, 0, 0, 0}};
        if (!(pflags & 256u)) {
#pragma unroll
        for (int r = 0; r < 4; ++r) *(LAS bf16_t*)(SB + (16 * kt + 4 * g + r) * R2_SRS + (16 * vt + li) * 2) = (bf16_t)f2bf(S[r]);
        __syncthreads();
#pragma unroll
        for (int ks = 0; ks < 2; ++ks) bs[ks] = tr8(SB + (32 * ks + 8 * g + q4) * R2_SRS + 32 * vt + 8 * p4, 4 * R2_SRS);
        }
        f32x4 ns; ns[0] = R.el[0] * S[0] + bflo(R.nf.x); ns[1] = R.el[1] * S[1] + bfhi(R.nf.x); ns[2] = R.el[2] * S[2] + bflo(R.nf.y); ns[3] = R.el[3] * S[3] + bfhi(R.nf.y);
        f32x4 ya = (f32x4){0.f, 0.f, 0.f, 0.f};
        const bool lat = c >= LC / 64;
        if (lat) { ya[0] = bf2f(R.y0[0]); ya[1] = bf2f(R.y0[1]); ya[2] = bf2f(R.y0[2]); ya[3] = bf2f(R.y0[3]); }
#pragma unroll
        for (int ks = 0; ks < 2; ++ks) { ns = __builtin_amdgcn_mfma_f32_16x16x32_bf16(R.am[ks], bs[ks], ns, 0, 0, 0); ya = __builtin_amdgcn_mfma_f32_16x16x32_bf16(R.ag[ks], bs[ks], ya, 0, 0, 0); }
        if (lat && !(pflags & 512u)) {
            unsigned char* yb = Yb + (size_t)rlow(c) * (RW * 2);
#pragma unroll
            for (int r = 0; r < 4; ++r) st_b16(yb + offY[r], f2bf(ya[r]));
        }
        S = ns;
    };
    R2Regs Q0, Q1, Q2, Q3, Q4, Q5;
    loadstep(0, Q0); loadstep(1, Q1); loadstep(2, Q2); loadstep(3, Q3); loadstep(4, Q4);
#define R2_STEP(k, QL, QS) { if (c + (k) + 5 < NCHUNK) loadstep(c + (k) + 5, QL); if (c + (k) < NCHUNK) step(c + (k), QS); }
    for (int c = 0; c < NCHUNK; c += 6) {
        R2_STEP(0, Q5, Q0) R2_STEP(1, Q0, Q1) R2_STEP(2, Q1, Q2) R2_STEP(3, Q2, Q3) R2_STEP(4, Q3, Q4) R2_STEP(5, Q4, Q5)
    }
#undef R2_STEP
    __syncthreads();
}
constexpr int TR_SCR = 64 * 65 * 4;
__device__ __forceinline__ void transpose_item(const float* W, int K, int N, int Npad, bf16_t* WT, int row_off, LAS float* scr, int item, int lane) {
    const int nblk = Npad / 64, kb = item / nblk, nb = item % nblk, k0 = 64 * kb, n0 = 64 * nb;
    const int n4 = (lane & 15) * 4, kq = lane >> 4;
    f32x4 v[16];
#pragma unroll
    for (int i = 0; i < 16; ++i) v[i] = (n0 + n4 < N) ? *(const f32x4*)(W + (size_t)(k0 + 4 * i + kq) * N + n0 + n4) : (f32x4){0.f, 0.f, 0.f, 0.f};
#pragma unroll
    for (int i = 0; i < 16; ++i) { LAS float* d = scr + (4 * i + kq) * 65 + n4; d[0] = v[i].x; d[1] = v[i].y; d[2] = v[i].z; d[3] = v[i].w; }
    LDS_WAIT(); asm volatile("" ::: "memory");
    const int c = lane & 7;
#pragma unroll
    for (int j = 0; j < 8; ++j) { const int n = (lane >> 3) + 8 * j; const LAS float* s = scr + (8 * c) * 65 + n;
        v4u o; o.x = pk2(s[0 * 65], s[1 * 65]); o.y = pk2(s[2 * 65], s[3 * 65]); o.z = pk2(s[4 * 65], s[5 * 65]); o.w = pk2(s[6 * 65], s[7 * 65]);
        *(GAS v4u*)(WT + (size_t)(row_off + n0 + n) * K + k0 + 8 * c) = o; }
    LDS_WAIT(); asm volatile("" ::: "memory");
}

constexpr int RING_OFF = 0, RING_BYTES = 131072;
constexpr int LDS_BYTES = 147456;
constexpr int LDSCTL_OFF = LDS_BYTES - 512, MISC_OFF = LDSCTL_OFF + 320, PARAM_OFF = LDS_BYTES - 1024;
__device__ __forceinline__ P load_params(const LAS unsigned* src) {
    P q; void** d = (void**)&q;
#pragma unroll
    for (int i = 0; i < 32; ++i) {
        const unsigned long long v = (unsigned long long)(unsigned)__builtin_amdgcn_readfirstlane((int)src[2 * i]) | ((unsigned long long)(unsigned)__builtin_amdgcn_readfirstlane((int)src[2 * i + 1]) << 32);
        d[i] = (void*)(GAS void*)v;
    }
    q.mask = 0u; q.pad = 0u;
    return q;
}
static_assert(8 * TR_SCR <= PARAM_OFF && ML_END <= PARAM_OFF && MI_END <= PARAM_OFF && R1_PAR + 1280 <= PARAM_OFF && sizeof(P) == 264, "LDS map");
constexpr int CW_BAR = 4096;
constexpr size_t CTL_ZERO_BYTES = 1 * MiB;
constexpr int NWAVES = 8;

__global__ void __launch_bounds__(NWAVES * 64, 2) mega_fwd(P p_arg) {
    extern __shared__ __attribute__((aligned(16))) unsigned char lds[];
    LAS unsigned char* L3 = (LAS unsigned char*)lds;
    volatile LAS unsigned* MISC = (volatile LAS unsigned*)(L3 + MISC_OFF);
    const int tid = threadIdx.x, lane = tid & 63, wave = __builtin_amdgcn_readfirstlane(tid >> 6);
    const int G = gridDim.x, bx = blockIdx.x;
    const int vcu = (G % 8 == 0) ? (bx % 8) * (G / 8) + bx / 8 : bx;
    for (int u = tid; u < (LDS_BYTES - LDSCTL_OFF) / 4; u += NWAVES * 64) ((LAS unsigned*)(L3 + LDSCTL_OFF))[u] = 0u;
    const LAS unsigned* PRM = (const LAS unsigned*)(L3 + PARAM_OFF);
    if (tid < 66) ((LAS unsigned*)(L3 + PARAM_OFF))[tid] = ((const unsigned*)__builtin_amdgcn_kernarg_segment_ptr())[tid];
    __syncthreads();
    XcdBarrier bar;
    { const P p = load_params(PRM); const unsigned region = (unsigned)__builtin_amdgcn_readfirstlane((int)PRM[65]); bar = xcd_barrier_post((unsigned*)(p.ws + WS_CTL) + CW_BAR + region * XCD_BAR_WORDS, MISC + 8); }
    const int gw = vcu * NWAVES + wave, ngw = G * NWAVES;
    const unsigned pflags = (unsigned)__builtin_amdgcn_readfirstlane((int)PRM[65]);
    const unsigned pmask = (unsigned)__builtin_amdgcn_readfirstlane((int)PRM[64]);
    int ph_idx_ = 0;
#define PH_BEGIN if ((pmask >> ph_idx_) & 1u) { const P p = load_params(PRM); unsigned char* ws = p.ws; const float* MOD = (const float*)(ws + WS_MOD); (void)MOD;
#define PH_END }
#define PH_BAR if ((pmask >> ph_idx_) & 1u) xcd_barrier(bar); ++ph_idx_;

    PH_BEGIN
    phase_mod(p, bx, G, (float*)lds);
    {
        LAS float* scr = (LAS float*)(L3 + RING_OFF + wave * TR_SCR);
        constexpr int I_IN = (D / 64) * (LDP / 64), I_OUT = (D / 64) * (D / 64);
        for (int it = gw; it < I_IN + I_OUT; it += ngw) {
            if (it < I_IN) transpose_item(p.w_in, D, NIN, LDP, (bf16_t*)(ws + WS_WIN_T), 0, scr, it, lane);
            else transpose_item(p.w_out, D, D, D, (bf16_t*)(ws + WS_WOUT_T), 0, scr, it - I_IN, lane);
        }
    }
    {
        bf16_t* WUPT = (bf16_t*)(ws + WS_WUPT); bf16_t* AUPT = (bf16_t*)(ws + WS_AUPT); bf16_t* GUPT = (bf16_t*)(ws + WS_GUPT);
        const int gt = bx * (NWAVES * 64) + tid, ngt = G * NWAVES * 64;
        for (int o = gt; o < 2 * 1024 * 64; o += ngt) { const int r = o & 63, c = (o >> 6) & 1023, d = o >> 16; const size_t si = (size_t)(d * 64 + r) * RW + c; WUPT[o] = (bf16_t)f2bf(p.r_w_up[si]); AUPT[o] = (bf16_t)f2bf(p.r_a_up[si]); }
        for (int o = gt; o < 1024 * 160; o += ngt) { const int i = o % 160, c = o / 160; GUPT[o] = (bf16_t)f2bf(p.r_g_up[(size_t)i * RW + c]); }
    }
    PH_END
    PH_BAR
    PH_BEGIN
    phase_normmod(p, 0, gw, ngw, lane);
    PH_END
    PH_BAR
    PH_BEGIN
    {
        pg8::Gemm g{(const bf16_t*)(ws + WS_HX), (const bf16_t*)(ws + WS_WIN_T), NROW, LDP, D}; pg8::StaticOrder S; S.init(NROW, LDP, G, bx);
        pg8::EpiBf16<0> E{(bf16_t*)(ws + WS_PROJ), LDP, nullptr, 0, 0, 1.f};
        pg8::gemm_phase<pg8::EpiBf16<0>, pg8::StaticOrder, true, true>(L3 + RING_OFF, g, S, E);
    }
    PH_END
    PH_BAR
    PH_BEGIN
    if (!(pflags & 8u)) phase_prep(p, bx, G);
    if (!(pflags & 16u)) phase_r1(p, L3, bx, G, pflags);
    PH_END
    PH_BAR
    PH_BEGIN
    phase_mintra(p, L3, bx, G);
    PH_END
    PH_BAR
    PH_BEGIN
    if (bx < 128) { if (!(pflags & 2u)) phase_mlstm(p, L3, bx); } else if (bx < 256) { if (!(pflags & 4u)) phase_r2(p, L3, bx - 128, pflags); }
    PH_END
    PH_BAR
    PH_BEGIN
    phase_post(p, gw, ngw, lane);
    PH_END
    PH_BAR
    PH_BEGIN
    {
        pg8::Gemm g{(const bf16_t*)(ws + WS_MIX), (const bf16_t*)(ws + WS_WOUT_T), NTOK, D, D}; pg8::StaticOrder S; S.init(NTOK, D, G, bx);
        pg8::EpiResid E{p.x, p.out, D, MOD + 2 * 2048, NMOD};
        pg8::gemm_phase<pg8::EpiResid, pg8::StaticOrder, true, true>(L3 + RING_OFF, g, S, E);
    }
    PH_END
    PH_BAR
    PH_BEGIN
    phase_normmod(p, 1, gw, ngw, lane);
    {
        LAS float* scr = (LAS float*)(L3 + RING_OFF + wave * TR_SCR);
        constexpr int I_UP = (D / 64) * (FF / 64), I_DN = (FF / 64) * (D / 64);
        for (int it = gw; it < 2 * I_UP + I_DN; it += ngw) {
            if (it < I_UP) transpose_item(p.f_w_up, D, FF, FF, (bf16_t*)(ws + WS_WUG_T), 0, scr, it, lane);
            else if (it < 2 * I_UP) transpose_item(p.f_w_gate, D, FF, FF, (bf16_t*)(ws + WS_WUG_T), FF, scr, it - I_UP, lane);
            else transpose_item(p.f_w_down, FF, D, D, (bf16_t*)(ws + WS_WDN_T), 0, scr, it - 2 * I_UP, lane);
        }
    }
    PH_END
    PH_BAR
    PH_BEGIN
    {
        pg8::Gemm g{(const bf16_t*)(ws + WS_HX2), (const bf16_t*)(ws + WS_WUG_T), NTOK, 2 * FF, D}; pg8::StaticOrder S; S.init(NTOK, 2 * FF, G, bx);
        pg8::EpiBf16<0> E{(bf16_t*)(ws + WS_UG), 2 * FF, nullptr, 0, 0, 1.f};
        pg8::gemm_phase<pg8::EpiBf16<0>, pg8::StaticOrder, true, true>(L3 + RING_OFF, g, S, E);
    }
    PH_END
    PH_BAR
    PH_BEGIN
    phase_convact(p, gw, lane);
    PH_END
    PH_BAR
    PH_BEGIN
    {
        pg8::Gemm g{(const bf16_t*)(ws + WS_ACT), (const bf16_t*)(ws + WS_WDN_T), NTOK, D, FF}; pg8::StaticOrder S; S.init(NTOK, D, G, bx);
        pg8::EpiResid E{p.out, p.out, D, MOD + 5 * 2048, NMOD};
        pg8::gemm_phase<pg8::EpiResid, pg8::StaticOrder, true, true>(L3 + RING_OFF, g, S, E);
    }
    PH_END
    PH_BAR
    PH_BEGIN
    phase_final(p, gw, ngw, lane);
    PH_END
#undef PH_BEGIN
#undef PH_END
#undef PH_BAR
}

extern "C" void kernel_launch(void* const* d_in, const int* in_sizes, int n_in, void* d_out, int out_size, void* d_ws, size_t ws_size, hipStream_t stream) {
    static int grid = 0;
    if (grid == 0) {
        if (n_in != 30 || out_size != NTOK * D || ws_size < WS_END) { fprintf(stderr, "kernel_launch: unexpected n_in %d / out %d / ws %zu\n", n_in, out_size, ws_size); grid = -1; return; }
        int dev = 0, cus = 0, per_cu = 0;
        if (hipGetDevice(&dev) != hipSuccess || hipDeviceGetAttribute(&cus, hipDeviceAttributeMultiprocessorCount, dev) != hipSuccess) { grid = -1; return; }
        if (hipFuncSetAttribute((const void*)mega_fwd, hipFuncAttributeMaxDynamicSharedMemorySize, LDS_BYTES) != hipSuccess) { fprintf(stderr, "kernel_launch: hipFuncSetAttribute failed\n"); grid = -1; return; }
        if (hipOccupancyMaxActiveBlocksPerMultiprocessor(&per_cu, (const void*)mega_fwd, NWAVES * 64, LDS_BYTES) != hipSuccess || per_cu < 1) fprintf(stderr, "kernel_launch: occupancy query reports %d\n", per_cu);
        (void)hipGetLastError();
        grid = cus;
    }
    if (grid < 0) return;
    if (hipMemsetAsync((char*)d_ws + WS_CTL, 0, CTL_ZERO_BYTES, stream) != hipSuccess) { fprintf(stderr, "kernel_launch: memset failed\n"); return; }
    P p{};
    const float** f = (const float**)&p;
    for (int i = 0; i < 30; ++i) f[i] = (const float*)d_in[i];
    p.out = (float*)d_out; p.ws = (unsigned char*)d_ws; p.mask = 0x1FFFu;
    hipLaunchKernelGGL(mega_fwd, dim3(grid), dim3(NWAVES * 64), LDS_BYTES, stream, p);
#ifdef PROBE_PHASE
#ifndef PROBE_FLAGS
#define PROBE_FLAGS 0u
#endif
    { P q = p; q.mask = PROBE_PHASE; q.pad = 1u | (PROBE_FLAGS); hipLaunchKernelGGL(mega_fwd, dim3(grid), dim3(NWAVES * 64), LDS_BYTES, stream, q); }
#endif
}
```

```cpp
#include <hip/hip_runtime.h>
#include <cstdint>
#include <cstdio>
namespace pg8 {
#define PG8_LAS __attribute__((address_space(3)))
typedef unsigned short bf16_t;
typedef short bf16x8 __attribute__((ext_vector_type(8)));
typedef float f32x4 __attribute__((ext_vector_type(4)));
typedef unsigned u32x4 __attribute__((ext_vector_type(4)));
constexpr int BM = 256, BK = 64, HALF = 128, HTB = HALF * BK * 2  , STAGE_BYTES = 8 * HTB, NXCD = 8, WGM = 8;

__host__ __device__ __forceinline__ int lds_byte(int r, int c) { const int st = (r >> 4) * 2 + (c >> 5), rr = r & 15, cc = c & 31, ob = rr * 64 + cc * 2; return st * 1024 + (ob ^ (((ob >> 9) & 1) << 5)); }
__host__ __device__ __forceinline__ void stage_rc(int b, int& R, int& C) { const int st = b / 1024, sb = b % 1024, swz = sb ^ (((sb >> 9) & 1) << 5); R = (st >> 1) * 16 + swz / 64; C = (st & 1) * 32 + (swz % 64) / 2; }
__host__ __device__ __forceinline__ int perm32(int rho) { const int n = rho >> 4, i = rho & 15; return 8 * (i >> 2) + 4 * n + (i & 3); }

struct Unit { int pm, pn; };
struct Gemm { const bf16_t* A; const bf16_t* Bt; int M, N, K; };

struct StaticOrder {
    int nM, nN, nwg, G, c;
    __host__ __device__ void init(int M, int N, int G_, int c_) { nM = M / BM; nN = N / BM; nwg = nM * nN; G = G_; c = c_; }
    __host__ __device__ bool next(int i, Unit& u) const {
        const long L = (long)i * G + c; if (L >= nwg) return false;
        int wgid = (int)L; { const int q = nwg / NXCD, r = nwg % NXCD, xcd = wgid % NXCD, off = wgid / NXCD; wgid = (xcd < r ? xcd * (q + 1) : r * (q + 1) + (xcd - r) * q) + off; }
        const int nig = WGM * nN, gid = wgid / nig, fm = gid * WGM, gsz = (nM - fm) < WGM ? (nM - fm) : WGM;
        u.pm = fm + ((wgid % nig) % gsz); u.pn = (wgid % nig) / gsz; return true;
    }
    __device__ __forceinline__ void a_ready(const Unit&) const {}
    __device__ __forceinline__ void done(const Unit&) const {}
};

__device__ __forceinline__ unsigned cvt_pk_bf16(float lo, float hi) { unsigned r; asm volatile("v_cvt_pk_bf16_f32 %0, %1, %2" : "=v"(r) : "v"(lo), "v"(hi)); return r; }
typedef float f32x2 __attribute__((ext_vector_type(2)));
__device__ __forceinline__ f32x2 gelu_pk(f32x2 v) {
    const f32x2 av = __builtin_elementwise_abs(v), d = av * 0.2316418882f + 1.0f;
    f32x2 t; t.x = __builtin_amdgcn_rcpf(d.x); t.y = __builtin_amdgcn_rcpf(d.y);
    f32x2 q = t * 0.5307027145f + (-0.7265760135f); q = q * t + 0.7107068705f; q = q * t + (-0.142248368f); q = q * t + 0.127414796f; q = q * t;
    const f32x2 s = (v * v) * (-0.72134752044f);
    f32x2 e; e.x = __builtin_amdgcn_exp2f(s.x); e.y = __builtin_amdgcn_exp2f(s.y);
    const f32x2 m = v * (q * e), r = v - m;
    f32x2 o; o.x = v.x < 0.f ? m.x : r.x; o.y = v.y < 0.f ? m.y : r.y; return o;
}

template <int ACT  > struct EpiBf16 {
    static constexpr bool PERM = true, AFTER_DRAIN = false; static_assert(ACT == 0 || ACT == 1, "EpiBf16: ACT is 0 (none) or 1 (gelu_pk)");
    bf16_t* O; int ldc; const float* bias; int split_cols; size_t split_stride; float scale0;
    __device__ __forceinline__ void operator()(const f32x4 (&acc)[2][2][4][2], const Unit& u, int wr, int wc, int fr, int fq) const {
        const int row0 = u.pm * BM + wr * 64 + fr; int colt = u.pn * BM; bf16_t* base = O;
        float sc = 1.f; if (split_cols) { const int t = colt / split_cols; base += (size_t)t * split_stride; colt -= t * split_cols; if (t == 0) sc = scale0; }
        const int col0 = colt + wc * 32 + 8 * fq, bcol0 = u.pn * BM + wc * 32 + 8 * fq;
        f32x4 bv[2][2];
#pragma unroll
        for (int bj = 0; bj < 2; ++bj)
#pragma unroll
            for (int n = 0; n < 2; ++n) bv[bj][n] = bias ? *(const f32x4*)(bias + bcol0 + bj * HALF + 4 * n) : (f32x4){0.f, 0.f, 0.f, 0.f};
#pragma unroll
        for (int ai = 0; ai < 2; ++ai)
#pragma unroll
            for (int m = 0; m < 4; ++m) { bf16_t* rowp = base + (size_t)(row0 + ai * HALF + m * 16) * ldc + col0;
#pragma unroll
                for (int bj = 0; bj < 2; ++bj) { f32x4 v0 = acc[ai][bj][m][0] + bv[bj][0], v1 = acc[ai][bj][m][1] + bv[bj][1];
                    if (ACT == 1) { f32x2 a = gelu_pk((f32x2){v0[0], v0[1]}), b = gelu_pk((f32x2){v0[2], v0[3]}), c = gelu_pk((f32x2){v1[0], v1[1]}), d = gelu_pk((f32x2){v1[2], v1[3]});
                        v0 = (f32x4){a.x, a.y, b.x, b.y}; v1 = (f32x4){c.x, c.y, d.x, d.y}; }
                    v0 = v0 * sc; v1 = v1 * sc; u32x4 w; w.x = cvt_pk_bf16(v0[0], v0[1]); w.y = cvt_pk_bf16(v0[2], v0[3]); w.z = cvt_pk_bf16(v1[0], v1[1]); w.w = cvt_pk_bf16(v1[2], v1[3]);
                    *(u32x4*)(rowp + bj * HALF) = w; } }
    }
};
struct EpiResid {
    static constexpr bool PERM = false, AFTER_DRAIN = false;
    const float* base; float* out; int ldc; const float* gate; int gstride;
    __device__ __forceinline__ void operator()(const f32x4 (&acc)[2][2][4][2], const Unit& u, int wr, int wc, int fr, int fq) const {
        const int row0 = u.pm * BM + wr * 64 + fr, col0 = u.pn * BM + wc * 32 + 4 * fq;
        const float* g = gate + (size_t)((u.pm * BM) >> 12) * gstride + col0;
        f32x4 gv[2][2];
#pragma unroll
        for (int bj = 0; bj < 2; ++bj)
#pragma unroll
            for (int n = 0; n < 2; ++n) gv[bj][n] = *(const f32x4*)(g + bj * HALF + n * 16);
#pragma unroll
        for (int ai = 0; ai < 2; ++ai)
#pragma unroll
            for (int m = 0; m < 4; ++m) { const size_t off = (size_t)(row0 + ai * HALF + m * 16) * ldc + col0;
#pragma unroll
                for (int bj = 0; bj < 2; ++bj)
#pragma unroll
                    for (int n = 0; n < 2; ++n) { const f32x4 bs = *(const f32x4*)(base + off + bj * HALF + n * 16); *(f32x4*)(out + off + bj * HALF + n * 16) = bs + gv[bj][n] * acc[ai][bj][m][n]; } }
    }
};
template <class Epi, class Sched, bool ALIGN_EPI = false, bool SP2 = false>
__device__ __forceinline__ void gemm_phase(PG8_LAS unsigned char* lds, const Gemm g, const Sched& S, const Epi& E) {
    const int tid = threadIdx.x, wid = __builtin_amdgcn_readfirstlane(tid >> 6), lane = tid & 63, wr = wid >> 2, wc = wid & 3, fr = lane & 15, fq = lane >> 4;
    const int K = g.K, nt = K / BK;
    unsigned voffA[2], voffB[2];
#pragma unroll
    for (int i = 0; i < 2; ++i) { int R, C; stage_rc(tid * 16 + i * 8192, R, C); const int Rb = Epi::PERM ? ((R & ~31) + perm32(R & 31)) : R;
        voffA[i] = (unsigned)(R * K + C) * 2u; voffB[i] = (unsigned)(Rb * K + C) * 2u; }
    const size_t kstep = (size_t)(BK * 2);
    const size_t hstep = (size_t)HALF * K * 2;
    const size_t tstep = 2 * hstep;
    const unsigned ldsw = (unsigned)wid * 1024u;
    const int aoff = lds_byte(wr * 64 + fr, fq * 8), boff = lds_byte(wc * 32 + fr, fq * 8);
#define PG8_SA(b, h) (((b) * 2 + (h)) * HTB)
#define PG8_SB(b, h) ((4 + (b) * 2 + (h)) * HTB)
#define PG8_STAGE(bufoff, gbase, voff) do { _Pragma("unroll") for (int _i = 0; _i < 2; ++_i) \
        __builtin_amdgcn_global_load_lds((const unsigned*)((const char*)(gbase) + (voff)[_i]), (PG8_LAS unsigned*)(lds + (bufoff) + ldsw + _i * 8192), 16, 0, 0); } while (0)
#define PG8_LDA(dst, b, h) do { _Pragma("unroll") for (int m = 0; m < 4; ++m) _Pragma("unroll") for (int k = 0; k < 2; ++k) dst[m][k] = *(const PG8_LAS bf16x8*)(lds + PG8_SA(b, h) + aoff + m * 2048 + k * 1024); } while (0)
#define PG8_LDB(dst, b, h) do { _Pragma("unroll") for (int n = 0; n < 2; ++n) _Pragma("unroll") for (int k = 0; k < 2; ++k) dst[n][k] = *(const PG8_LAS bf16x8*)(lds + PG8_SB(b, h) + boff + n * 2048 + k * 1024); } while (0)
#define PG8_MMA(ai, bj, At, Bt) do { __builtin_amdgcn_s_setprio(1); _Pragma("unroll") for (int m = 0; m < 4; ++m) _Pragma("unroll") for (int n = 0; n < 2; ++n) _Pragma("unroll") for (int k = 0; k < 2; ++k) \
        acc[ai][bj][m][n] = __builtin_amdgcn_mfma_f32_16x16x32_bf16(Bt[n][k], At[m][k], acc[ai][bj][m][n], 0, 0, 0); __builtin_amdgcn_s_setprio(0); } while (0)
#define PG8_WAIT_V(n) asm volatile("s_waitcnt vmcnt(" #n ")" ::: "memory")
#define PG8_WAIT_L(n) asm volatile("s_waitcnt lgkmcnt(" #n ")" ::: "memory")
#define PG8_BAR __builtin_amdgcn_s_barrier()
#define PG8_SCHED __builtin_amdgcn_sched_barrier(0)
    Unit cur, nxt; int ui = 0;
    if (!S.next(0, cur)) return;
    f32x4 acc[2][2][4][2];
#pragma unroll
    for (int a = 0; a < 2; ++a)
#pragma unroll
        for (int b = 0; b < 2; ++b)
#pragma unroll
            for (int m = 0; m < 4; ++m)
#pragma unroll
                for (int n = 0; n < 2; ++n) acc[a][b][m][n] = (f32x4){0.f, 0.f, 0.f, 0.f};
    bf16x8 At[4][2], B0[2][2], B1[2][2];
    const char* cA = (const char*)g.A + (size_t)cur.pm * tstep; const char* cB = (const char*)g.Bt + (size_t)cur.pn * tstep;
    S.a_ready(cur);
    if constexpr (SP2) {
        PG8_STAGE(PG8_SB(0, 0), cB, voffB); PG8_STAGE(PG8_SB(0, 1), cB + hstep, voffB); PG8_STAGE(PG8_SA(0, 0), cA, voffA); PG8_STAGE(PG8_SA(0, 1), cA + hstep, voffA);
        if (wr == 1) PG8_BAR;
        PG8_WAIT_V(2); PG8_BAR;
        PG8_STAGE(PG8_SB(1, 0), cB + kstep, voffB); PG8_STAGE(PG8_SA(1, 0), cA + kstep, voffA); PG8_STAGE(PG8_SB(1, 1), cB + hstep + kstep, voffB);
        PG8_WAIT_V(6); PG8_BAR;
    } else {
        PG8_STAGE(PG8_SB(0, 0), cB, voffB); PG8_STAGE(PG8_SA(0, 0), cA, voffA); PG8_STAGE(PG8_SB(0, 1), cB + hstep, voffB); PG8_STAGE(PG8_SA(0, 1), cA + hstep, voffA);
        if (wr == 1) PG8_BAR;
        PG8_WAIT_V(4); PG8_BAR;
        PG8_STAGE(PG8_SB(1, 0), cB + kstep, voffB); PG8_STAGE(PG8_SA(1, 0), cA + kstep, voffA); PG8_STAGE(PG8_SB(1, 1), cB + hstep + kstep, voffB);
        PG8_WAIT_V(6); PG8_BAR;
    }
    for (;;) {
        const bool has_next = S.next(ui + 1, nxt);
        const char* nA = has_next ? (const char*)g.A + (size_t)nxt.pm * tstep : cA; const char* nB = has_next ? (const char*)g.Bt + (size_t)nxt.pn * tstep : cB;
        for (int t = 0; t < nt; t += 2) {
            const bool last = (t == nt - 2);
            const char* a1 = cA + (size_t)(t + 1) * kstep;
            const char* a2 = last ? nA : cA + (size_t)(t + 2) * kstep; const char* b2 = last ? nB : cB + (size_t)(t + 2) * kstep;
            const char* a3 = a2 + kstep; const char* b3 = b2 + kstep;
            if (last && has_next) S.a_ready(nxt);
            if constexpr (SP2) {
            PG8_LDB(B0, 0, 0); PG8_LDB(B1, 0, 1); PG8_SCHED; PG8_LDA(At, 0, 0); PG8_STAGE(PG8_SA(1, 1), a1 + hstep, voffA);
            PG8_WAIT_V(8); PG8_WAIT_L(0); PG8_BAR; PG8_MMA(0, 0, At, B0); PG8_MMA(0, 1, At, B1); PG8_BAR; PG8_SCHED;
            PG8_LDA(At, 0, 1); PG8_STAGE(PG8_SB(0, 0), b2, voffB); PG8_STAGE(PG8_SB(0, 1), b2 + hstep, voffB); PG8_STAGE(PG8_SA(0, 0), a2, voffA);
            PG8_WAIT_V(8); PG8_WAIT_L(0); PG8_BAR; PG8_MMA(1, 0, At, B0); PG8_MMA(1, 1, At, B1); PG8_BAR; PG8_SCHED;
            PG8_LDB(B0, 1, 0); PG8_LDB(B1, 1, 1); PG8_SCHED; PG8_LDA(At, 1, 0); PG8_STAGE(PG8_SA(0, 1), a2 + hstep, voffA);
            PG8_WAIT_V(8); PG8_WAIT_L(0); PG8_BAR; PG8_MMA(0, 0, At, B0); PG8_MMA(0, 1, At, B1); PG8_BAR; PG8_SCHED;
            PG8_LDA(At, 1, 1); PG8_STAGE(PG8_SB(1, 0), b3, voffB); PG8_STAGE(PG8_SB(1, 1), b3 + hstep, voffB); PG8_STAGE(PG8_SA(1, 0), a3, voffA);
            PG8_WAIT_V(8); PG8_WAIT_L(0); PG8_BAR; PG8_MMA(1, 0, At, B0); PG8_MMA(1, 1, At, B1); PG8_BAR; PG8_SCHED;
            } else {
            PG8_LDB(B0, 0, 0); PG8_SCHED; PG8_LDA(At, 0, 0); PG8_STAGE(PG8_SA(1, 1), a1 + hstep, voffA);
            PG8_WAIT_L(8); PG8_BAR; PG8_WAIT_L(0); PG8_MMA(0, 0, At, B0); PG8_BAR; PG8_SCHED;
            PG8_LDB(B1, 0, 1); PG8_STAGE(PG8_SB(0, 0), b2, voffB);
            PG8_BAR; PG8_WAIT_L(0); PG8_MMA(0, 1, At, B1); PG8_BAR;
            PG8_LDA(At, 0, 1); PG8_STAGE(PG8_SA(0, 0), a2, voffA);
            PG8_BAR; PG8_WAIT_L(0); PG8_MMA(1, 0, At, B0); PG8_BAR; PG8_SCHED;
            PG8_STAGE(PG8_SB(0, 1), b2 + hstep, voffB);
            PG8_WAIT_V(6); PG8_BAR; PG8_MMA(1, 1, At, B1); PG8_BAR;
            PG8_LDB(B0, 1, 0); PG8_SCHED; PG8_LDA(At, 1, 0); PG8_STAGE(PG8_SA(0, 1), a2 + hstep, voffA);
            PG8_WAIT_L(8); PG8_BAR; PG8_WAIT_L(0); PG8_MMA(0, 0, At, B0); PG8_BAR; PG8_SCHED;
            PG8_LDB(B1, 1, 1); PG8_STAGE(PG8_SB(1, 0), b3, voffB);
            PG8_BAR; PG8_WAIT_L(0); PG8_MMA(0, 1, At, B1); PG8_BAR;
            PG8_LDA(At, 1, 1); PG8_STAGE(PG8_SA(1, 0), a3, voffA);
            PG8_BAR; PG8_WAIT_L(0); PG8_MMA(1, 0, At, B0); PG8_BAR; PG8_SCHED;
            PG8_STAGE(PG8_SB(1, 1), b3 + hstep, voffB);
            PG8_WAIT_V(6); PG8_BAR; PG8_MMA(1, 1, At, B1); PG8_BAR;
            }
        }
        if constexpr (ALIGN_EPI) { if (wr == 0) PG8_BAR; }
        if constexpr (!Epi::AFTER_DRAIN) { E(acc, cur, wr, wc, fr, fq); S.done(cur); }
        if (!has_next) break;
#pragma unroll
        for (int a = 0; a < 2; ++a)
#pragma unroll
            for (int b = 0; b < 2; ++b)
#pragma unroll
                for (int m = 0; m < 4; ++m)
#pragma unroll
                    for (int n = 0; n < 2; ++n) acc[a][b][m][n] = (f32x4){0.f, 0.f, 0.f, 0.f};
        cur = nxt; cA = nA; cB = nB; ++ui;
        if constexpr (ALIGN_EPI) { if (wr == 1) PG8_BAR; }
    }
    PG8_WAIT_V(0);
    if constexpr (!ALIGN_EPI) { if (wr == 0) PG8_BAR; }
    PG8_BAR;
    if constexpr (Epi::AFTER_DRAIN) { E.fused(acc, cur, wr, wc, fr, fq, lds, wid, lane); S.done(cur); }
#undef PG8_SA
#undef PG8_SB
#undef PG8_STAGE
#undef PG8_LDA
#undef PG8_LDB
#undef PG8_MMA
#undef PG8_WAIT_V
#undef PG8_WAIT_L
#undef PG8_BAR
#undef PG8_SCHED
}
}
#define GAS __attribute__((address_space(1)))
#define LAS __attribute__((address_space(3)))
typedef unsigned short bf16;
typedef unsigned v4u __attribute__((ext_vector_type(4)));
typedef float f32x4 __attribute__((ext_vector_type(4)));
typedef short bf16x8 __attribute__((ext_vector_type(8)));
typedef GAS unsigned gu32;
typedef GAS unsigned long long gu64;
#define RLX_AGENT __ATOMIC_RELAXED, __HIP_MEMORY_SCOPE_AGENT
#define LDS_WAIT() asm volatile("s_waitcnt lgkmcnt(0)" ::: "memory")
#define VM_WAIT() asm volatile("s_waitcnt vmcnt(0)" ::: "memory")
__device__ __forceinline__ unsigned long long rt() { return __builtin_amdgcn_s_memrealtime(); }
typedef float f32x2_cv __attribute__((ext_vector_type(2))); typedef __bf16 bf16x2_cv __attribute__((ext_vector_type(2)));
__device__ __forceinline__ unsigned pk2(float lo, float hi) { f32x2_cv v = {lo, hi}; bf16x2_cv b = __builtin_convertvector(v, bf16x2_cv); return __builtin_bit_cast(unsigned, b); }
__device__ __forceinline__ unsigned f2bf(float f) { return pk2(f, 0.f) & 0xffffu; }

#define XB_TMO      128
#define XB_XCNT(j)  (256  + 64 * (j))
#define XB_XSUB(j)  (1280 + 64 * (j))
#define XB_XGEN(j)  (2304 + 64 * (j))
#define XB_TOP      3328
#define XB_TOPGEN   3392
#define XCD_BAR_WORDS 3456
#define XB_SPIN_CAP (1u << 18)

__device__ __forceinline__ unsigned xb_ld(unsigned* p)              { return __hip_atomic_load(p, __ATOMIC_RELAXED, __HIP_MEMORY_SCOPE_AGENT); }
__device__ __forceinline__ unsigned xb_add(unsigned* p, unsigned v) { return __hip_atomic_fetch_add(p, v, __ATOMIC_RELAXED, __HIP_MEMORY_SCOPE_AGENT); }
__device__ __forceinline__ unsigned xb_xcc_id() { return (unsigned)__builtin_amdgcn_s_getreg((3 << 11) | 20) & 0xFu; }
#define XB_SPIN(cond, bar) do { unsigned _sp = 0; while (cond) { __builtin_amdgcn_s_sleep(1); \
    if ((++_sp & 255u) == 0u) { if (xb_ld(&(bar)[XB_TMO])) break; if (_sp > XB_SPIN_CAP) { atomicAdd(&(bar)[XB_TMO], 1u); break; } } } } while (0)

struct XcdBarrier {
    unsigned* bar; unsigned x;
    volatile LAS unsigned* st;
};

__device__ __forceinline__ XcdBarrier xcd_barrier_post(unsigned* bar, volatile LAS unsigned* st) {
    XcdBarrier b; b.bar = bar; b.x = xb_xcc_id(); b.st = st;
    if (threadIdx.x == 0) (void)xb_add(&bar[XB_XCNT(b.x)], 1u);
    return b;
}
__device__ __forceinline__ void xcd_barrier_complete(unsigned* bar, unsigned x, unsigned& nloc, unsigned& nx) {
    const unsigned G = gridDim.x * gridDim.y * gridDim.z;
    unsigned sum, cnt, mine, sp = 0u;
    for (;;) {
        sum = 0u; cnt = 0u; mine = 0u;
#pragma unroll
        for (unsigned j = 0; j < 16; ++j) { const unsigned c = xb_ld(&bar[XB_XCNT(j)]); sum += c; cnt += (c > 0u) ? 1u : 0u; mine = (j == x) ? c : mine; }
        if (sum == G) break;
        __builtin_amdgcn_s_sleep(1);
        if ((++sp & 255u) == 0u) { if (xb_ld(&bar[XB_TMO])) break; if (sp > XB_SPIN_CAP) { atomicAdd(&bar[XB_TMO], 1u); break; } }
    }
    nloc = mine > 0u ? mine : 1u; nx = cnt > 0u ? cnt : 1u;
}

__device__ __forceinline__ void xcd_barrier(const XcdBarrier& b) {
    asm volatile("s_waitcnt vmcnt(0)" ::: "memory");
    __syncthreads();
    if (threadIdx.x == 0) {
        unsigned* bar = b.bar;
        __builtin_amdgcn_s_waitcnt(0);
        unsigned nloc = b.st[0], nx = b.st[1];
        if (nloc == 0u) { xcd_barrier_complete(bar, b.x, nloc, nx); b.st[0] = nloc; b.st[1] = nx; }
        const unsigned old = xb_add(&bar[XB_XSUB(b.x)], 1u);
        const unsigned gen = old / nloc;
        if (old + 1u == (gen + 1u) * nloc) {
            __builtin_amdgcn_fence(__ATOMIC_RELEASE, "agent");
            asm volatile("s_waitcnt vmcnt(0)" ::: "memory");
            const unsigned og = xb_add(&bar[XB_TOP], 1u);
            const unsigned tg = og / nx;
            if (og + 1u == (tg + 1u) * nx) xb_add(&bar[XB_TOPGEN], 1u);
            else XB_SPIN(xb_ld(&bar[XB_TOPGEN]) == tg, bar);
            __builtin_amdgcn_fence(__ATOMIC_ACQUIRE, "agent");
            xb_add(&bar[XB_XGEN(b.x)], 1u);
            asm volatile("s_waitcnt vmcnt(0)" ::: "memory");
        } else {
            XB_SPIN(xb_ld(&bar[XB_XGEN(b.x)]) == gen, bar);
            __builtin_amdgcn_fence(__ATOMIC_ACQUIRE, "agent");
            asm volatile("s_waitcnt vmcnt(0)" ::: "memory");
        }
    }
    __syncthreads();
}
typedef unsigned short bf16_t;
typedef float f32x2 __attribute__((ext_vector_type(2)));
typedef unsigned u32x4 __attribute__((ext_vector_type(4)));
typedef unsigned u32x2 __attribute__((ext_vector_type(2)));
__device__ __forceinline__ float bf2f(bf16_t v) { return __uint_as_float(((unsigned)v) << 16); }
__device__ __forceinline__ float bflo(unsigned w) { return __uint_as_float(w << 16); }
__device__ __forceinline__ float bfhi(unsigned w) { return __uint_as_float(w & 0xffff0000u); }
#ifdef DIAG_SLOT
#define DIAG_ON 1
#else
#define DIAG_ON 0
#endif
__device__ __forceinline__ unsigned long long tick() { return __builtin_amdgcn_s_memtime(); }
__device__ __forceinline__ void st_b16(void* ptr, unsigned v) { asm volatile("global_store_short %0, %1, off" :: "v"(ptr), "v"(v) : "memory"); }
__device__ __forceinline__ void st_b32(void* ptr, float v) { asm volatile("global_store_dword %0, %1, off" :: "v"(ptr), "v"(v) : "memory"); }
__device__ __forceinline__ void st_b64(void* ptr, u32x2 v) { asm volatile("global_store_dwordx2 %0, %1, off" :: "v"(ptr), "v"(v) : "memory"); }
__device__ __forceinline__ void st_b128(void* ptr, u32x4 v) { asm volatile("global_store_dwordx4 %0, %1, off\n\ts_nop 1" :: "v"(ptr), "v"(v) : "memory"); }
__device__ __forceinline__ void st_f128(void* ptr, f32x4 v) { asm volatile("global_store_dwordx4 %0, %1, off\n\ts_nop 1" :: "v"(ptr), "v"(v) : "memory"); }
__device__ __forceinline__ void unpack8(const u32x4 v, float (&o)[8]) { o[0] = bflo(v.x); o[1] = bfhi(v.x); o[2] = bflo(v.y); o[3] = bfhi(v.y); o[4] = bflo(v.z); o[5] = bfhi(v.z); o[6] = bflo(v.w); o[7] = bfhi(v.w); }
constexpr int D = 2048, NB = 2, L = 4096, LC = 256;
constexpr int NTOK = NB * L, NCTX = NB * LC, NROW = NTOK + NCTX;
constexpr int NIN = 6576, LDP = 6656;
constexpr int C_Q = 0, C_K = 512, C_VM = 1024, C_OM = 2048, C_G = 3072, C_R = 3088, C_KR = 4112, C_VR = 5136, C_LW = 6160, C_LA = 6288, C_LG = 6416;
constexpr int FF = 5632, NMOD = 12288;
constexpr int RW = 1024;
constexpr int NSTEP = LC + L;

constexpr size_t MiB = 1u << 20;
constexpr size_t WS_CTL = 0;
constexpr size_t WS_DIAG = 512 * 1024;
constexpr size_t WS_MOD = 1 * MiB;
constexpr size_t WS_GATES = 2 * MiB;
constexpr size_t WS_BONUS = 3 * MiB;
constexpr size_t WS_BONUS_B = 4 * MiB;
constexpr size_t WS_DENS = 7 * MiB;
constexpr size_t WS_WUPT = 5 * MiB;
constexpr size_t WS_AUPT = 5 * MiB + 256 * 1024;
constexpr size_t WS_GUPT = 5 * MiB + 512 * 1024;
constexpr size_t WS_WOUT_T = 8 * MiB;
constexpr size_t WS_WIN_T = 16 * MiB;
constexpr size_t WS_HX = 42 * MiB;
constexpr size_t WS_KK = 16 * MiB;
constexpr size_t WS_QC = 33 * MiB;
constexpr size_t WS_KC = 42 * MiB;
constexpr size_t WS_GG = 51 * MiB;
constexpr size_t WS_PROJ = 76 * MiB;
constexpr size_t WS_LWF = 187 * MiB;
constexpr size_t WS_LWB = 204 * MiB;
constexpr size_t WS_AF = 221 * MiB;
constexpr size_t WS_AB = 238 * MiB;
constexpr size_t WS_CHD = 187 * MiB;
constexpr size_t WS_YF = 291 * MiB;
constexpr size_t WS_YB = 307 * MiB;
constexpr size_t WS_HF = 323 * MiB;
constexpr size_t WS_HB = 339 * MiB;
constexpr size_t WS_MIX = 187 * MiB;
constexpr size_t WS_HX2 = 8 * MiB;
constexpr size_t WS_WUG_T = 40 * MiB;
constexpr size_t WS_WDN_T = 84 * MiB;
constexpr size_t WS_UG = 106 * MiB;
constexpr size_t WS_ACT = 282 * MiB;
constexpr size_t WS_END = 370 * MiB;

struct P {
    const float *x, *c, *ctx, *c_ctx, *w_mod, *b_mod, *g_norm1, *g_norm2, *w_in, *m_conv_w, *m_conv_b, *m_gate_b, *m_norm_g;
    const float *r_w0, *r_w_up, *r_a0, *r_a_up, *r_g_up, *r_k_k, *r_k_a, *r_r_k, *r_gn_w, *r_gn_b, *w_out, *f_w_up, *f_w_gate, *f_conv_w, *f_conv_b, *f_w_down, *g_final;
    float* out; unsigned char* ws; unsigned mask, pad;
};

__device__ __forceinline__ float wave_sum(float v) {
#pragma unroll
    for (int o = 1; o < 64; o <<= 1) v += __shfl_xor(v, o);
    return v;
}
__device__ __forceinline__ float sigmoidf_(float x) { return 1.f / (1.f + __expf(-x)); }
__device__ __forceinline__ float softplusf_(float x) { return fmaxf(x, 0.f) + log1pf(__expf(-fabsf(x))); }

__device__ __forceinline__ void row_seq(int r, int& base, int& t, int& len) {
    if (r < NTOK) { base = r & ~(L - 1); t = r & (L - 1); len = L; } else { const int q = r - NTOK; base = NTOK + (q & ~(LC - 1)); t = q & (LC - 1); len = LC; }
}
__device__ __forceinline__ int step_row(int s, int b, int dir) {
    if (s < LC) { const int t = dir ? (LC - 1 - s) : s; return NTOK + b * LC + t; }
    const int u = s - LC; const int t = dir ? (L - 1 - u) : u; return b * L + t;
}

__device__ __forceinline__ void phase_mod(const P& p, int bid, int nb, float* lds) {
    float* sc = lds;
    float* red = lds + 3 * 2048;
    const int tid = threadIdx.x;
    for (int i = tid; i < 3 * 2048; i += blockDim.x) { const int v = i >> 11, k = i & 2047; const float xv = v < 2 ? p.c[v * 2048 + k] : p.c_ctx[k]; sc[i] = xv / (1.f + __expf(-xv)); }
    __syncthreads();
    float* MOD = (float*)(p.ws + WS_MOD);
    for (int cb = bid; cb < NMOD / 48; cb += nb) {
        const int cg = tid % 12, kl = tid / 12;
        float a[3][4];
#pragma unroll
        for (int v = 0; v < 3; ++v)
#pragma unroll
            for (int j = 0; j < 4; ++j) a[v][j] = 0.f;
        if (kl < 42) {
            for (int k = kl; k < 2048; k += 42) {
                const f32x4 w = *(const f32x4*)(p.w_mod + (size_t)k * NMOD + cb * 48 + cg * 4);
#pragma unroll
                for (int v = 0; v < 3; ++v) { const float s = sc[v * 2048 + k]; a[v][0] += s * w.x; a[v][1] += s * w.y; a[v][2] += s * w.z; a[v][3] += s * w.w; }
            }
#pragma unroll
            for (int v = 0; v < 3; ++v)
#pragma unroll
                for (int j = 0; j < 4; ++j) red[kl * 144 + v * 48 + cg * 4 + j] = a[v][j];
        }
        __syncthreads();
        if (tid < 144) {
            float s = 0.f;
            for (int k = 0; k < 42; ++k) s += red[k * 144 + tid];
            const int v = tid / 48, cc = tid % 48;
            MOD[v * NMOD + cb * 48 + cc] = s + p.b_mod[cb * 48 + cc];
        }
        __syncthreads();
    }
}

__device__ __forceinline__ void normmod_row(const float* src, const float* g, const float* sh, const float* sc, bf16_t* dst, int lane) {
    f32x4 v[8]; float s = 0.f;
#pragma unroll
    for (int j = 0; j < 8; ++j) { v[j] = *((const f32x4*)src + lane + 64 * j); s += (v[j].x * v[j].x + v[j].y * v[j].y) + (v[j].z * v[j].z + v[j].w * v[j].w); }
    const float rs = rsqrtf(wave_sum(s) * (1.f / D) + 1e-6f);
#pragma unroll
    for (int j = 0; j < 8; ++j) {
        const f32x4 gg = *((const f32x4*)g + lane + 64 * j), a = *((const f32x4*)sc + lane + 64 * j), b = *((const f32x4*)sh + lane + 64 * j);
        const float o0 = v[j].x * rs * gg.x * (1.f + a.x) + b.x, o1 = v[j].y * rs * gg.y * (1.f + a.y) + b.y, o2 = v[j].z * rs * gg.z * (1.f + a.z) + b.z, o3 = v[j].w * rs * gg.w * (1.f + a.w) + b.w;
        u32x2 w; w.x = pk2(o0, o1); w.y = pk2(o2, o3);
        *((u32x2*)dst + lane + 64 * j) = w;
    }
}
__device__ __forceinline__ void phase_normmod(const P& p, int which, int gw, int ngw, int lane) {
    const float* MOD = (const float*)(p.ws + WS_MOD);
    if (which == 0) {
        bf16_t* HX = (bf16_t*)(p.ws + WS_HX);
        for (int r = gw; r < NROW; r += ngw) {
            const float* src = r < NTOK ? p.x + (size_t)r * D : p.ctx + (size_t)(r - NTOK) * D;
            const int v = r < NTOK ? (r >> 12) : 2;
            normmod_row(src, p.g_norm1, MOD + v * NMOD + 0, MOD + v * NMOD + 2048, HX + (size_t)r * D, lane);
        }
    } else {
        bf16_t* HX2 = (bf16_t*)(p.ws + WS_HX2);
        for (int r = gw; r < NTOK; r += ngw) {
            const int v = r >> 12;
            normmod_row(p.out + (size_t)r * D, p.g_norm2, MOD + v * NMOD + 3 * 2048, MOD + v * NMOD + 4 * 2048, HX2 + (size_t)r * D, lane);
        }
    }
}

__device__ __forceinline__ void phase_lora_ref(const P& p, int bid, int nb, float* lds) {
    float* tl = lds;
    float* la = lds + 128;
    float* sg = lds + 256;
    const bf16_t* PROJ = (const bf16_t*)(p.ws + WS_PROJ);
    bf16_t* LW[2] = {(bf16_t*)(p.ws + WS_LWF), (bf16_t*)(p.ws + WS_LWB)};
    bf16_t* AA[2] = {(bf16_t*)(p.ws + WS_AF), (bf16_t*)(p.ws + WS_AB)};
    bf16_t* GG = (bf16_t*)(p.ws + WS_GG);
    const int tid = threadIdx.x;
    for (int r = bid; r < NROW; r += nb) {
        const bf16_t* pr = PROJ + (size_t)r * LDP;
        if (tid < 128) tl[tid] = tanhf(bf2f(pr[C_LW + tid]));
        else if (tid < 256) la[tid - 128] = bf2f(pr[C_LA + tid - 128]);
        else if (tid < 416) sg[tid - 256] = sigmoidf_(bf2f(pr[C_LG + tid - 256]));
        __syncthreads();
        for (int c = tid; c < RW; c += blockDim.x) {
#pragma unroll
            for (int d = 0; d < 2; ++d) {
                float aw = p.r_w0[d * RW + c], aa = p.r_a0[d * RW + c];
                for (int k = 0; k < 64; ++k) { aw += tl[d * 64 + k] * p.r_w_up[(size_t)(d * 64 + k) * RW + c]; aa += la[d * 64 + k] * p.r_a_up[(size_t)(d * 64 + k) * RW + c]; }
                const float wlog = -softplusf_(-aw) - 0.5f;
                LW[d][(size_t)r * RW + c] = (bf16_t)f2bf(-__expf(wlog));
                AA[d][(size_t)r * RW + c] = (bf16_t)f2bf(sigmoidf_(aa));
            }
            if (r < NTOK) {
                float g = 0.f;
                for (int k = 0; k < 160; ++k) g += sg[k] * p.r_g_up[(size_t)k * RW + c];
                GG[(size_t)r * RW + c] = (bf16_t)f2bf(g);
            }
        }
        __syncthreads();
    }
}

__device__ __forceinline__ void phase_prep(const P& p, int bid, int nb) {
    const bf16_t* PROJ = (const bf16_t*)(p.ws + WS_PROJ);
    bf16_t* QC = (bf16_t*)(p.ws + WS_QC); bf16_t* KC = (bf16_t*)(p.ws + WS_KC);
    float* GATES = (float*)(p.ws + WS_GATES);
    const int tid = threadIdx.x, rl = tid >> 7, c0 = (tid & 127) * 8;
    float cw[3][8], cb[8];
#pragma unroll
    for (int k = 0; k < 3; ++k) { *(f32x4*)&cw[k][0] = *(const f32x4*)(p.m_conv_w + k * 1024 + c0); *(f32x4*)&cw[k][4] = *(const f32x4*)(p.m_conv_w + k * 1024 + c0 + 4); }
    *(f32x4*)&cb[0] = *(const f32x4*)(p.m_conv_b + c0); *(f32x4*)&cb[4] = *(const f32x4*)(p.m_conv_b + c0 + 4);
    for (int r = bid * 4 + rl; r < NROW; r += nb * 4) {
        int base, t, len; row_seq(r, base, t, len);
        const bf16_t* pr = PROJ + (size_t)r * LDP;
        const bool hp = t > 0, hn = t + 1 < len;
        float cur[8], prv[8], nxt[8];
        unpack8(*(const u32x4*)(pr + c0), cur); unpack8(*(const u32x4*)(pr - (hp ? LDP : 0) + c0), prv); unpack8(*(const u32x4*)(pr + (hn ? LDP : 0) + c0), nxt);
        const float mp = hp ? 1.f : 0.f, mn = hn ? 1.f : 0.f, sc = c0 < 512 ? 0.08838834764831845f : 1.f;
        float o[8];
#pragma unroll
        for (int j = 0; j < 8; ++j) o[j] = (prv[j] * (cw[0][j] * mp) + cur[j] * cw[1][j] + nxt[j] * (cw[2][j] * mn) + cb[j]) * sc;
        u32x4 w; w.x = pk2(o[0], o[1]); w.y = pk2(o[2], o[3]); w.z = pk2(o[4], o[5]); w.w = pk2(o[6], o[7]);
        if (c0 < 512) *(u32x4*)(QC + (size_t)r * 512 + c0) = w; else *(u32x4*)(KC + (size_t)r * 512 + c0 - 512) = w;
        if ((tid & 127) < 16) {
            const int j = tid & 127;
            float v = bf2f(pr[C_G + j]) + p.m_gate_b[j];
            if (j >= 8) v = -softplusf_(-v);
            GATES[(size_t)r * 16 + j] = v;
        }
    }
}

__device__ void rwkv_ref_task(const P& p, int gw, int lane) {
    const bf16_t* PROJ = (const bf16_t*)(p.ws + WS_PROJ); const bf16_t* KK = (const bf16_t*)(p.ws + WS_KK);
    const int stream = gw >> 6, vrow = gw & 63, dir = stream >> 5, b = (stream >> 4) & 1, h = stream & 15;
    const bf16_t* LW = (const bf16_t*)(p.ws + (dir ? WS_LWB : WS_LWF)); const bf16_t* AA = (const bf16_t*)(p.ws + (dir ? WS_AB : WS_AF));
    bf16_t* Y = (bf16_t*)(p.ws + (dir ? WS_YB : WS_YF));
    const int c = h * 64 + lane; const float rka = p.r_k_a[c];
    float s = 0.f;
    for (int st = 0; st < NSTEP; ++st) {
        const int r = step_row(st, b, dir);
        const float w = __expf(bf2f(LW[(size_t)r * RW + c])), a = bf2f(AA[(size_t)r * RW + c]), kk = bf2f(KK[(size_t)r * RW + c]);
        const float kr = bf2f(PROJ[(size_t)r * LDP + C_KR + c]), rr = bf2f(PROJ[(size_t)r * LDP + C_R + c]), vv = bf2f(PROJ[(size_t)r * LDP + C_VR + h * 64 + vrow]);
        const float kd = kr * (1.f + (a - 1.f) * rka);
        const float sa = wave_sum(s * kk);
        s = s * w - sa * (kk * a) + vv * kd;
        const float y = wave_sum(s * rr);
        if (st >= LC && lane == 0) Y[(size_t)r * RW + h * 64 + vrow] = (bf16_t)f2bf(y);
    }
}
__device__ void mlstm_ref_task(const P& p, int gw, int lane) {
    const bf16_t* PROJ = (const bf16_t*)(p.ws + WS_PROJ); const bf16_t* QC = (const bf16_t*)(p.ws + WS_QC); const bf16_t* KC = (const bf16_t*)(p.ws + WS_KC);
    const float* GATES = (const float*)(p.ws + WS_GATES);
    const int stream = gw >> 8, vrow = gw & 255, dir = stream >> 3, b = (stream >> 2) & 1, h = stream & 3;
    bf16_t* H = (bf16_t*)(p.ws + (dir ? WS_HB : WS_HF));
    float c0 = 0.f, c1 = 0.f, n0 = 0.f, n1 = 0.f;
    for (int st = 0; st < NSTEP; ++st) {
        const int r = step_row(st, b, dir);
        const float ig = GATES[(size_t)r * 16 + dir * 4 + h], lf = GATES[(size_t)r * 16 + 8 + dir * 4 + h];
        const float f = __expf(lf), ei = __expf(ig);
        const float k0 = bf2f(KC[(size_t)r * 512 + h * 128 + lane]), k1 = bf2f(KC[(size_t)r * 512 + h * 128 + 64 + lane]);
        const float q0 = bf2f(QC[(size_t)r * 512 + h * 128 + lane]), q1 = bf2f(QC[(size_t)r * 512 + h * 128 + 64 + lane]);
        const float v = bf2f(PROJ[(size_t)r * LDP + C_VM + h * 256 + vrow]);
        c0 = f * c0 + ei * v * k0; c1 = f * c1 + ei * v * k1; n0 = f * n0 + ei * k0; n1 = f * n1 + ei * k1;
        const float num = wave_sum(c0 * q0 + c1 * q1), den = wave_sum(n0 * q0 + n1 * q1);
        if (st >= LC && lane == 0) H[(size_t)r * RW + h * 256 + vrow] = (bf16_t)f2bf(num / fmaxf(fabsf(den), 1.f));
    }
}

__device__ __forceinline__ void phase_post(const P& p, int gw, int ngw, int lane) {
    const bf16_t* PROJ = (const bf16_t*)(p.ws + WS_PROJ);
    const bf16_t* YF = (const bf16_t*)(p.ws + WS_YF); const bf16_t* YB = (const bf16_t*)(p.ws + WS_YB);
    const bf16_t* HF = (const bf16_t*)(p.ws + WS_HF); const bf16_t* HB = (const bf16_t*)(p.ws + WS_HB);
    const bf16_t* GG = (const bf16_t*)(p.ws + WS_GG); const float* BONUS = (const float*)(p.ws + WS_BONUS); const float* BONUSB = (const float*)(p.ws + WS_BONUS_B);
    bf16_t* MIX = (bf16_t*)(p.ws + WS_MIX);
    for (int it = gw; it < NTOK * 4; it += ngw) {
        const int r = it >> 2, qt = it & 3, c0 = (qt & 1) * 512 + lane * 8;
        const bf16_t* pr = PROJ + (size_t)r * LDP;
        float o[8];
        if (qt < 2) {
            float a[8], b[8], om[8], gn[8];
            unpack8(*(const u32x4*)(HF + (size_t)r * RW + c0), a); unpack8(*(const u32x4*)(HB + (size_t)r * RW + c0), b); unpack8(*(const u32x4*)(pr + C_OM + c0), om);
            *(f32x4*)&gn[0] = *(const f32x4*)(p.m_norm_g + c0); *(f32x4*)&gn[4] = *(const f32x4*)(p.m_norm_g + c0 + 4);
            float ss = 0.f;
#pragma unroll
            for (int j = 0; j < 8; ++j) { a[j] += b[j]; ss += a[j] * a[j]; }
#pragma unroll
            for (int o2 = 1; o2 < 32; o2 <<= 1) ss += __shfl_xor(ss, o2);
            const float rs = rsqrtf(ss * (1.f / 256.f) + 1e-6f);
#pragma unroll
            for (int j = 0; j < 8; ++j) o[j] = a[j] * rs * gn[j] * __builtin_amdgcn_rcpf(1.f + __expf(-om[j]));
            u32x4 w; w.x = pk2(o[0], o[1]); w.y = pk2(o[2], o[3]); w.z = pk2(o[4], o[5]); w.w = pk2(o[6], o[7]);
            *(u32x4*)(MIX + (size_t)r * D + c0) = w;
        } else {
            float a[8], b[8], vr[8], gg[8], gw_[8], gb[8];
            unpack8(*(const u32x4*)(YF + (size_t)r * RW + c0), a); unpack8(*(const u32x4*)(YB + (size_t)r * RW + c0), b);
            unpack8(*(const u32x4*)(pr + C_VR + c0), vr); unpack8(*(const u32x4*)(GG + (size_t)r * RW + c0), gg);
            *(f32x4*)&gw_[0] = *(const f32x4*)(p.r_gn_w + c0); *(f32x4*)&gw_[4] = *(const f32x4*)(p.r_gn_w + c0 + 4);
            *(f32x4*)&gb[0] = *(const f32x4*)(p.r_gn_b + c0); *(f32x4*)&gb[4] = *(const f32x4*)(p.r_gn_b + c0 + 4);
            const int hd = c0 >> 6;
            const float bn = BONUS[(size_t)r * 16 + hd] + BONUSB[(size_t)r * 16 + hd];
            float sm = 0.f;
#pragma unroll
            for (int j = 0; j < 8; ++j) { a[j] += b[j]; sm += a[j]; }
            sm += __shfl_xor(sm, 1); sm += __shfl_xor(sm, 2); sm += __shfl_xor(sm, 4);
            const float mu = sm * (1.f / 64.f);
            float sv = 0.f;
#pragma unroll
            for (int j = 0; j < 8; ++j) { a[j] -= mu; sv += a[j] * a[j]; }
            sv += __shfl_xor(sv, 1); sv += __shfl_xor(sv, 2); sv += __shfl_xor(sv, 4);
            const float rs = rsqrtf(sv * (1.f / 64.f) + 64e-5f);
#pragma unroll
            for (int j = 0; j < 8; ++j) o[j] = (a[j] * rs * gw_[j] + gb[j] + bn * vr[j]) * gg[j];
            u32x4 w; w.x = pk2(o[0], o[1]); w.y = pk2(o[2], o[3]); w.z = pk2(o[4], o[5]); w.w = pk2(o[6], o[7]);
            *(u32x4*)(MIX + (size_t)r * D + 1024 + c0) = w;
        }
    }
}

__device__ __forceinline__ void phase_convact(const P& p, int gw, int lane) {
    const bf16_t* UG = (const bf16_t*)(p.ws + WS_UG); bf16_t* ACT = (bf16_t*)(p.ws + WS_ACT);
    constexpr int NCGW = FF / 8 / 64, NSTRIPE = 186, TPS = 45;
    const int cgw = gw % NCGW, stripe = gw / NCGW;
    if (stripe >= NSTRIPE) return;
    const int f = (cgw * 64 + lane) * 8;
    float cw[9][8], cb[8];
#pragma unroll
    for (int k = 0; k < 9; ++k) { *(f32x4*)&cw[k][0] = *(const f32x4*)(p.f_conv_w + (size_t)k * FF + f); *(f32x4*)&cw[k][4] = *(const f32x4*)(p.f_conv_w + (size_t)k * FF + f + 4); }
    *(f32x4*)&cb[0] = *(const f32x4*)(p.f_conv_b + f); *(f32x4*)&cb[4] = *(const f32x4*)(p.f_conv_b + f + 4);
    const int r1 = min(NTOK, (stripe + 1) * TPS);
    for (int r = stripe * TPS; r < r1; r += 2) {
        u32x4 ld[2][10]; float msk[2][9]; bool have[2];
#pragma unroll
        for (int tk = 0; tk < 2; ++tk) {
            const int rr_ = min(r + tk, NTOK - 1); have[tk] = (r + tk) < r1;
            const int b = rr_ >> 12, t = rr_ & 4095, gr = t >> 6, gc = t & 63;
#pragma unroll
            for (int dr = 0; dr < 3; ++dr)
#pragma unroll
                for (int dc = 0; dc < 3; ++dc) {
                    const int rr = gr + dr - 1, cc = gc + dc - 1;
                    const bool ok = rr >= 0 && rr < 64 && cc >= 0 && cc < 64;
                    const int nb_ = ok ? (b * 4096 + rr * 64 + cc) : rr_; msk[tk][dr * 3 + dc] = ok ? 1.f : 0.f;
                    ld[tk][dr * 3 + dc] = *(const u32x4*)(UG + (size_t)nb_ * (2 * FF) + f);
                }
            ld[tk][9] = *(const u32x4*)(UG + (size_t)rr_ * (2 * FF) + FF + f);
        }
#pragma unroll
        for (int tk = 0; tk < 2; ++tk) {
            float acc[8];
#pragma unroll
            for (int j = 0; j < 8; ++j) acc[j] = cb[j];
#pragma unroll
            for (int k = 0; k < 9; ++k) { float u[8]; unpack8(ld[tk][k], u);
#pragma unroll
                for (int j = 0; j < 8; ++j) acc[j] += u[j] * (cw[k][j] * msk[tk][k]); }
            float gt[8]; unpack8(ld[tk][9], gt);
            float o[8];
#pragma unroll
            for (int j = 0; j < 8; ++j) { const float u = acc[j], z2 = 1.5957691216057308f * (u + 0.044715f * u * u * u); o[j] = u * __builtin_amdgcn_rcpf(1.f + __expf(-z2)) * gt[j]; }
            u32x4 w; w.x = pk2(o[0], o[1]); w.y = pk2(o[2], o[3]); w.z = pk2(o[4], o[5]); w.w = pk2(o[6], o[7]);
            if (have[tk]) *(u32x4*)(ACT + (size_t)(r + tk) * FF + f) = w;
        }
    }
}

__device__ __forceinline__ void phase_final(const P& p, int gw, int ngw, int lane) {
    for (int r = gw; r < NTOK; r += ngw) {
        float* row = p.out + (size_t)r * D;
        f32x4 v[8]; float s = 0.f;
#pragma unroll
        for (int j = 0; j < 8; ++j) { v[j] = *((const f32x4*)row + lane + 64 * j); s += (v[j].x * v[j].x + v[j].y * v[j].y) + (v[j].z * v[j].z + v[j].w * v[j].w); }
        const float rs = rsqrtf(wave_sum(s) * (1.f / D) + 1e-6f);
#pragma unroll
        for (int j = 0; j < 8; ++j) { const f32x4 g = *((const f32x4*)p.g_final + lane + 64 * j); f32x4 o; o.x = v[j].x * rs * g.x; o.y = v[j].y * rs * g.y; o.z = v[j].z * rs * g.z; o.w = v[j].w * rs * g.w; *((f32x4*)row + lane + 64 * j) = o; }
    }
}

typedef short s16x4 __attribute__((ext_vector_type(4)));
__device__ __forceinline__ bf16x8 tr8(const LAS unsigned char* p0, int rstride4) {
    const s16x4 lo = __builtin_amdgcn_ds_read_tr16_b64_v4i16((LAS s16x4*)p0);
    const s16x4 hi = __builtin_amdgcn_ds_read_tr16_b64_v4i16((LAS s16x4*)(p0 + rstride4));
    return (bf16x8){lo[0], lo[1], lo[2], lo[3], hi[0], hi[1], hi[2], hi[3]};
}
template <int CTRL, int RM, bool BC> __device__ __forceinline__ float dppf(float oldv, float src) { return __int_as_float(__builtin_amdgcn_update_dpp(__float_as_int(oldv), __float_as_int(src), CTRL, RM, 0xF, BC)); }
__device__ __forceinline__ float wave_scan_add(float x) {
    x += dppf<0x111, 0xF, true>(0.f, x); x += dppf<0x112, 0xF, true>(0.f, x); x += dppf<0x114, 0xF, true>(0.f, x); x += dppf<0x118, 0xF, true>(0.f, x);
    x += dppf<0x142, 0xA, false>(0.f, x); x += dppf<0x143, 0xC, false>(0.f, x);
    return x;
}
__device__ __forceinline__ float wave_scan_max(float x) {
    const float ni = -__builtin_inff();
    x = fmaxf(x, dppf<0x111, 0xF, false>(ni, x)); x = fmaxf(x, dppf<0x112, 0xF, false>(ni, x)); x = fmaxf(x, dppf<0x114, 0xF, false>(ni, x)); x = fmaxf(x, dppf<0x118, 0xF, false>(ni, x));
    x = fmaxf(x, dppf<0x142, 0xA, false>(ni, x)); x = fmaxf(x, dppf<0x143, 0xC, false>(ni, x));
    return x;
}
__device__ __forceinline__ float lane_bcast63(float x) { return __int_as_float(__builtin_amdgcn_readlane(__float_as_int(x), 63)); }
constexpr int MI_QS = 0, MI_KS = 17408, MI_VS = 34816, MI_PS = 68608, MI_SC = 77824, MI_END = 78336;
constexpr int MI_RS = 272, MI_VRS = 528, MI_PRS = 144;
constexpr int NTASK_MI = 16 * (L / 64);
__device__ __forceinline__ void phase_mintra(const P& p, LAS unsigned char* L3, int bid, int nb) {
    int tid_ = threadIdx.x; asm volatile("" : "+v"(tid_));
    const int tid = tid_, lane = tid & 63, w = __builtin_amdgcn_readfirstlane(tid >> 6), g = lane >> 4, li = lane & 15, q4 = li >> 2, p4 = li & 3;
    const bf16_t* PROJ = (const bf16_t*)(p.ws + WS_PROJ); const bf16_t* QC = (const bf16_t*)(p.ws + WS_QC); const bf16_t* KC = (const bf16_t*)(p.ws + WS_KC);
    const float* GATES = (const float*)(p.ws + WS_GATES);
    const int mt = w >> 1, nh = w & 1;
    for (int task = bid; task < NTASK_MI; task += nb) {
        const int stream = task & 15, c = LC / 64 + (task >> 4), dir = stream >> 3, b = (stream >> 2) & 1, h = stream & 3;
        bf16_t* NUMS = (bf16_t*)(p.ws + (dir ? WS_HB : WS_HF)); float* DENS = (float*)(p.ws + WS_DENS) + dir * (NTOK * 4);
        {
            u32x4 qv[2], kv[2], vv[4];
#pragma unroll
            for (int i = 0; i < 2; ++i) { const int pc = tid + 512 * i, j = pc >> 4, dp = pc & 15; const int r = step_row(64 * c + j, b, dir);
                qv[i] = *(const u32x4*)(QC + (size_t)r * 512 + h * 128 + dp * 8); kv[i] = *(const u32x4*)(KC + (size_t)r * 512 + h * 128 + dp * 8); }
#pragma unroll
            for (int i = 0; i < 4; ++i) { const int pc = tid + 512 * i, j = pc >> 5, dp = pc & 31; const int r = step_row(64 * c + j, b, dir); vv[i] = *(const u32x4*)(PROJ + (size_t)r * LDP + C_VM + h * 256 + dp * 8); }
            if (w == 0) {
                const int r = step_row(64 * c + lane, b, dir);
                const float gi = GATES[(size_t)r * 16 + dir * 4 + h], gf = GATES[(size_t)r * 16 + 8 + dir * 4 + h];
                const float bc = wave_scan_add(gf), av = gi - bc, pml = wave_scan_max(av);
                LAS float* sc = (LAS float*)(L3 + MI_SC); sc[lane] = av; sc[64 + lane] = pml;
            }
#pragma unroll
            for (int i = 0; i < 2; ++i) { const int pc = tid + 512 * i, j = pc >> 4, dp = pc & 15; *(LAS u32x4*)(L3 + MI_QS + j * MI_RS + dp * 16) = qv[i]; *(LAS u32x4*)(L3 + MI_KS + j * MI_RS + dp * 16) = kv[i]; }
#pragma unroll
            for (int i = 0; i < 4; ++i) { const int pc = tid + 512 * i, j = pc >> 5, dp = pc & 31; *(LAS u32x4*)(L3 + MI_VS + j * MI_VRS + dp * 16) = vv[i]; }
        }
        __syncthreads();
        {
            const LAS float* sc = (const LAS float*)(L3 + MI_SC);
            bf16x8 aq[4];
#pragma unroll
            for (int ks = 0; ks < 4; ++ks) aq[ks] = *(const LAS bf16x8*)(L3 + MI_QS + (16 * mt + li) * MI_RS + (32 * ks + 8 * g) * 2);
            const f32x4 pmv = *(const LAS f32x4*)(sc + 64 + 16 * mt + 4 * g);
#pragma unroll
            for (int n = 0; n < 2; ++n) {
                const int nt = 2 * nh + n;
                f32x4 sv = (f32x4){0.f, 0.f, 0.f, 0.f};
                if (nt <= mt) {
#pragma unroll
                    for (int ks = 0; ks < 4; ++ks) { const bf16x8 bk = *(const LAS bf16x8*)(L3 + MI_KS + (16 * nt + li) * MI_RS + (32 * ks + 8 * g) * 2); sv = __builtin_amdgcn_mfma_f32_16x16x32_bf16(aq[ks], bk, sv, 0, 0, 0); }
                    const float av = sc[16 * nt + li];
#pragma unroll
                    for (int r = 0; r < 4; ++r) { const int j = 16 * mt + 4 * g + r, ss = 16 * nt + li; sv[r] = (ss <= j) ? sv[r] * __expf(av - pmv[r]) : 0.f; }
                }
#pragma unroll
                for (int r = 0; r < 4; ++r) *(LAS bf16_t*)(L3 + MI_PS + (16 * mt + 4 * g + r) * MI_PRS + (16 * nt + li) * 2) = (bf16_t)f2bf(sv[r]);
            }
        }
        __syncthreads();
        {
            bf16x8 ap[2];
#pragma unroll
            for (int ks = 0; ks < 2; ++ks) ap[ks] = *(const LAS bf16x8*)(L3 + MI_PS + (16 * mt + li) * MI_PRS + (32 * ks + 8 * g) * 2);
            f32x4 acc[8];
#pragma unroll
            for (int x = 0; x < 8; ++x) acc[x] = (f32x4){0.f, 0.f, 0.f, 0.f};
#pragma unroll
            for (int ks = 0; ks < 2; ++ks)
#pragma unroll
                for (int x = 0; x < 8; ++x) { const bf16x8 bv = tr8(L3 + MI_VS + (32 * ks + 8 * g + q4) * MI_VRS + 32 * (8 * nh + x) + 8 * p4, 4 * MI_VRS); acc[x] = __builtin_amdgcn_mfma_f32_16x16x32_bf16(ap[ks], bv, acc[x], 0, 0, 0); }
            if (nh == 0) {
                const short one = li == 0 ? (short)0x3F80 : (short)0;
                const bf16x8 ones = (bf16x8){one, one, one, one, one, one, one, one};
                f32x4 dn = (f32x4){0.f, 0.f, 0.f, 0.f};
                dn = __builtin_amdgcn_mfma_f32_16x16x32_bf16(ap[0], ones, dn, 0, 0, 0); dn = __builtin_amdgcn_mfma_f32_16x16x32_bf16(ap[1], ones, dn, 0, 0, 0);
                if (li == 0) {
                    const int row0 = step_row(64 * c + 16 * mt + 4 * g, b, dir);
#pragma unroll
                    for (int r = 0; r < 4; ++r) st_b32(DENS + (size_t)(row0 + (dir ? -r : r)) * 4 + h, dn[r]);
                }
            }
#pragma unroll
            for (int x = 0; x < 8; ++x)
#pragma unroll
                for (int r = 0; r < 4; ++r) *(LAS bf16_t*)(L3 + MI_QS + (16 * mt + 4 * g + r) * MI_VRS + (16 * (8 * nh + x) + li) * 2) = (bf16_t)f2bf(acc[x][r]);
        }
        __syncthreads();
#pragma unroll
        for (int i = 0; i < 4; ++i) { const int pc = tid + 512 * i, j = pc >> 5, dp = pc & 31; const int r = step_row(64 * c + j, b, dir); st_b128(NUMS + (size_t)r * RW + h * 256 + dp * 8, *(const LAS u32x4*)(L3 + MI_QS + j * MI_VRS + dp * 16)); }
        __syncthreads();
    }
}

constexpr int ML_QS = 0, ML_KS = 17408, ML_VW = 34816, ML_OFFB = 41984, ML_CS = 83968, ML_CSB = 13056, ML_SC = 110080, ML_SCB = 2048, ML_END = 116224;
constexpr int ML_RS = 272, ML_VRS = 112, NCHUNK = NSTEP / 64;

__device__ __forceinline__ void phase_mlstm(const P& p, LAS unsigned char* L3, int task) {
    int tid_ = threadIdx.x; asm volatile("" : "+v"(tid_));
    const int tid = tid_, lane = tid & 63, w = __builtin_amdgcn_readfirstlane(tid >> 6), g = lane >> 4, li = lane & 15, q4 = li >> 2, p4 = li & 3;
    const int stream = task >> 3, sl = task & 7, dir = stream >> 3, b = (stream >> 2) & 1, h = stream & 3;
    const bf16_t* PROJ = (const bf16_t*)(p.ws + WS_PROJ); const bf16_t* QC = (const bf16_t*)(p.ws + WS_QC); const bf16_t* KC = (const bf16_t*)(p.ws + WS_KC);
    const float* GATES = (const float*)(p.ws + WS_GATES); const float* DENS = (const float*)(p.ws + WS_DENS) + dir * (NTOK * 4);
    bf16_t* H = (bf16_t*)(p.ws + (dir ? WS_HB : WS_HF));
    const int mt = w >> 1, nh = w & 1;
    for (int i = tid; i < 2 * ML_CSB / 4; i += 512) ((LAS unsigned*)(L3 + ML_CS))[i] = 0u;
    auto rlow = [&](int c) -> int { const int r0 = step_row(64 * c, b, dir); return dir ? r0 - 63 : r0; };
    unsigned offQ[2], offV = 0u, offNS[4], offGt, offDn;
#pragma unroll
    for (int i = 0; i < 2; ++i) { const int pc = tid + 512 * i, j = pc >> 4, dp = pc & 15; offQ[i] = (unsigned)((dir ? 63 - j : j) * 1024 + dp * 16); }
    if (tid < 256) { const int j = tid >> 2, pc = tid & 3; offV = (unsigned)((dir ? 63 - j : j) * (LDP * 2) + pc * 16); }
#pragma unroll
    for (int r = 0; r < 4; ++r) { const int j = 16 * mt + 4 * g + r; offNS[r] = (unsigned)((dir ? 63 - j : j) * (RW * 2) + (16 * nh + li) * 2); }
    offGt = (unsigned)((dir ? 63 - lane : lane) * 64); offDn = (unsigned)((dir ? 63 - lane : lane) * 16);
    const unsigned char* QCb = (const unsigned char*)QC + h * 256; const unsigned char* KCb = (const unsigned char*)KC + h * 256;
    const unsigned char* PVb = (const unsigned char*)PROJ + (C_VM + h * 256 + sl * 32) * 2; unsigned char* Hb = (unsigned char*)H + (h * 256 + sl * 32) * 2;
    const unsigned char* GTb = (const unsigned char*)GATES + (dir * 4 + h) * 4; const unsigned char* DNb = (const unsigned char*)DENS + h * 4;
    struct Stg { u32x4 q[2], k[2], v; };
    Stg S; float g_i = 0.f, g_f = 0.f, g_d = 0.f; float m_old = 0.f;
    auto load_chunk = [&](int c) {
        const size_t rl = (size_t)rlow(c);
#pragma unroll
        for (int i = 0; i < 2; ++i) { S.q[i] = *(const u32x4*)(QCb + rl * 1024 + offQ[i]); S.k[i] = *(const u32x4*)(KCb + rl * 1024 + offQ[i]); }
        if (tid < 256) S.v = *(const u32x4*)(PVb + rl * (LDP * 2) + offV);
    };
    auto load_ns = [&](int c, bf16_t (&ns)[4]) {
        if (c >= LC / 64) { const unsigned char* hb = Hb + (size_t)rlow(c) * (RW * 2);
#pragma unroll
            for (int r = 0; r < 4; ++r) ns[r] = *(const bf16_t*)(hb + offNS[r]); }
    };
    auto load_gates = [&](int c) { if (w == 0) { const size_t rl = (size_t)rlow(c); g_i = *(const float*)(GTb + rl * 64 + offGt); g_f = *(const float*)(GTb + rl * 64 + 32 + offGt); g_d = c >= LC / 64 ? *(const float*)(DNb + rl * 16 + offDn) : 0.f; } };
    auto scalars = [&](int buf) {
        const float bc = wave_scan_add(g_f);
        const float a = g_i - bc; const float pml = wave_scan_max(a);
        const float pm = fmaxf(pml, m_old);
        const float pmL = lane_bcast63(pm), bl = lane_bcast63(bc);
        LAS float* sc = (LAS float*)(L3 + ML_SC + buf * ML_SCB);
        sc[lane] = __expf(pml - pm); sc[64 + lane] = __expf(m_old - pm); sc[128 + lane] = __expf(-(bc + pm)); sc[192 + lane] = __expf(a - pmL); sc[256 + lane] = g_d;
        if (lane == 0) sc[320] = __expf(m_old - pmL);
        m_old = bl + pmL;
    };
    auto write_stage = [&](int buf, int scb) {
        LAS unsigned char* B = L3 + buf * ML_OFFB; const LAS float* sc = (const LAS float*)(L3 + ML_SC + scb * ML_SCB);
#pragma unroll
        for (int i = 0; i < 2; ++i) { const int pc = tid + 512 * i, j = pc >> 4, dp = pc & 15; *(LAS u32x4*)(B + ML_QS + j * ML_RS + dp * 16) = S.q[i]; *(LAS u32x4*)(B + ML_KS + j * ML_RS + dp * 16) = S.k[i]; }
        if (tid < 256) { const int j = tid >> 2, pc = tid & 3; const float wk = sc[192 + j]; const u32x4 vreg = S.v;
            u32x4 o; o.x = pk2(bflo(vreg.x) * wk, bfhi(vreg.x) * wk); o.y = pk2(bflo(vreg.y) * wk, bfhi(vreg.y) * wk); o.z = pk2(bflo(vreg.z) * wk, bfhi(vreg.z) * wk); o.w = pk2(bflo(vreg.w) * wk, bfhi(vreg.w) * wk);
            *(LAS u32x4*)(B + ML_VW + j * ML_VRS + pc * 16) = o; }
        else if (tid < 320) { const int j = tid - 256; LAS u32x4* d = (LAS u32x4*)(B + ML_VW + j * ML_VRS + 64); d[0] = (u32x4){f2bf(sc[192 + j]), 0u, 0u, 0u}; d[1] = (u32x4){0u, 0u, 0u, 0u}; }
    };
    load_chunk(0); load_gates(0);
    if (w == 0) scalars(0);
    load_gates(1);
    __syncthreads();
    write_stage(0, 0);
    if (w == 0) scalars(1);
    load_chunk(1); load_gates(2);
    bf16_t nsA[4], nsB[4]; load_ns(0, nsA); load_ns(1, nsB);
    __syncthreads();
    f32x4 accC[3];
#pragma unroll
    for (int i = 0; i < 3; ++i) accC[i] = (f32x4){0.f, 0.f, 0.f, 0.f};
    auto mstep = [&](int c, bf16_t (&nsCur)[4]) {
        const int cur = c & 1, nxt = cur ^ 1;
        LAS unsigned char* B = L3 + cur * ML_OFFB; const LAS float* sc = (const LAS float*)(L3 + ML_SC + (c % 3) * ML_SCB);
        float hv[4];
        if (c >= LC / 64) {
            const LAS unsigned char* CSc = L3 + ML_CS + cur * ML_CSB;
            f32x4 nC[2] = {(f32x4){0.f, 0.f, 0.f, 0.f}, (f32x4){0.f, 0.f, 0.f, 0.f}};
#pragma unroll
            for (int ks = 0; ks < 4; ++ks) {
                const bf16x8 aq = *(const LAS bf16x8*)(B + ML_QS + (16 * mt + li) * ML_RS + (32 * ks + 8 * g) * 2);
#pragma unroll
                for (int x = 0; x < 2; ++x) { const int vt = x ? 2 : nh; const bf16x8 bc = *(const LAS bf16x8*)(CSc + (16 * vt + li) * ML_RS + (32 * ks + 8 * g) * 2); nC[x] = __builtin_amdgcn_mfma_f32_16x16x32_bf16(aq, bc, nC[x], 0, 0, 0); }
            }
            const f32x4 resc = *(const LAS f32x4*)(sc + 16 * mt + 4 * g), inter = *(const LAS f32x4*)(sc + 64 + 16 * mt + 4 * g), emj = *(const LAS f32x4*)(sc + 128 + 16 * mt + 4 * g), dns = *(const LAS f32x4*)(sc + 256 + 16 * mt + 4 * g);
#pragma unroll
            for (int r = 0; r < 4; ++r) {
                const float denC = __shfl(nC[1][r], lane & 48);
                const float den = resc[r] * dns[r] + inter[r] * denC;
                hv[r] = (resc[r] * bf2f(nsCur[r]) + inter[r] * nC[0][r]) * __builtin_amdgcn_rcpf(fmaxf(fabsf(den), emj[r]));
            }
        }
        {
            const float decay = sc[320];
            bf16x8 bkT[2];
#pragma unroll
            for (int ks = 0; ks < 2; ++ks) bkT[ks] = tr8(B + ML_KS + (32 * ks + 8 * g + q4) * ML_RS + 32 * w + 8 * p4, 4 * ML_RS);
#pragma unroll
            for (int vt = 0; vt < 3; ++vt) {
                accC[vt] = accC[vt] * decay;
#pragma unroll
                for (int ks = 0; ks < 2; ++ks) { const bf16x8 av = tr8(B + ML_VW + (32 * ks + 8 * g + q4) * ML_VRS + 32 * vt + 8 * p4, 4 * ML_VRS); accC[vt] = __builtin_amdgcn_mfma_f32_16x16x32_bf16(av, bkT[ks], accC[vt], 0, 0, 0); }
            }
            LAS unsigned char* CSn = L3 + ML_CS + nxt * ML_CSB;
#pragma unroll
            for (int vt = 0; vt < 3; ++vt)
#pragma unroll
                for (int r = 0; r < 4; ++r) *(LAS bf16_t*)(CSn + (16 * vt + 4 * g + r) * ML_RS + (16 * w + li) * 2) = (bf16_t)f2bf(accC[vt][r]);
        }
        if (w == 0 && c + 2 < NCHUNK) scalars((c + 2) % 3);
        if (c + 1 < NCHUNK) write_stage(nxt, (c + 1) % 3);
        if (c >= LC / 64) {
            unsigned char* hb = Hb + (size_t)rlow(c) * (RW * 2);
#pragma unroll
            for (int r = 0; r < 4; ++r) st_b16(hb + offNS[r], f2bf(hv[r]));
        }
        if (c + 2 < NCHUNK) { load_chunk(c + 2); load_ns(c + 2, nsCur); }
        if (c + 3 < NCHUNK) load_gates(c + 3);
        __syncthreads();
    };
    for (int c = 0; c < NCHUNK; c += 2) { mstep(c, nsA); mstep(c + 1, nsB); }
}
template <bool ATR, bool BTR>
__device__ __forceinline__ void mm_tiles(const LAS unsigned char* A, int a_rs, const LAS unsigned char* Bm, int b_rs, int ksteps, f32x4 (&acc)[2], int mt, int nt0, int g, int li) {
    const int q4 = li >> 2, p4 = li & 3;
    for (int ks = 0; ks < ksteps; ++ks) {
        const bf16x8 a = ATR ? tr8(A + (32 * ks + 8 * g + q4) * a_rs + 32 * mt + 8 * p4, 4 * a_rs) : *(const LAS bf16x8*)(A + (16 * mt + li) * a_rs + (32 * ks + 8 * g) * 2);
#pragma unroll
        for (int n = 0; n < 2; ++n) {
            const bf16x8 b = BTR ? tr8(Bm + (32 * ks + 8 * g + q4) * b_rs + 32 * (nt0 + n) + 8 * p4, 4 * b_rs) : *(const LAS bf16x8*)(Bm + (16 * (nt0 + n) + li) * b_rs + (32 * ks + 8 * g) * 2);
            acc[n] = __builtin_amdgcn_mfma_f32_16x16x32_bf16(a, b, acc[n], 0, 0, 0);
        }
    }
}
constexpr int R1_TLW = 0, R1_LA = 9216, R1_SG = 18432, R1_FW = 39936, R1_FA = 57344;
constexpr int R1_AK = 0, R1_ABO = 9216, R1_BK = 18432, R1_BB = 27648, R1_ABF = 36864, R1_AKV = 40960, R1_TINV = 50176, R1_LP = 54272;
constexpr int R1_WT = 74752, R1_ELC = R1_WT + 2048, R1_KAP = 77056, R1_KT = 86272, R1_BT = 95488, R1_RHO = 104704, R1_VV = 113920, R1_XB = 123136, R1_END = 140544;
constexpr int R1_PAR = R1_END;
constexpr int R1_RS = 144, R1_SGRS = 336, R1_FRS = 272, R1_RHRS = 528, R1_XRS = 272;
constexpr int NTASK_R1 = 64 * NCHUNK;
constexpr int CH_M = 0, CH_G = 8192, CH_N = 16384, CH_E = 24576, CH_REC = 24832;
__device__ __forceinline__ int afrag_off(int row, int k) { return ((((row >> 4) * 2 + (k >> 5)) * 64 + ((k >> 3) & 3) * 16 + (row & 15)) * 8 + (k & 7)) * 2; }

__device__ __forceinline__ float fsig(float x) { return __builtin_amdgcn_rcpf(1.f + __expf(-x)); }
__device__ __forceinline__ float ftanh(float x) { return 1.f - 2.f * __builtin_amdgcn_rcpf(1.f + __expf(2.f * x)); }
__device__ __forceinline__ u32x4 map8_tanh(const u32x4 v) { u32x4 o; o.x = pk2(ftanh(bflo(v.x)), ftanh(bfhi(v.x))); o.y = pk2(ftanh(bflo(v.y)), ftanh(bfhi(v.y))); o.z = pk2(ftanh(bflo(v.z)), ftanh(bfhi(v.z))); o.w = pk2(ftanh(bflo(v.w)), ftanh(bfhi(v.w))); return o; }
__device__ __forceinline__ u32x4 map8_sig(const u32x4 v) { u32x4 o; o.x = pk2(fsig(bflo(v.x)), fsig(bfhi(v.x))); o.y = pk2(fsig(bflo(v.y)), fsig(bfhi(v.y))); o.z = pk2(fsig(bflo(v.z)), fsig(bfhi(v.z))); o.w = pk2(fsig(bflo(v.w)), fsig(bfhi(v.w))); return o; }
__device__ __forceinline__ u32x4 pack8(const float (&x)[8]) { u32x4 o; o.x = pk2(x[0], x[1]); o.y = pk2(x[2], x[3]); o.z = pk2(x[4], x[5]); o.w = pk2(x[6], x[7]); return o; }

__device__ __forceinline__ void phase_r1(const P& p, LAS unsigned char* L3, int bid, int nb, unsigned pflags) {
    int tid_ = threadIdx.x; asm volatile("" : "+v"(tid_));
    const int tid = tid_, lane = tid & 63, w = __builtin_amdgcn_readfirstlane(tid >> 6);
#define R1_LANES int lz_ = tid; asm volatile("" : "+v"(lz_)); const int g = (lz_ >> 4) & 3, li = lz_ & 15, q4 = li >> 2, p4 = li & 3, t = lz_ >> 3, c8 = (lz_ & 7) * 8; (void)g; (void)li; (void)q4; (void)p4; (void)t; (void)c8;
    const int mt = w >> 1, nt0 = 2 * (w & 1);
    const bf16_t* PROJ = (const bf16_t*)(p.ws + WS_PROJ);
    const bf16_t* WUPT = (const bf16_t*)(p.ws + WS_WUPT); const bf16_t* AUPT = (const bf16_t*)(p.ws + WS_AUPT); const bf16_t* GUPT = (const bf16_t*)(p.ws + WS_GUPT);
    bf16_t* GG = (bf16_t*)(p.ws + WS_GG);
    if (bid >= NTASK_R1) return;
    const int stream = bid & 63, dir = stream >> 5, b = (stream >> 4) & 1, h = stream & 15;
    float* BON = (float*)(p.ws + (dir ? WS_BONUS_B : WS_BONUS));
    bf16_t* Yo = (bf16_t*)(p.ws + (dir ? WS_YB : WS_YF));
    bf16x8 wfr[2][2], afr[2][2];
    {
        R1_LANES
#pragma unroll
        for (int ks = 0; ks < 2; ++ks)
#pragma unroll
            for (int n = 0; n < 2; ++n) { const size_t wo = ((size_t)(dir * 1024 + 64 * h + 16 * (nt0 + n) + li) * 64 + 32 * ks + 8 * g); wfr[ks][n] = *(const bf16x8*)(WUPT + wo); afr[ks][n] = *(const bf16x8*)(AUPT + wo); }
    }
    if (tid < 64) {
        const int ch = 64 * h + tid; LAS float* pp = (LAS float*)(L3 + R1_PAR);
        pp[tid] = p.r_w0[dir * RW + ch]; pp[64 + tid] = p.r_a0[dir * RW + ch]; pp[128 + tid] = p.r_k_k[ch]; pp[192 + tid] = p.r_k_a[ch]; pp[256 + tid] = p.r_r_k[ch];
    }
    struct Ld { u32x4 rr, kr, vr, lw, la, lg[3]; int row; };
    auto load_task = [&](int task, Ld& X) {
        int lz0_ = tid; asm volatile("" : "+v"(lz0_)); const int t0 = lz0_ >> 3, c80 = (lz0_ & 7) * 8;
        X.row = step_row(64 * (task >> 6) + t0, b, dir);
        const bf16_t* pr = PROJ + (size_t)X.row * LDP;
        X.rr = *(const u32x4*)(pr + C_R + 64 * h + c80); X.kr = *(const u32x4*)(pr + C_KR + 64 * h + c80); X.vr = *(const u32x4*)(pr + C_VR + 64 * h + c80);
        X.lw = *(const u32x4*)(pr + C_LW + 64 * dir + c80); X.la = *(const u32x4*)(pr + C_LA + 64 * dir + c80);
        const int cc_ = task >> 6, tcl_ = dir ? 63 - (cc_ - LC / 64) : cc_ - LC / 64;
        if (cc_ >= LC / 64 && (tcl_ & 1) == dir) {
#pragma unroll
            for (int i = 0; i < 3; ++i) { const int pc = lz0_ + 512 * i; if (pc < 64 * 20) { const int tt = pc / 20, q = pc % 20; X.lg[i] = *(const u32x4*)(PROJ + (size_t)step_row(64 * (task >> 6) + tt, b, dir) * LDP + C_LG + q * 8); } }
        }
    };
    Ld cur; load_task(bid, cur);
    unsigned long long dS[10] = {0,0,0,0,0,0,0,0,0,0}, tq = 0; if (DIAG_ON) tq = tick();
#define R1_MARK(k) if (DIAG_ON) { const unsigned long long tn = tick(); dS[k] += tn - tq; tq = tn; }
    for (int task = bid; task < NTASK_R1; task += nb) {
        const int c = task >> 6;
        const bool lat = c >= LC / 64;
        const int tc_ = dir ? 63 - (c - LC / 64) : c - LC / 64;
        const bool do_g = lat && (tc_ & 1) == dir;
        unsigned char* rec = p.ws + WS_CHD + (size_t)(stream * NCHUNK + c) * CH_REC;
        const u32x4 rr = cur.rr, kr = cur.kr, vr = cur.vr; const int row = cur.row;
        bf16x8 gb[5][2];
        if (do_g) {
            R1_LANES
#pragma unroll
            for (int ks = 0; ks < 5; ++ks)
#pragma unroll
                for (int n = 0; n < 2; ++n) gb[ks][n] = *(const bf16x8*)(GUPT + (size_t)(64 * h + 16 * (nt0 + n) + li) * 160 + 32 * ks + 8 * g);
        }
        {
            R1_LANES
            *(LAS u32x4*)(L3 + R1_TLW + t * R1_RS + c8 * 2) = map8_tanh(cur.lw);
            *(LAS u32x4*)(L3 + R1_LA + t * R1_RS + c8 * 2) = cur.la;
            if (do_g) {
#pragma unroll
                for (int i = 0; i < 3; ++i) { const int pc = lz_ + 512 * i; if (pc < 64 * 20) { const int tt = pc / 20, q = pc % 20; *(LAS u32x4*)(L3 + R1_SG + tt * R1_SGRS + q * 16) = map8_sig(cur.lg[i]); } }
            }
        }
        __syncthreads();
        R1_MARK(0)
        {
            R1_LANES
            f32x4 aw[2], aa[2];
#pragma unroll
            for (int n = 0; n < 2; ++n) { aw[n] = (f32x4){0.f, 0.f, 0.f, 0.f}; aa[n] = (f32x4){0.f, 0.f, 0.f, 0.f}; }
#pragma unroll
            for (int ks = 0; ks < 2; ++ks) {
                const bf16x8 a1 = *(const LAS bf16x8*)(L3 + R1_TLW + (16 * mt + li) * R1_RS + (32 * ks + 8 * g) * 2);
                const bf16x8 a2 = *(const LAS bf16x8*)(L3 + R1_LA + (16 * mt + li) * R1_RS + (32 * ks + 8 * g) * 2);
#pragma unroll
                for (int n = 0; n < 2; ++n) { aw[n] = __builtin_amdgcn_mfma_f32_16x16x32_bf16(a1, wfr[ks][n], aw[n], 0, 0, 0); aa[n] = __builtin_amdgcn_mfma_f32_16x16x32_bf16(a2, afr[ks][n], aa[n], 0, 0, 0); }
            }
#pragma unroll
            for (int n = 0; n < 2; ++n)
#pragma unroll
                for (int r = 0; r < 4; ++r) {
                    *(LAS float*)(L3 + R1_FW + (16 * mt + 4 * g + r) * R1_FRS + (16 * (nt0 + n) + li) * 4) = aw[n][r];
                    *(LAS float*)(L3 + R1_FA + (16 * mt + 4 * g + r) * R1_FRS + (16 * (nt0 + n) + li) * 4) = aa[n][r];
                }
            if (do_g) {
                f32x4 ag[2] = {(f32x4){0.f, 0.f, 0.f, 0.f}, (f32x4){0.f, 0.f, 0.f, 0.f}};
#pragma unroll
                for (int ks = 0; ks < 5; ++ks) {
                    const bf16x8 a3 = *(const LAS bf16x8*)(L3 + R1_SG + (16 * mt + li) * R1_SGRS + (32 * ks + 8 * g) * 2);
#pragma unroll
                    for (int n = 0; n < 2; ++n) ag[n] = __builtin_amdgcn_mfma_f32_16x16x32_bf16(a3, gb[ks][n], ag[n], 0, 0, 0);
                }
#pragma unroll
                for (int n = 0; n < 2; ++n)
#pragma unroll
                    for (int r = 0; r < 4; ++r) *(LAS bf16_t*)(L3 + R1_XB + (16 * mt + 4 * g + r) * R1_RS + (16 * (nt0 + n) + li) * 2) = (bf16_t)f2bf(ag[n][r]);
            }
        }
        __syncthreads();
        R1_MARK(1)
        {
            float kap[8];
            R1_LANES
            const int ch = 64 * h + c8;
            if (do_g) st_b128(GG + (size_t)row * RW + ch, *(const LAS u32x4*)(L3 + R1_XB + t * R1_RS + c8 * 2));
            float fw[8], fa[8], w0[8], a0[8], rkk[8], rka[8], rrk[8];
            *(f32x4*)&fw[0] = *(const LAS f32x4*)(L3 + R1_FW + t * R1_FRS + c8 * 4); *(f32x4*)&fw[4] = *(const LAS f32x4*)(L3 + R1_FW + t * R1_FRS + c8 * 4 + 16);
            *(f32x4*)&fa[0] = *(const LAS f32x4*)(L3 + R1_FA + t * R1_FRS + c8 * 4); *(f32x4*)&fa[4] = *(const LAS f32x4*)(L3 + R1_FA + t * R1_FRS + c8 * 4 + 16);
#pragma unroll
            for (int i = 0; i < 2; ++i) {
                *(f32x4*)&w0[4 * i] = *(const LAS f32x4*)(L3 + R1_PAR + (c8 + 4 * i) * 4); *(f32x4*)&a0[4 * i] = *(const LAS f32x4*)(L3 + R1_PAR + (64 + c8 + 4 * i) * 4);
                *(f32x4*)&rkk[4 * i] = *(const LAS f32x4*)(L3 + R1_PAR + (128 + c8 + 4 * i) * 4); *(f32x4*)&rka[4 * i] = *(const LAS f32x4*)(L3 + R1_PAR + (192 + c8 + 4 * i) * 4); *(f32x4*)&rrk[4 * i] = *(const LAS f32x4*)(L3 + R1_PAR + (256 + c8 + 4 * i) * 4);
            }
            float krf[8], rf[8]; unpack8(kr, krf); unpack8(rr, rf);
            float wl[8], av[8], kkv[8], lam[8]; float ss = 0.f, bs = 0.f;
#pragma unroll
            for (int i = 0; i < 8; ++i) {
                wl[i] = -0.6065306597126334f * fsig(w0[i] + fw[i]);
                av[i] = fsig(a0[i] + fa[i]);
                kkv[i] = krf[i] * rkk[i]; ss += kkv[i] * kkv[i];
                bs += rf[i] * krf[i] * rrk[i] * (1.f - rka[i] + rka[i] * av[i]);
                lam[i] = wl[i];
            }
            ss += __shfl_xor(ss, 1); ss += __shfl_xor(ss, 2); ss += __shfl_xor(ss, 4);
            bs += __shfl_xor(bs, 1); bs += __shfl_xor(bs, 2); bs += __shfl_xor(bs, 4);
            const float rn = rsqrtf(ss + 1e-12f);
            if ((tid & 7) == 0) st_b32(BON + (size_t)row * 16 + h, bs);
#pragma unroll
            for (int o = 8; o < 64; o <<= 1)
#pragma unroll
                for (int i = 0; i < 8; ++i) { const float tv = __shfl_up(lam[i], o); if (lane >= o) lam[i] += tv; }
            if ((lane >> 3) == 7) { *(LAS f32x4*)(L3 + R1_WT + w * 256 + c8 * 4) = *(f32x4*)&lam[0]; *(LAS f32x4*)(L3 + R1_WT + w * 256 + c8 * 4 + 16) = *(f32x4*)&lam[4]; }
            __syncthreads();
            float lc[8];
#pragma unroll
            for (int i = 0; i < 8; ++i) lc[i] = 0.f;
#pragma unroll
            for (int ww = 0; ww < 8; ++ww) {
                float tv[8]; *(f32x4*)&tv[0] = *(const LAS f32x4*)(L3 + R1_WT + ww * 256 + c8 * 4); *(f32x4*)&tv[4] = *(const LAS f32x4*)(L3 + R1_WT + ww * 256 + c8 * 4 + 16);
#pragma unroll
                for (int i = 0; i < 8; ++i) { lc[i] += tv[i]; if (ww < w) lam[i] += tv[i]; }
            }
            float kt8[8], bt8[8], rho8[8];
#pragma unroll
            for (int i = 0; i < 8; ++i) {
                const float e_cur = __expf(lam[i]), e_prev = e_cur * __expf(-wl[i]), e_inv = __expf(-lam[i]);
                const float kk = kkv[i] * rn, kd = krf[i] * (1.f + (av[i] - 1.f) * rka[i]);
                kap[i] = kk * e_prev; rho8[i] = rf[i] * e_cur; kt8[i] = kd * e_inv; bt8[i] = kk * av[i] * e_inv;
            }
            *(LAS u32x4*)(L3 + R1_KAP + t * R1_RS + c8 * 2) = pack8(kap);
            *(LAS u32x4*)(L3 + R1_KT + t * R1_RS + c8 * 2) = pack8(kt8);
            *(LAS u32x4*)(L3 + R1_BT + t * R1_RS + c8 * 2) = pack8(bt8);
            *(LAS u32x4*)(L3 + R1_RHO + t * R1_RS + c8 * 2) = pack8(rho8);
            *(LAS u32x4*)(L3 + R1_VV + t * R1_RS + c8 * 2) = vr;
            if (t == 63) {
                f32x4 e0, e1; e0.x = __expf(lc[0]); e0.y = __expf(lc[1]); e0.z = __expf(lc[2]); e0.w = __expf(lc[3]); e1.x = __expf(lc[4]); e1.y = __expf(lc[5]); e1.z = __expf(lc[6]); e1.w = __expf(lc[7]);
                *(LAS f32x4*)(L3 + R1_ELC + c8 * 4) = e0; *(LAS f32x4*)(L3 + R1_ELC + c8 * 4 + 16) = e1;
                st_f128(rec + CH_E + c8 * 4, e0); st_f128(rec + CH_E + c8 * 4 + 16, e1);
            }
        }
        if (task + nb < NTASK_R1) load_task(task + nb, cur);
        __syncthreads();
        if (pflags & 32u) continue;
        R1_MARK(2)
        {
            R1_LANES
            for (int i = tid; i < 64 * R1_XRS / 16; i += 512) *(LAS u32x4*)(L3 + R1_XB + i * 16) = (u32x4){0u, 0u, 0u, 0u};
            for (int i = tid; i < (4096 + 9216) / 16; i += 512) *(LAS u32x4*)(L3 + R1_TINV + i * 16) = (u32x4){0u, 0u, 0u, 0u};
            f32x4 ak[2], ab[2], bk[2], bb[2];
#pragma unroll
            for (int n = 0; n < 2; ++n) { ak[n] = (f32x4){0.f, 0.f, 0.f, 0.f}; ab[n] = ak[n]; bk[n] = ak[n]; bb[n] = ak[n]; }
            if (nt0 <= mt) {
                mm_tiles<false, false>(L3 + R1_KAP, R1_RS, L3 + R1_KT, R1_RS, 2, ak, mt, nt0, g, li);
                mm_tiles<false, false>(L3 + R1_KAP, R1_RS, L3 + R1_BT, R1_RS, 2, ab, mt, nt0, g, li);
                mm_tiles<false, false>(L3 + R1_RHO, R1_RS, L3 + R1_KT, R1_RS, 2, bk, mt, nt0, g, li);
                mm_tiles<false, false>(L3 + R1_RHO, R1_RS, L3 + R1_BT, R1_RS, 2, bb, mt, nt0, g, li);
            }
#pragma unroll
            for (int n = 0; n < 2; ++n)
#pragma unroll
                for (int r = 0; r < 4; ++r) {
                    const int tt = 16 * mt + 4 * g + r, ii = 16 * (nt0 + n) + li; const bool sl = ii < tt, le = ii <= tt, dg = (nt0 + n) == mt;
                    const int o = tt * R1_RS + ii * 2;
                    *(LAS bf16_t*)(L3 + R1_AK + o) = (bf16_t)f2bf(sl ? ak[n][r] : 0.f);
                    *(LAS bf16_t*)(L3 + R1_ABO + o) = (bf16_t)f2bf((sl && !dg) ? ab[n][r] : 0.f);
                    *(LAS bf16_t*)(L3 + R1_BK + o) = (bf16_t)f2bf(le ? bk[n][r] : 0.f);
                    *(LAS bf16_t*)(L3 + R1_BB + o) = (bf16_t)f2bf(le ? bb[n][r] : 0.f);
                    if (dg) *(LAS float*)(L3 + R1_ABF + (mt * 256 + (4 * g + r) * 16 + li) * 4) = sl ? ab[n][r] : 0.f;
                }
        }
        __syncthreads();
        R1_MARK(3)
        f32x4 y0a[2], na[2];
        {
            R1_LANES
            f32x4 akv[2];
#pragma unroll
            for (int n = 0; n < 2; ++n) { akv[n] = (f32x4){0.f, 0.f, 0.f, 0.f}; y0a[n] = akv[n]; na[n] = akv[n]; }
            mm_tiles<false, true>(L3 + R1_AK, R1_RS, L3 + R1_VV, R1_RS, 2, akv, mt, nt0, g, li);
            mm_tiles<false, true>(L3 + R1_BK, R1_RS, L3 + R1_VV, R1_RS, 2, y0a, mt, nt0, g, li);
            mm_tiles<true, true>(L3 + R1_KT, R1_RS, L3 + R1_VV, R1_RS, 2, na, mt, nt0, g, li);
#pragma unroll
            for (int n = 0; n < 2; ++n)
#pragma unroll
                for (int r = 0; r < 4; ++r) *(LAS bf16_t*)(L3 + R1_AKV + (16 * mt + 4 * g + r) * R1_RS + (16 * (nt0 + n) + li) * 2) = (bf16_t)f2bf(akv[n][r]);
            if (w == 0) {
                const int blk = lz_ >> 4, col = lz_ & 15;
                float tv[16];
#pragma unroll
                for (int i = 0; i < 16; ++i) tv[i] = (i == col) ? 1.f : 0.f;
#pragma unroll
                for (int i = 1; i < 16; ++i) {
                    const LAS float* lrow = (const LAS float*)(L3 + R1_ABF + (blk * 256 + i * 16) * 4);
                    float lv[16];
#pragma unroll
                    for (int j4 = 0; j4 < (i + 3) / 4; ++j4) *(f32x4*)&lv[4 * j4] = *(const LAS f32x4*)(lrow + 4 * j4);
#pragma unroll
                    for (int j = 0; j < i; ++j) tv[i] -= lv[j] * tv[j];
                    asm volatile("" ::: "memory");
                }
#pragma unroll
                for (int i = 0; i < 16; ++i) *(LAS bf16_t*)(L3 + R1_TINV + ((blk * 16 + i) * 32 + col) * 2) = (bf16_t)f2bf(tv[i]);
            }
        }
        __syncthreads();
        R1_MARK(4)
        {
            R1_LANES
            const int g1 = g & 1;
            const LAS unsigned char* Rsrc = (w < 4) ? (L3 + R1_KAP + 32 * w) : (L3 + R1_AKV + 32 * (w - 4));
            f32x4 xr[4];
#pragma unroll
            for (int bi = 0; bi < 4; ++bi) {
                const bf16x8 ta = *(const LAS bf16x8*)(L3 + R1_TINV + ((bi * 16 + li) * 32 + 8 * g) * 2);
                const bf16x8 rb = tr8(Rsrc + (16 * bi + 8 * g1 + q4) * R1_RS + 8 * p4, 4 * R1_RS);
                xr[bi] = __builtin_amdgcn_mfma_f32_16x16x32_bf16(ta, rb, (f32x4){0.f, 0.f, 0.f, 0.f}, 0, 0, 0);
            }
            if (w < 6) {
                const int bi = w < 1 ? 1 : (w < 3 ? 2 : 3), bj = w < 1 ? 0 : (w < 3 ? w - 1 : w - 3);
                const bf16x8 ta = *(const LAS bf16x8*)(L3 + R1_TINV + ((bi * 16 + li) * 32 + 8 * g) * 2);
                const bf16x8 lb = tr8(L3 + R1_ABO + (16 * bi + 8 * g1 + q4) * R1_RS + 32 * bj + 8 * p4, 4 * R1_RS);
                const f32x4 lp = __builtin_amdgcn_mfma_f32_16x16x32_bf16(ta, lb, (f32x4){0.f, 0.f, 0.f, 0.f}, 0, 0, 0);
#pragma unroll
                for (int r = 0; r < 4; ++r) *(LAS bf16_t*)(L3 + R1_LP + (16 * bi + 4 * g + r) * R1_RS + (16 * bj + li) * 2) = (bf16_t)f2bf(lp[r]);
            }
            __syncthreads();
#pragma unroll
            for (int bi = 0; bi < 4; ++bi) {
                if (bi > 0) {
                    f32x4 acc = (f32x4){0.f, 0.f, 0.f, 0.f};
#pragma unroll
                    for (int ks = 0; ks < (bi + 1) / 2; ++ks) {
                        const bf16x8 a = *(const LAS bf16x8*)(L3 + R1_LP + (16 * bi + li) * R1_RS + (32 * ks + 8 * g) * 2);
                        const bf16x8 bx = tr8(L3 + R1_XB + (32 * ks + 8 * g + q4) * R1_XRS + 32 * w + 8 * p4, 4 * R1_XRS);
                        acc = __builtin_amdgcn_mfma_f32_16x16x32_bf16(a, bx, acc, 0, 0, 0);
                    }
                    xr[bi] = xr[bi] - acc;
                }
#pragma unroll
                for (int r = 0; r < 4; ++r) *(LAS bf16_t*)(L3 + R1_XB + (16 * bi + 4 * g + r) * R1_XRS + (16 * w + li) * 2) = (bf16_t)f2bf(xr[bi][r]);
                asm volatile("s_waitcnt lgkmcnt(0)" ::: "memory");
            }
        }
        __syncthreads();
        R1_MARK(5)
        {
            R1_LANES
            f32x4 gx[2], yx[2], mx[2], nx[2];
#pragma unroll
            for (int n = 0; n < 2; ++n) { gx[n] = (f32x4){0.f, 0.f, 0.f, 0.f}; yx[n] = gx[n]; mx[n] = gx[n]; nx[n] = gx[n]; }
            mm_tiles<false, true>(L3 + R1_BB, R1_RS, L3 + R1_XB, R1_XRS, 2, gx, mt, nt0, g, li);
            mm_tiles<false, true>(L3 + R1_BB, R1_RS, L3 + R1_XB + 128, R1_XRS, 2, yx, mt, nt0, g, li);
            mm_tiles<true, true>(L3 + R1_BT, R1_RS, L3 + R1_XB, R1_XRS, 2, mx, mt, nt0, g, li);
            mm_tiles<true, true>(L3 + R1_BT, R1_RS, L3 + R1_XB + 128, R1_XRS, 2, nx, mt, nt0, g, li);
            const f32x4 elc = *(const LAS f32x4*)(L3 + R1_ELC + (16 * mt + 4 * g) * 4);
#pragma unroll
            for (int n = 0; n < 2; ++n) {
                const int col = 16 * (nt0 + n) + li;
                float nv[4];
#pragma unroll
                for (int r = 0; r < 4; ++r) {
                    const int rw = 16 * mt + 4 * g + r, o = rw * R1_RS + col * 2;
                    const float rho = bf2f(*(const LAS bf16_t*)(L3 + R1_RHO + o));
                    *(LAS bf16_t*)(L3 + R1_AK + o) = (bf16_t)f2bf(rho - gx[n][r]);
                    *(LAS bf16_t*)(L3 + R1_ABO + o) = (bf16_t)f2bf(-elc[r] * mx[n][r]);
                    *(LAS bf16_t*)(L3 + R1_BK + o) = (bf16_t)f2bf(y0a[n][r] - yx[n][r]);
                    nv[r] = elc[r] * (na[n][r] - nx[n][r]);
                }
                u32x2 nf; nf.x = pk2(nv[0], nv[1]); nf.y = pk2(nv[2], nv[3]);
                st_b64(rec + CH_N + ((mt * 4 + nt0 + n) * 64 + lane) * 8, nf);
            }
        }
        __syncthreads();
        R1_MARK(6)
        {
            R1_LANES
            const int fo = (16 * (w >> 1) + li) * R1_RS + (32 * (w & 1) + 8 * g) * 2;
            st_b128(rec + CH_G + (w * 64 + lane) * 16, *(const LAS u32x4*)(L3 + R1_AK + fo));
            st_b128(rec + CH_M + (w * 64 + lane) * 16, *(const LAS u32x4*)(L3 + R1_ABO + fo));
            if (lat) st_b128(Yo + (size_t)row * RW + 64 * h + c8, *(const LAS u32x4*)(L3 + R1_BK + t * R1_RS + c8 * 2));
        }
        __syncthreads();
        R1_MARK(7)
    }
    if (DIAG_ON && bid == 0 && tid == 0) { float* dg = (float*)(p.ws + WS_DIAG); for (int k = 0; k < 8; ++k) dg[8 + k] = (float)dS[k]; }
#undef R1_MARK
#undef R1_LANES
}

constexpr int R2_SB = 0, R2_SRS = 80, R2_SBB = 64 * R2_SRS;
struct R2Regs { bf16x8 am[2], ag[2]; u32x2 nf; f32x4 el; bf16_t y0[4]; };
__device__ __forceinline__ void phase_r2(const P& p, LAS unsigned char* L3, int task, unsigned pflags) {
    int tid_ = threadIdx.x; asm volatile("" : "+v"(tid_));
    const int tid = tid_, lane = tid & 63, w = __builtin_amdgcn_readfirstlane(tid >> 6), g = lane >> 4, li = lane & 15, q4 = li >> 2, p4 = li & 3;
    const int stream = task >> 1, vh = task & 1, dir = stream >> 5, b = (stream >> 4) & 1, h = stream & 15;
    const int kt = w >> 1, vt = w & 1, vtg = 2 * vh + vt;
    bf16_t* Yo = (bf16_t*)(p.ws + (dir ? WS_YB : WS_YF));
    const unsigned char* rec0 = p.ws + WS_CHD + (size_t)stream * NCHUNK * CH_REC;
    auto rlow = [&](int c) -> int { const int r0 = step_row(64 * c, b, dir); return dir ? r0 - 63 : r0; };
    unsigned offY[4];
#pragma unroll
    for (int r = 0; r < 4; ++r) { const int j = 16 * kt + 4 * g + r; offY[r] = (unsigned)((dir ? 63 - j : j) * (RW * 2) + (16 * vtg + li) * 2); }
    unsigned char* Yb = (unsigned char*)Yo + 64 * h * 2;
    const unsigned offA0 = (unsigned)(((kt * 2 + 0) * 64 + lane) * 16), offA1 = (unsigned)(((kt * 2 + 1) * 64 + lane) * 16), offN = (unsigned)(CH_N + ((kt * 4 + vtg) * 64 + lane) * 8), offE = (unsigned)(CH_E + (16 * kt + 4 * g) * 4);
    auto loadstep = [&](int c, R2Regs& R) {
        if (pflags & 128u) return;
        const unsigned char* rec = rec0 + (size_t)c * CH_REC;
        R.am[0] = *(const bf16x8*)(rec + CH_M + offA0); R.am[1] = *(const bf16x8*)(rec + CH_M + offA1); R.ag[0] = *(const bf16x8*)(rec + CH_G + offA0); R.ag[1] = *(const bf16x8*)(rec + CH_G + offA1);
        R.nf = *(const u32x2*)(rec + offN);
        R.el = *(const f32x4*)(rec + offE);
        if (c >= LC / 64) {
            const unsigned char* yb = Yb + (size_t)rlow(c) * (RW * 2);
#pragma unroll
            for (int r = 0; r < 4; ++r) R.y0[r] = *(const bf16_t*)(yb + offY[r]);
        }
    };
    f32x4 S = (f32x4){0.f, 0.f, 0.f, 0.f};
    unsigned long long dT[4] = {0ull, 0ull, 0ull, 0ull};
    auto step = [&](int c, const R2Regs& R) {
        unsigned long long q0 = 0, q1 = 0, q2 = 0;
        if (DIAG_ON) q0 = tick();
        LAS unsigned char* SB = L3 + R2_SB + (c & 1) * R2_SBB;
        bf16x8 bs[2] = {(bf16x8){0, 0, 0, 0, 0, 0, 0, 0}, (bf16x8){0, 0, 0, 0, 0, 0, 0, 0}};
        if (!(pflags & 256u)) {
#pragma unroll
        for (int r = 0; r < 4; ++r) *(LAS bf16_t*)(SB + (16 * kt + 4 * g + r) * R2_SRS + (16 * vt + li) * 2) = (bf16_t)f2bf(S[r]);
        __syncthreads();
#pragma unroll
        for (int ks = 0; ks < 2; ++ks) bs[ks] = tr8(SB + (32 * ks + 8 * g + q4) * R2_SRS + 32 * vt + 8 * p4, 4 * R2_SRS);
        }
        if (DIAG_ON) { asm volatile("s_waitcnt lgkmcnt(0)" ::: "memory"); q1 = tick(); }
        f32x4 ns; ns[0] = R.el[0] * S[0] + bflo(R.nf.x); ns[1] = R.el[1] * S[1] + bfhi(R.nf.x); ns[2] = R.el[2] * S[2] + bflo(R.nf.y); ns[3] = R.el[3] * S[3] + bfhi(R.nf.y);
        f32x4 ya = (f32x4){0.f, 0.f, 0.f, 0.f};
        const bool lat = c >= LC / 64;
        if (lat) { ya[0] = bf2f(R.y0[0]); ya[1] = bf2f(R.y0[1]); ya[2] = bf2f(R.y0[2]); ya[3] = bf2f(R.y0[3]); }
#pragma unroll
        for (int ks = 0; ks < 2; ++ks) { ns = __builtin_amdgcn_mfma_f32_16x16x32_bf16(R.am[ks], bs[ks], ns, 0, 0, 0); ya = __builtin_amdgcn_mfma_f32_16x16x32_bf16(R.ag[ks], bs[ks], ya, 0, 0, 0); }
        if (lat && !(pflags & 512u)) {
            unsigned char* yb = Yb + (size_t)rlow(c) * (RW * 2);
#pragma unroll
            for (int r = 0; r < 4; ++r) st_b16(yb + offY[r], f2bf(ya[r]));
        }
        S = ns;
        if (DIAG_ON) { asm volatile("s_nop 7\n\ts_nop 7" : "+v"(S)); q2 = tick(); dT[0] += q1 - q0; dT[1] += q2 - q1; }
    };
    unsigned long long tA = 0, rA = 0; if (DIAG_ON) { tA = tick(); rA = __builtin_amdgcn_s_memrealtime(); }
    R2Regs Q0, Q1, Q2, Q3, Q4, Q5;
    loadstep(0, Q0); loadstep(1, Q1); loadstep(2, Q2); loadstep(3, Q3); loadstep(4, Q4);
#define R2_STEP(k, QL, QS) { if (c + (k) + 5 < NCHUNK) loadstep(c + (k) + 5, QL); if (c + (k) < NCHUNK) step(c + (k), QS); }
    for (int c = 0; c < NCHUNK; c += 6) {
        R2_STEP(0, Q5, Q0) R2_STEP(1, Q0, Q1) R2_STEP(2, Q1, Q2) R2_STEP(3, Q2, Q3) R2_STEP(4, Q3, Q4) R2_STEP(5, Q4, Q5)
    }
#undef R2_STEP
    if (DIAG_ON && task == 0 && tid == 0) { float* dg = (float*)(p.ws + WS_DIAG); dg[0] = (float)(tick() - tA); dg[1] = (float)(__builtin_amdgcn_s_memrealtime() - rA); dg[2] = (float)dT[0]; dg[3] = (float)dT[1]; }
    __syncthreads();
}
constexpr int TR_SCR = 64 * 65 * 4;
__device__ __forceinline__ void transpose_item(const float* W, int K, int N, int Npad, bf16_t* WT, int row_off, LAS float* scr, int item, int lane) {
    const int nblk = Npad / 64, kb = item / nblk, nb = item % nblk, k0 = 64 * kb, n0 = 64 * nb;
    const int n4 = (lane & 15) * 4, kq = lane >> 4;
    f32x4 v[16];
#pragma unroll
    for (int i = 0; i < 16; ++i) v[i] = (n0 + n4 < N) ? *(const f32x4*)(W + (size_t)(k0 + 4 * i + kq) * N + n0 + n4) : (f32x4){0.f, 0.f, 0.f, 0.f};
#pragma unroll
    for (int i = 0; i < 16; ++i) { LAS float* d = scr + (4 * i + kq) * 65 + n4; d[0] = v[i].x; d[1] = v[i].y; d[2] = v[i].z; d[3] = v[i].w; }
    LDS_WAIT(); asm volatile("" ::: "memory");
    const int c = lane & 7;
#pragma unroll
    for (int j = 0; j < 8; ++j) { const int n = (lane >> 3) + 8 * j; const LAS float* s = scr + (8 * c) * 65 + n;
        v4u o; o.x = pk2(s[0 * 65], s[1 * 65]); o.y = pk2(s[2 * 65], s[3 * 65]); o.z = pk2(s[4 * 65], s[5 * 65]); o.w = pk2(s[6 * 65], s[7 * 65]);
        *(GAS v4u*)(WT + (size_t)(row_off + n0 + n) * K + k0 + 8 * c) = o; }
    LDS_WAIT(); asm volatile("" ::: "memory");
}

constexpr int RING_OFF = 0, RING_BYTES = 131072;
constexpr int LDS_BYTES = 147456;
constexpr int LDSCTL_OFF = LDS_BYTES - 512, MISC_OFF = LDSCTL_OFF + 320, PARAM_OFF = LDS_BYTES - 1024;
__device__ __forceinline__ P load_params(const LAS unsigned* src) {
    P q; void** d = (void**)&q;
#pragma unroll
    for (int i = 0; i < 32; ++i) {
        const unsigned long long v = (unsigned long long)(unsigned)__builtin_amdgcn_readfirstlane((int)src[2 * i]) | ((unsigned long long)(unsigned)__builtin_amdgcn_readfirstlane((int)src[2 * i + 1]) << 32);
        d[i] = (void*)(GAS void*)v;
    }
    q.mask = 0u; q.pad = 0u;
    return q;
}
static_assert(8 * TR_SCR <= PARAM_OFF && ML_END <= PARAM_OFF && MI_END <= PARAM_OFF && R1_PAR + 1280 <= PARAM_OFF && sizeof(P) == 264, "LDS map");
constexpr int CW_BAR = 4096;
constexpr size_t CTL_ZERO_BYTES = 1 * MiB;
constexpr int NWAVES = 8;

__global__ void __launch_bounds__(NWAVES * 64, 2) mega_fwd(P p_arg) {
    extern __shared__ __attribute__((aligned(16))) unsigned char lds[];
    LAS unsigned char* L3 = (LAS unsigned char*)lds;
    volatile LAS unsigned* MISC = (volatile LAS unsigned*)(L3 + MISC_OFF);
    const int tid0 = threadIdx.x, wave = __builtin_amdgcn_readfirstlane(tid0 >> 6);
    const int G = gridDim.x, bx = blockIdx.x;
    const int vcu = (G % 8 == 0) ? (bx % 8) * (G / 8) + bx / 8 : bx;
    for (int u = tid0; u < (LDS_BYTES - LDSCTL_OFF) / 4; u += NWAVES * 64) ((LAS unsigned*)(L3 + LDSCTL_OFF))[u] = 0u;
    const LAS unsigned* PRM = (const LAS unsigned*)(L3 + PARAM_OFF);
    if (tid0 < 66) ((LAS unsigned*)(L3 + PARAM_OFF))[tid0] = ((const unsigned*)__builtin_amdgcn_kernarg_segment_ptr())[tid0];
    __syncthreads();
    XcdBarrier bar;
    { const P p = load_params(PRM); const unsigned region = (unsigned)__builtin_amdgcn_readfirstlane((int)PRM[65]); bar = xcd_barrier_post((unsigned*)(p.ws + WS_CTL) + CW_BAR + region * XCD_BAR_WORDS, MISC + 8); }
    const int gw = vcu * NWAVES + wave, ngw = G * NWAVES;
    const unsigned pflags = (unsigned)__builtin_amdgcn_readfirstlane((int)PRM[65]);
    const unsigned pmask = (unsigned)__builtin_amdgcn_readfirstlane((int)PRM[64]);
    int ph_idx_ = 0;
#define PH_BEGIN if ((pmask >> ph_idx_) & 1u) { const int tid = threadIdx.x, lane = tid & 63; (void)tid; (void)lane; const P p = load_params(PRM); unsigned char* ws = p.ws; const float* MOD = (const float*)(ws + WS_MOD); (void)MOD;
#define PH_END }
#define PH_BAR if ((pmask >> ph_idx_) & 1u) xcd_barrier(bar); ++ph_idx_;

    PH_BEGIN
    phase_mod(p, bx, G, (float*)lds);
    {
        LAS float* scr = (LAS float*)(L3 + RING_OFF + wave * TR_SCR);
        constexpr int I_IN = (D / 64) * (LDP / 64), I_OUT = (D / 64) * (D / 64);
        for (int it = gw; it < I_IN + I_OUT; it += ngw) {
            if (it < I_IN) transpose_item(p.w_in, D, NIN, LDP, (bf16_t*)(ws + WS_WIN_T), 0, scr, it, lane);
            else transpose_item(p.w_out, D, D, D, (bf16_t*)(ws + WS_WOUT_T), 0, scr, it - I_IN, lane);
        }
    }
    {
        bf16_t* WUPT = (bf16_t*)(ws + WS_WUPT); bf16_t* AUPT = (bf16_t*)(ws + WS_AUPT); bf16_t* GUPT = (bf16_t*)(ws + WS_GUPT);
        const int gt = bx * (NWAVES * 64) + tid, ngt = G * NWAVES * 64;
        for (int o = gt; o < 2 * 1024 * 64; o += ngt) { const int r = o & 63, c = (o >> 6) & 1023, d = o >> 16; const size_t si = (size_t)(d * 64 + r) * RW + c; WUPT[o] = (bf16_t)f2bf(p.r_w_up[si]); AUPT[o] = (bf16_t)f2bf(p.r_a_up[si]); }
        for (int o = gt; o < 1024 * 160; o += ngt) { const int i = o % 160, c = o / 160; GUPT[o] = (bf16_t)f2bf(p.r_g_up[(size_t)i * RW + c]); }
    }
    PH_END
    PH_BAR
    PH_BEGIN
    phase_normmod(p, 0, gw, ngw, lane);
    PH_END
    PH_BAR
    PH_BEGIN
    {
        pg8::Gemm g{(const bf16_t*)(ws + WS_HX), (const bf16_t*)(ws + WS_WIN_T), NROW, LDP, D}; pg8::StaticOrder S; S.init(NROW, LDP, G, bx);
        pg8::EpiBf16<0> E{(bf16_t*)(ws + WS_PROJ), LDP, nullptr, 0, 0, 1.f};
        pg8::gemm_phase<pg8::EpiBf16<0>, pg8::StaticOrder, true, true>(L3 + RING_OFF, g, S, E);
    }
    PH_END
    PH_BAR
    PH_BEGIN
    if (!(pflags & 8u)) phase_prep(p, bx, G);
    if (!(pflags & 16u)) phase_r1(p, L3, bx, G, pflags);
    PH_END
    PH_BAR
    PH_BEGIN
    phase_mintra(p, L3, bx, G);
    PH_END
    PH_BAR
    PH_BEGIN
    if (bx < 128) { if (!(pflags & 2u)) phase_mlstm(p, L3, bx); } else if (bx < 256) { if (!(pflags & 4u)) phase_r2(p, L3, bx - 128, pflags); }
    PH_END
    PH_BAR
    PH_BEGIN
    phase_post(p, gw, ngw, lane);
    PH_END
    PH_BAR
    PH_BEGIN
    {
        pg8::Gemm g{(const bf16_t*)(ws + WS_MIX), (const bf16_t*)(ws + WS_WOUT_T), NTOK, D, D}; pg8::StaticOrder S; S.init(NTOK, D, G, bx);
        pg8::EpiResid E{p.x, p.out, D, MOD + 2 * 2048, NMOD};
        pg8::gemm_phase<pg8::EpiResid, pg8::StaticOrder, true, true>(L3 + RING_OFF, g, S, E);
    }
    PH_END
    PH_BAR
    PH_BEGIN
    phase_normmod(p, 1, gw, ngw, lane);
    {
        LAS float* scr = (LAS float*)(L3 + RING_OFF + wave * TR_SCR);
        constexpr int I_UP = (D / 64) * (FF / 64), I_DN = (FF / 64) * (D / 64);
        for (int it = gw; it < 2 * I_UP; it += ngw) {
            if (it < I_UP) transpose_item(p.f_w_up, D, FF, FF, (bf16_t*)(ws + WS_WUG_T), 0, scr, it, lane);
            else transpose_item(p.f_w_gate, D, FF, FF, (bf16_t*)(ws + WS_WUG_T), FF, scr, it - I_UP, lane);
        }
    }
    PH_END
    PH_BAR
    PH_BEGIN
    {
        pg8::Gemm g{(const bf16_t*)(ws + WS_HX2), (const bf16_t*)(ws + WS_WUG_T), NTOK, 2 * FF, D}; pg8::StaticOrder S; S.init(NTOK, 2 * FF, G, bx);
        pg8::EpiBf16<0> E{(bf16_t*)(ws + WS_UG), 2 * FF, nullptr, 0, 0, 1.f};
        pg8::gemm_phase<pg8::EpiBf16<0>, pg8::StaticOrder, true, true>(L3 + RING_OFF, g, S, E);
        if (G == 256 && bx >= 128) {
            __syncthreads();
            LAS float* scr = (LAS float*)(L3 + RING_OFF + wave * TR_SCR);
            constexpr int I_DN = (FF / 64) * (D / 64);
            for (int it = (bx - 128) * NWAVES + wave; it < I_DN; it += 128 * NWAVES) transpose_item(p.f_w_down, FF, D, D, (bf16_t*)(ws + WS_WDN_T), 0, scr, it, lane);
        } else if (G != 256) {
            __syncthreads();
            LAS float* scr = (LAS float*)(L3 + RING_OFF + wave * TR_SCR);
            constexpr int I_DN = (FF / 64) * (D / 64);
            for (int it = gw; it < I_DN; it += ngw) transpose_item(p.f_w_down, FF, D, D, (bf16_t*)(ws + WS_WDN_T), 0, scr, it, lane);
        }
    }
    PH_END
    PH_BAR
    PH_BEGIN
    phase_convact(p, gw, lane);
    PH_END
    PH_BAR
    PH_BEGIN
    {
        pg8::Gemm g{(const bf16_t*)(ws + WS_ACT), (const bf16_t*)(ws + WS_WDN_T), NTOK, D, FF}; pg8::StaticOrder S; S.init(NTOK, D, G, bx);
        pg8::EpiResid E{p.out, p.out, D, MOD + 5 * 2048, NMOD};
        pg8::gemm_phase<pg8::EpiResid, pg8::StaticOrder, true, true>(L3 + RING_OFF, g, S, E);
    }
    PH_END
    PH_BAR
    PH_BEGIN
    phase_final(p, gw, ngw, lane);
#ifdef DIAG_SLOT
    if (bx == 0 && threadIdx.x == 0) { asm volatile("s_waitcnt vmcnt(0)" ::: "memory"); p.out[0] = rintf(log2f(fmaxf(((const float*)(ws + WS_DIAG))[DIAG_SLOT], 1.f)) * 4.f) + (DIAG_SCALE); }
#endif
    PH_END
#undef PH_BEGIN
#undef PH_END
#undef PH_BAR
}

extern "C" void kernel_launch(void* const* d_in, const int* in_sizes, int n_in, void* d_out, int out_size, void* d_ws, size_t ws_size, hipStream_t stream) {
    static int grid = 0;
    if (grid == 0) {
        if (n_in != 30 || out_size != NTOK * D || ws_size < WS_END) { fprintf(stderr, "kernel_launch: unexpected n_in %d / out %d / ws %zu\n", n_in, out_size, ws_size); grid = -1; return; }
        int dev = 0, cus = 0, per_cu = 0;
        if (hipGetDevice(&dev) != hipSuccess || hipDeviceGetAttribute(&cus, hipDeviceAttributeMultiprocessorCount, dev) != hipSuccess) { grid = -1; return; }
        if (hipFuncSetAttribute((const void*)mega_fwd, hipFuncAttributeMaxDynamicSharedMemorySize, LDS_BYTES) != hipSuccess) { fprintf(stderr, "kernel_launch: hipFuncSetAttribute failed\n"); grid = -1; return; }
        if (hipOccupancyMaxActiveBlocksPerMultiprocessor(&per_cu, (const void*)mega_fwd, NWAVES * 64, LDS_BYTES) != hipSuccess || per_cu < 1) fprintf(stderr, "kernel_launch: occupancy query reports %d\n", per_cu);
        (void)hipGetLastError();
        grid = cus;
    }
    if (grid < 0) return;
    if (hipMemsetAsync((char*)d_ws + WS_CTL, 0, CTL_ZERO_BYTES, stream) != hipSuccess) { fprintf(stderr, "kernel_launch: memset failed\n"); return; }
    P p{};
    const float** f = (const float**)&p;
    for (int i = 0; i < 30; ++i) f[i] = (const float*)d_in[i];
    p.out = (float*)d_out; p.ws = (unsigned char*)d_ws; p.mask = 0x1FFFu;
    hipLaunchKernelGGL(mega_fwd, dim3(grid), dim3(NWAVES * 64), LDS_BYTES, stream, p);
#ifdef PROBE_PHASE
#ifndef PROBE_FLAGS
#define PROBE_FLAGS 0u
#endif
    { P q = p; q.mask = PROBE_PHASE; q.pad = 1u | (PROBE_FLAGS); hipLaunchKernelGGL(mega_fwd, dim3(grid), dim3(NWAVES * 64), LDS_BYTES, stream, q); }
#endif
}
```

```cpp
#include <hip/hip_runtime.h>
#include <cstdint>
#include <cstdio>
namespace pg8 {
#define PG8_LAS __attribute__((address_space(3)))
typedef unsigned short bf16_t;
typedef short bf16x8 __attribute__((ext_vector_type(8)));
typedef float f32x4 __attribute__((ext_vector_type(4)));
typedef unsigned u32x4 __attribute__((ext_vector_type(4)));
constexpr int BM = 256, BK = 64, HALF = 128, HTB = HALF * BK * 2  , STAGE_BYTES = 8 * HTB, NXCD = 8, WGM = 8;

__host__ __device__ __forceinline__ int lds_byte(int r, int c) { const int st = (r >> 4) * 2 + (c >> 5), rr = r & 15, cc = c & 31, ob = rr * 64 + cc * 2; return st * 1024 + (ob ^ (((ob >> 9) & 1) << 5)); }
__host__ __device__ __forceinline__ void stage_rc(int b, int& R, int& C) { const int st = b / 1024, sb = b % 1024, swz = sb ^ (((sb >> 9) & 1) << 5); R = (st >> 1) * 16 + swz / 64; C = (st & 1) * 32 + (swz % 64) / 2; }
__host__ __device__ __forceinline__ int perm32(int rho) { const int n = rho >> 4, i = rho & 15; return 8 * (i >> 2) + 4 * n + (i & 3); }

struct Unit { int pm, pn; };
struct Gemm { const bf16_t* A; const bf16_t* Bt; int M, N, K; };

struct StaticOrder {
    int nM, nN, nwg, G, c;
    __host__ __device__ void init(int M, int N, int G_, int c_) { nM = M / BM; nN = N / BM; nwg = nM * nN; G = G_; c = c_; }
    __host__ __device__ bool next(int i, Unit& u) const {
        const long L = (long)i * G + c; if (L >= nwg) return false;
        int wgid = (int)L; { const int q = nwg / NXCD, r = nwg % NXCD, xcd = wgid % NXCD, off = wgid / NXCD; wgid = (xcd < r ? xcd * (q + 1) : r * (q + 1) + (xcd - r) * q) + off; }
        const int nig = WGM * nN, gid = wgid / nig, fm = gid * WGM, gsz = (nM - fm) < WGM ? (nM - fm) : WGM;
        u.pm = fm + ((wgid % nig) % gsz); u.pn = (wgid % nig) / gsz; return true;
    }
    __device__ __forceinline__ void a_ready(const Unit&) const {}
    __device__ __forceinline__ void done(const Unit&) const {}
};

__device__ __forceinline__ unsigned cvt_pk_bf16(float lo, float hi) { unsigned r; asm volatile("v_cvt_pk_bf16_f32 %0, %1, %2" : "=v"(r) : "v"(lo), "v"(hi)); return r; }
typedef float f32x2 __attribute__((ext_vector_type(2)));
__device__ __forceinline__ f32x2 gelu_pk(f32x2 v) {
    const f32x2 av = __builtin_elementwise_abs(v), d = av * 0.2316418882f + 1.0f;
    f32x2 t; t.x = __builtin_amdgcn_rcpf(d.x); t.y = __builtin_amdgcn_rcpf(d.y);
    f32x2 q = t * 0.5307027145f + (-0.7265760135f); q = q * t + 0.7107068705f; q = q * t + (-0.142248368f); q = q * t + 0.127414796f; q = q * t;
    const f32x2 s = (v * v) * (-0.72134752044f);
    f32x2 e; e.x = __builtin_amdgcn_exp2f(s.x); e.y = __builtin_amdgcn_exp2f(s.y);
    const f32x2 m = v * (q * e), r = v - m;
    f32x2 o; o.x = v.x < 0.f ? m.x : r.x; o.y = v.y < 0.f ? m.y : r.y; return o;
}

template <int ACT  > struct EpiBf16 {
    static constexpr bool PERM = true, AFTER_DRAIN = false; static_assert(ACT == 0 || ACT == 1, "EpiBf16: ACT is 0 (none) or 1 (gelu_pk)");
    bf16_t* O; int ldc; const float* bias; int split_cols; size_t split_stride; float scale0;
    __device__ __forceinline__ void operator()(const f32x4 (&acc)[2][2][4][2], const Unit& u, int wr, int wc, int fr, int fq) const {
        const int row0 = u.pm * BM + wr * 64 + fr; int colt = u.pn * BM; bf16_t* base = O;
        float sc = 1.f; if (split_cols) { const int t = colt / split_cols; base += (size_t)t * split_stride; colt -= t * split_cols; if (t == 0) sc = scale0; }
        const int col0 = colt + wc * 32 + 8 * fq, bcol0 = u.pn * BM + wc * 32 + 8 * fq;
        f32x4 bv[2][2];
#pragma unroll
        for (int bj = 0; bj < 2; ++bj)
#pragma unroll
            for (int n = 0; n < 2; ++n) bv[bj][n] = bias ? *(const f32x4*)(bias + bcol0 + bj * HALF + 4 * n) : (f32x4){0.f, 0.f, 0.f, 0.f};
#pragma unroll
        for (int ai = 0; ai < 2; ++ai)
#pragma unroll
            for (int m = 0; m < 4; ++m) { bf16_t* rowp = base + (size_t)(row0 + ai * HALF + m * 16) * ldc + col0;
#pragma unroll
                for (int bj = 0; bj < 2; ++bj) { f32x4 v0 = acc[ai][bj][m][0] + bv[bj][0], v1 = acc[ai][bj][m][1] + bv[bj][1];
                    if (ACT == 1) { f32x2 a = gelu_pk((f32x2){v0[0], v0[1]}), b = gelu_pk((f32x2){v0[2], v0[3]}), c = gelu_pk((f32x2){v1[0], v1[1]}), d = gelu_pk((f32x2){v1[2], v1[3]});
                        v0 = (f32x4){a.x, a.y, b.x, b.y}; v1 = (f32x4){c.x, c.y, d.x, d.y}; }
                    v0 = v0 * sc; v1 = v1 * sc; u32x4 w; w.x = cvt_pk_bf16(v0[0], v0[1]); w.y = cvt_pk_bf16(v0[2], v0[3]); w.z = cvt_pk_bf16(v1[0], v1[1]); w.w = cvt_pk_bf16(v1[2], v1[3]);
                    *(u32x4*)(rowp + bj * HALF) = w; } }
    }
};
struct EpiResid {
    static constexpr bool PERM = false, AFTER_DRAIN = false;
    const float* base; float* out; int ldc; const float* gate; int gstride;
    __device__ __forceinline__ void operator()(const f32x4 (&acc)[2][2][4][2], const Unit& u, int wr, int wc, int fr, int fq) const {
        const int row0 = u.pm * BM + wr * 64 + fr, col0 = u.pn * BM + wc * 32 + 4 * fq;
        const float* g = gate + (size_t)((u.pm * BM) >> 12) * gstride + col0;
        f32x4 gv[2][2];
#pragma unroll
        for (int bj = 0; bj < 2; ++bj)
#pragma unroll
            for (int n = 0; n < 2; ++n) gv[bj][n] = *(const f32x4*)(g + bj * HALF + n * 16);
#pragma unroll
        for (int ai = 0; ai < 2; ++ai)
#pragma unroll
            for (int m = 0; m < 4; ++m) { const size_t off = (size_t)(row0 + ai * HALF + m * 16) * ldc + col0;
#pragma unroll
                for (int bj = 0; bj < 2; ++bj)
#pragma unroll
                    for (int n = 0; n < 2; ++n) { const f32x4 bs = *(const f32x4*)(base + off + bj * HALF + n * 16); *(f32x4*)(out + off + bj * HALF + n * 16) = bs + gv[bj][n] * acc[ai][bj][m][n]; } }
    }
};
template <class Epi, class Sched, bool ALIGN_EPI = false, bool SP2 = false>
__device__ __forceinline__ void gemm_phase(PG8_LAS unsigned char* lds, const Gemm g, const Sched& S, const Epi& E) {
    const int tid = threadIdx.x, wid = __builtin_amdgcn_readfirstlane(tid >> 6), lane = tid & 63, wr = wid >> 2, wc = wid & 3, fr = lane & 15, fq = lane >> 4;
    const int K = g.K, nt = K / BK;
    unsigned voffA[2], voffB[2];
#pragma unroll
    for (int i = 0; i < 2; ++i) { int R, C; stage_rc(tid * 16 + i * 8192, R, C); const int Rb = Epi::PERM ? ((R & ~31) + perm32(R & 31)) : R;
        voffA[i] = (unsigned)(R * K + C) * 2u; voffB[i] = (unsigned)(Rb * K + C) * 2u; }
    const size_t kstep = (size_t)(BK * 2);
    const size_t hstep = (size_t)HALF * K * 2;
    const size_t tstep = 2 * hstep;
    const unsigned ldsw = (unsigned)wid * 1024u;
    const int aoff = lds_byte(wr * 64 + fr, fq * 8), boff = lds_byte(wc * 32 + fr, fq * 8);
#define PG8_SA(b, h) (((b) * 2 + (h)) * HTB)
#define PG8_SB(b, h) ((4 + (b) * 2 + (h)) * HTB)
#define PG8_STAGE(bufoff, gbase, voff) do { _Pragma("unroll") for (int _i = 0; _i < 2; ++_i) \
        __builtin_amdgcn_global_load_lds((const unsigned*)((const char*)(gbase) + (voff)[_i]), (PG8_LAS unsigned*)(lds + (bufoff) + ldsw + _i * 8192), 16, 0, 0); } while (0)
#define PG8_LDA(dst, b, h) do { _Pragma("unroll") for (int m = 0; m < 4; ++m) _Pragma("unroll") for (int k = 0; k < 2; ++k) dst[m][k] = *(const PG8_LAS bf16x8*)(lds + PG8_SA(b, h) + aoff + m * 2048 + k * 1024); } while (0)
#define PG8_LDB(dst, b, h) do { _Pragma("unroll") for (int n = 0; n < 2; ++n) _Pragma("unroll") for (int k = 0; k < 2; ++k) dst[n][k] = *(const PG8_LAS bf16x8*)(lds + PG8_SB(b, h) + boff + n * 2048 + k * 1024); } while (0)
#define PG8_MMA(ai, bj, At, Bt) do { __builtin_amdgcn_s_setprio(1); _Pragma("unroll") for (int m = 0; m < 4; ++m) _Pragma("unroll") for (int n = 0; n < 2; ++n) _Pragma("unroll") for (int k = 0; k < 2; ++k) \
        acc[ai][bj][m][n] = __builtin_amdgcn_mfma_f32_16x16x32_bf16(Bt[n][k], At[m][k], acc[ai][bj][m][n], 0, 0, 0); __builtin_amdgcn_s_setprio(0); } while (0)
#define PG8_WAIT_V(n) asm volatile("s_waitcnt vmcnt(" #n ")" ::: "memory")
#define PG8_WAIT_L(n) asm volatile("s_waitcnt lgkmcnt(" #n ")" ::: "memory")
#define PG8_BAR __builtin_amdgcn_s_barrier()
#define PG8_SCHED __builtin_amdgcn_sched_barrier(0)
    Unit cur, nxt; int ui = 0;
    if (!S.next(0, cur)) return;
    f32x4 acc[2][2][4][2];
#pragma unroll
    for (int a = 0; a < 2; ++a)
#pragma unroll
        for (int b = 0; b < 2; ++b)
#pragma unroll
            for (int m = 0; m < 4; ++m)
#pragma unroll
                for (int n = 0; n < 2; ++n) acc[a][b][m][n] = (f32x4){0.f, 0.f, 0.f, 0.f};
    bf16x8 At[4][2], B0[2][2], B1[2][2];
    const char* cA = (const char*)g.A + (size_t)cur.pm * tstep; const char* cB = (const char*)g.Bt + (size_t)cur.pn * tstep;
    S.a_ready(cur);
    if constexpr (SP2) {
        PG8_STAGE(PG8_SB(0, 0), cB, voffB); PG8_STAGE(PG8_SB(0, 1), cB + hstep, voffB); PG8_STAGE(PG8_SA(0, 0), cA, voffA); PG8_STAGE(PG8_SA(0, 1), cA + hstep, voffA);
        if (wr == 1) PG8_BAR;
        PG8_WAIT_V(2); PG8_BAR;
        PG8_STAGE(PG8_SB(1, 0), cB + kstep, voffB); PG8_STAGE(PG8_SA(1, 0), cA + kstep, voffA); PG8_STAGE(PG8_SB(1, 1), cB + hstep + kstep, voffB);
        PG8_WAIT_V(6); PG8_BAR;
    } else {
        PG8_STAGE(PG8_SB(0, 0), cB, voffB); PG8_STAGE(PG8_SA(0, 0), cA, voffA); PG8_STAGE(PG8_SB(0, 1), cB + hstep, voffB); PG8_STAGE(PG8_SA(0, 1), cA + hstep, voffA);
        if (wr == 1) PG8_BAR;
        PG8_WAIT_V(4); PG8_BAR;
        PG8_STAGE(PG8_SB(1, 0), cB + kstep, voffB); PG8_STAGE(PG8_SA(1, 0), cA + kstep, voffA); PG8_STAGE(PG8_SB(1, 1), cB + hstep + kstep, voffB);
        PG8_WAIT_V(6); PG8_BAR;
    }
    for (;;) {
        const bool has_next = S.next(ui + 1, nxt);
        const char* nA = has_next ? (const char*)g.A + (size_t)nxt.pm * tstep : cA; const char* nB = has_next ? (const char*)g.Bt + (size_t)nxt.pn * tstep : cB;
        for (int t = 0; t < nt; t += 2) {
            const bool last = (t == nt - 2);
            const char* a1 = cA + (size_t)(t + 1) * kstep;
            const char* a2 = last ? nA : cA + (size_t)(t + 2) * kstep; const char* b2 = last ? nB : cB + (size_t)(t + 2) * kstep;
            const char* a3 = a2 + kstep; const char* b3 = b2 + kstep;
            if (last && has_next) S.a_ready(nxt);
            if constexpr (SP2) {
            PG8_LDB(B0, 0, 0); PG8_LDB(B1, 0, 1); PG8_SCHED; PG8_LDA(At, 0, 0); PG8_STAGE(PG8_SA(1, 1), a1 + hstep, voffA);
            PG8_WAIT_V(8); PG8_WAIT_L(0); PG8_BAR; PG8_MMA(0, 0, At, B0); PG8_MMA(0, 1, At, B1); PG8_BAR; PG8_SCHED;
            PG8_LDA(At, 0, 1); PG8_STAGE(PG8_SB(0, 0), b2, voffB); PG8_STAGE(PG8_SB(0, 1), b2 + hstep, voffB); PG8_STAGE(PG8_SA(0, 0), a2, voffA);
            PG8_WAIT_V(8); PG8_WAIT_L(0); PG8_BAR; PG8_MMA(1, 0, At, B0); PG8_MMA(1, 1, At, B1); PG8_BAR; PG8_SCHED;
            PG8_LDB(B0, 1, 0); PG8_LDB(B1, 1, 1); PG8_SCHED; PG8_LDA(At, 1, 0); PG8_STAGE(PG8_SA(0, 1), a2 + hstep, voffA);
            PG8_WAIT_V(8); PG8_WAIT_L(0); PG8_BAR; PG8_MMA(0, 0, At, B0); PG8_MMA(0, 1, At, B1); PG8_BAR; PG8_SCHED;
            PG8_LDA(At, 1, 1); PG8_STAGE(PG8_SB(1, 0), b3, voffB); PG8_STAGE(PG8_SB(1, 1), b3 + hstep, voffB); PG8_STAGE(PG8_SA(1, 0), a3, voffA);
            PG8_WAIT_V(8); PG8_WAIT_L(0); PG8_BAR; PG8_MMA(1, 0, At, B0); PG8_MMA(1, 1, At, B1); PG8_BAR; PG8_SCHED;
            } else {
            PG8_LDB(B0, 0, 0); PG8_SCHED; PG8_LDA(At, 0, 0); PG8_STAGE(PG8_SA(1, 1), a1 + hstep, voffA);
            PG8_WAIT_L(8); PG8_BAR; PG8_WAIT_L(0); PG8_MMA(0, 0, At, B0); PG8_BAR; PG8_SCHED;
            PG8_LDB(B1, 0, 1); PG8_STAGE(PG8_SB(0, 0), b2, voffB);
            PG8_BAR; PG8_WAIT_L(0); PG8_MMA(0, 1, At, B1); PG8_BAR;
            PG8_LDA(At, 0, 1); PG8_STAGE(PG8_SA(0, 0), a2, voffA);
            PG8_BAR; PG8_WAIT_L(0); PG8_MMA(1, 0, At, B0); PG8_BAR; PG8_SCHED;
            PG8_STAGE(PG8_SB(0, 1), b2 + hstep, voffB);
            PG8_WAIT_V(6); PG8_BAR; PG8_MMA(1, 1, At, B1); PG8_BAR;
            PG8_LDB(B0, 1, 0); PG8_SCHED; PG8_LDA(At, 1, 0); PG8_STAGE(PG8_SA(0, 1), a2 + hstep, voffA);
            PG8_WAIT_L(8); PG8_BAR; PG8_WAIT_L(0); PG8_MMA(0, 0, At, B0); PG8_BAR; PG8_SCHED;
            PG8_LDB(B1, 1, 1); PG8_STAGE(PG8_SB(1, 0), b3, voffB);
            PG8_BAR; PG8_WAIT_L(0); PG8_MMA(0, 1, At, B1); PG8_BAR;
            PG8_LDA(At, 1, 1); PG8_STAGE(PG8_SA(1, 0), a3, voffA);
            PG8_BAR; PG8_WAIT_L(0); PG8_MMA(1, 0, At, B0); PG8_BAR; PG8_SCHED;
            PG8_STAGE(PG8_SB(1, 1), b3 + hstep, voffB);
            PG8_WAIT_V(6); PG8_BAR; PG8_MMA(1, 1, At, B1); PG8_BAR;
            }
        }
        if constexpr (ALIGN_EPI) { if (wr == 0) PG8_BAR; }
        if constexpr (!Epi::AFTER_DRAIN) { E(acc, cur, wr, wc, fr, fq); S.done(cur); }
        if (!has_next) break;
#pragma unroll
        for (int a = 0; a < 2; ++a)
#pragma unroll
            for (int b = 0; b < 2; ++b)
#pragma unroll
                for (int m = 0; m < 4; ++m)
#pragma unroll
                    for (int n = 0; n < 2; ++n) acc[a][b][m][n] = (f32x4){0.f, 0.f, 0.f, 0.f};
        cur = nxt; cA = nA; cB = nB; ++ui;
        if constexpr (ALIGN_EPI) { if (wr == 1) PG8_BAR; }
    }
    PG8_WAIT_V(0);
    if constexpr (!ALIGN_EPI) { if (wr == 0) PG8_BAR; }
    PG8_BAR;
    if constexpr (Epi::AFTER_DRAIN) { E.fused(acc, cur, wr, wc, fr, fq, lds, wid, lane); S.done(cur); }
#undef PG8_SA
#undef PG8_SB
#undef PG8_STAGE
#undef PG8_LDA
#undef PG8_LDB
#undef PG8_MMA
#undef PG8_WAIT_V
#undef PG8_WAIT_L
#undef PG8_BAR
#undef PG8_SCHED
}
}
#define GAS __attribute__((address_space(1)))
#define LAS __attribute__((address_space(3)))
typedef unsigned short bf16;
typedef unsigned v4u __attribute__((ext_vector_type(4)));
typedef float f32x4 __attribute__((ext_vector_type(4)));
typedef short bf16x8 __attribute__((ext_vector_type(8)));
typedef GAS unsigned gu32;
typedef GAS unsigned long long gu64;
#define RLX_AGENT __ATOMIC_RELAXED, __HIP_MEMORY_SCOPE_AGENT
#define LDS_WAIT() asm volatile("s_waitcnt lgkmcnt(0)" ::: "memory")
#define VM_WAIT() asm volatile("s_waitcnt vmcnt(0)" ::: "memory")
__device__ __forceinline__ unsigned long long rt() { return __builtin_amdgcn_s_memrealtime(); }
typedef float f32x2_cv __attribute__((ext_vector_type(2))); typedef __bf16 bf16x2_cv __attribute__((ext_vector_type(2)));
__device__ __forceinline__ unsigned pk2(float lo, float hi) { f32x2_cv v = {lo, hi}; bf16x2_cv b = __builtin_convertvector(v, bf16x2_cv); return __builtin_bit_cast(unsigned, b); }
__device__ __forceinline__ unsigned f2bf(float f) { return pk2(f, 0.f) & 0xffffu; }

#define XB_TMO      128
#define XB_XCNT(j)  (256  + 64 * (j))
#define XB_XSUB(j)  (1280 + 64 * (j))
#define XB_XGEN(j)  (2304 + 64 * (j))
#define XB_TOP      3328
#define XB_TOPGEN   3392
#define XCD_BAR_WORDS 3456
#define XB_SPIN_CAP (1u << 18)

__device__ __forceinline__ unsigned xb_ld(unsigned* p)              { return __hip_atomic_load(p, __ATOMIC_RELAXED, __HIP_MEMORY_SCOPE_AGENT); }
__device__ __forceinline__ unsigned xb_add(unsigned* p, unsigned v) { return __hip_atomic_fetch_add(p, v, __ATOMIC_RELAXED, __HIP_MEMORY_SCOPE_AGENT); }
__device__ __forceinline__ unsigned xb_xcc_id() { return (unsigned)__builtin_amdgcn_s_getreg((3 << 11) | 20) & 0xFu; }
#define XB_SPIN(cond, bar) do { unsigned _sp = 0; while (cond) { __builtin_amdgcn_s_sleep(1); \
    if ((++_sp & 255u) == 0u) { if (xb_ld(&(bar)[XB_TMO])) break; if (_sp > XB_SPIN_CAP) { atomicAdd(&(bar)[XB_TMO], 1u); break; } } } } while (0)

struct XcdBarrier {
    unsigned* bar; unsigned x;
    volatile LAS unsigned* st;
};

__device__ __forceinline__ XcdBarrier xcd_barrier_post(unsigned* bar, volatile LAS unsigned* st) {
    XcdBarrier b; b.bar = bar; b.x = xb_xcc_id(); b.st = st;
    if (threadIdx.x == 0) (void)xb_add(&bar[XB_XCNT(b.x)], 1u);
    return b;
}
__device__ __forceinline__ void xcd_barrier_complete(unsigned* bar, unsigned x, unsigned& nloc, unsigned& nx) {
    const unsigned G = gridDim.x * gridDim.y * gridDim.z;
    unsigned sum, cnt, mine, sp = 0u;
    for (;;) {
        sum = 0u; cnt = 0u; mine = 0u;
#pragma unroll
        for (unsigned j = 0; j < 16; ++j) { const unsigned c = xb_ld(&bar[XB_XCNT(j)]); sum += c; cnt += (c > 0u) ? 1u : 0u; mine = (j == x) ? c : mine; }
        if (sum == G) break;
        __builtin_amdgcn_s_sleep(1);
        if ((++sp & 255u) == 0u) { if (xb_ld(&bar[XB_TMO])) break; if (sp > XB_SPIN_CAP) { atomicAdd(&bar[XB_TMO], 1u); break; } }
    }
    nloc = mine > 0u ? mine : 1u; nx = cnt > 0u ? cnt : 1u;
}

__device__ __forceinline__ void xcd_barrier(const XcdBarrier& b) {
    asm volatile("s_waitcnt vmcnt(0)" ::: "memory");
    __syncthreads();
    if (threadIdx.x == 0) {
        unsigned* bar = b.bar;
        __builtin_amdgcn_s_waitcnt(0);
        unsigned nloc = b.st[0], nx = b.st[1];
        if (nloc == 0u) { xcd_barrier_complete(bar, b.x, nloc, nx); b.st[0] = nloc; b.st[1] = nx; }
        const unsigned old = xb_add(&bar[XB_XSUB(b.x)], 1u);
        const unsigned gen = old / nloc;
        if (old + 1u == (gen + 1u) * nloc) {
            __builtin_amdgcn_fence(__ATOMIC_RELEASE, "agent");
            asm volatile("s_waitcnt vmcnt(0)" ::: "memory");
            const unsigned og = xb_add(&bar[XB_TOP], 1u);
            const unsigned tg = og / nx;
            if (og + 1u == (tg + 1u) * nx) xb_add(&bar[XB_TOPGEN], 1u);
            else XB_SPIN(xb_ld(&bar[XB_TOPGEN]) == tg, bar);
            __builtin_amdgcn_fence(__ATOMIC_ACQUIRE, "agent");
            xb_add(&bar[XB_XGEN(b.x)], 1u);
            asm volatile("s_waitcnt vmcnt(0)" ::: "memory");
        } else {
            XB_SPIN(xb_ld(&bar[XB_XGEN(b.x)]) == gen, bar);
            __builtin_amdgcn_fence(__ATOMIC_ACQUIRE, "agent");
            asm volatile("s_waitcnt vmcnt(0)" ::: "memory");
        }
    }
    __syncthreads();
}
typedef unsigned short bf16_t;
typedef float f32x2 __attribute__((ext_vector_type(2)));
typedef unsigned u32x4 __attribute__((ext_vector_type(4)));
typedef unsigned u32x2 __attribute__((ext_vector_type(2)));
__device__ __forceinline__ float bf2f(bf16_t v) { return __uint_as_float(((unsigned)v) << 16); }
__device__ __forceinline__ float bflo(unsigned w) { return __uint_as_float(w << 16); }
__device__ __forceinline__ float bfhi(unsigned w) { return __uint_as_float(w & 0xffff0000u); }
#ifdef DIAG_SLOT
#define DIAG_ON 1
#else
#define DIAG_ON 0
#endif
__device__ __forceinline__ unsigned long long tick() { return __builtin_amdgcn_s_memtime(); }
__device__ __forceinline__ void st_b16(void* ptr, unsigned v) { asm volatile("global_store_short %0, %1, off" :: "v"(ptr), "v"(v) : "memory"); }
__device__ __forceinline__ void st_b32(void* ptr, float v) { asm volatile("global_store_dword %0, %1, off" :: "v"(ptr), "v"(v) : "memory"); }
__device__ __forceinline__ void st_b64(void* ptr, u32x2 v) { asm volatile("global_store_dwordx2 %0, %1, off" :: "v"(ptr), "v"(v) : "memory"); }
__device__ __forceinline__ void st_b128(void* ptr, u32x4 v) { asm volatile("global_store_dwordx4 %0, %1, off\n\ts_nop 1" :: "v"(ptr), "v"(v) : "memory"); }
__device__ __forceinline__ void st_f128(void* ptr, f32x4 v) { asm volatile("global_store_dwordx4 %0, %1, off\n\ts_nop 1" :: "v"(ptr), "v"(v) : "memory"); }
__device__ __forceinline__ void unpack8(const u32x4 v, float (&o)[8]) { o[0] = bflo(v.x); o[1] = bfhi(v.x); o[2] = bflo(v.y); o[3] = bfhi(v.y); o[4] = bflo(v.z); o[5] = bfhi(v.z); o[6] = bflo(v.w); o[7] = bfhi(v.w); }
constexpr int D = 2048, NB = 2, L = 4096, LC = 256;
constexpr int NTOK = NB * L, NCTX = NB * LC, NROW = NTOK + NCTX;
constexpr int NIN = 6576, LDP = 6656;
constexpr int C_Q = 0, C_K = 512, C_VM = 1024, C_OM = 2048, C_G = 3072, C_R = 3088, C_KR = 4112, C_VR = 5136, C_LW = 6160, C_LA = 6288, C_LG = 6416;
constexpr int FF = 5632, NMOD = 12288;
constexpr int RW = 1024;
constexpr int NSTEP = LC + L;

constexpr size_t MiB = 1u << 20;
constexpr size_t WS_CTL = 0;
constexpr size_t WS_DIAG = 512 * 1024;
constexpr size_t WS_MOD = 1 * MiB;
constexpr size_t WS_GATES = 2 * MiB;
constexpr size_t WS_BONUS = 3 * MiB;
constexpr size_t WS_BONUS_B = 4 * MiB;
constexpr size_t WS_DENS = 7 * MiB;
constexpr size_t WS_WUPT = 5 * MiB;
constexpr size_t WS_AUPT = 5 * MiB + 256 * 1024;
constexpr size_t WS_GUPT = 5 * MiB + 512 * 1024;
constexpr size_t WS_WOUT_T = 8 * MiB;
constexpr size_t WS_WUG_T = 16 * MiB;
constexpr size_t WS_WDN_T = 60 * MiB;
constexpr size_t WS_PROJ = 82 * MiB;
constexpr size_t WS_WIN_T = 193 * MiB;
constexpr size_t WS_HX = 219 * MiB;
constexpr size_t WS_CHD = 193 * MiB;
constexpr size_t WS_YF = 297 * MiB;
constexpr size_t WS_YB = 313 * MiB;
constexpr size_t WS_HF = 329 * MiB;
constexpr size_t WS_HB = 345 * MiB;
constexpr size_t WS_MIX = 193 * MiB;
constexpr size_t DO_QC = 0 * MiB;
constexpr size_t DO_KC = 9 * MiB;
constexpr size_t DO_GG = 18 * MiB;
constexpr size_t WS_KK = 361 * MiB, WS_LWF = 361 * MiB, WS_LWB = 361 * MiB, WS_AF = 361 * MiB, WS_AB = 361 * MiB;
constexpr size_t WS_HX2 = 82 * MiB;
constexpr size_t WS_UG = 114 * MiB;
constexpr size_t WS_ACT = 290 * MiB;
constexpr size_t WS_END = 378 * MiB;

struct P {
    const float *x, *c, *ctx, *c_ctx, *w_mod, *b_mod, *g_norm1, *g_norm2, *w_in, *m_conv_w, *m_conv_b, *m_gate_b, *m_norm_g;
    const float *r_w0, *r_w_up, *r_a0, *r_a_up, *r_g_up, *r_k_k, *r_k_a, *r_r_k, *r_gn_w, *r_gn_b, *w_out, *f_w_up, *f_w_gate, *f_conv_w, *f_conv_b, *f_w_down, *g_final;
    float* out; unsigned char* ws; unsigned mask, pad;
};

__device__ __forceinline__ float wave_sum(float v) {
#pragma unroll
    for (int o = 1; o < 64; o <<= 1) v += __shfl_xor(v, o);
    return v;
}
__device__ __forceinline__ float sigmoidf_(float x) { return 1.f / (1.f + __expf(-x)); }
__device__ __forceinline__ float softplusf_(float x) { return fmaxf(x, 0.f) + log1pf(__expf(-fabsf(x))); }

__device__ __forceinline__ void row_seq(int r, int& base, int& t, int& len) {
    if (r < NTOK) { base = r & ~(L - 1); t = r & (L - 1); len = L; } else { const int q = r - NTOK; base = NTOK + (q & ~(LC - 1)); t = q & (LC - 1); len = LC; }
}
__device__ __forceinline__ int step_row(int s, int b, int dir) {
    if (s < LC) { const int t = dir ? (LC - 1 - s) : s; return NTOK + b * LC + t; }
    const int u = s - LC; const int t = dir ? (L - 1 - u) : u; return b * L + t;
}

__device__ __forceinline__ void phase_mod(const P& p, int bid, int nb, float* lds) {
    float* sc = lds;
    float* red = lds + 3 * 2048;
    const int tid = threadIdx.x;
    for (int i = tid; i < 3 * 2048; i += blockDim.x) { const int v = i >> 11, k = i & 2047; const float xv = v < 2 ? p.c[v * 2048 + k] : p.c_ctx[k]; sc[i] = xv / (1.f + __expf(-xv)); }
    __syncthreads();
    float* MOD = (float*)(p.ws + WS_MOD);
    for (int cb = bid; cb < NMOD / 48; cb += nb) {
        const int cg = tid % 12, kl = tid / 12;
        float a[3][4];
#pragma unroll
        for (int v = 0; v < 3; ++v)
#pragma unroll
            for (int j = 0; j < 4; ++j) a[v][j] = 0.f;
        if (kl < 42) {
            for (int k = kl; k < 2048; k += 42) {
                const f32x4 w = *(const f32x4*)(p.w_mod + (size_t)k * NMOD + cb * 48 + cg * 4);
#pragma unroll
                for (int v = 0; v < 3; ++v) { const float s = sc[v * 2048 + k]; a[v][0] += s * w.x; a[v][1] += s * w.y; a[v][2] += s * w.z; a[v][3] += s * w.w; }
            }
#pragma unroll
            for (int v = 0; v < 3; ++v)
#pragma unroll
                for (int j = 0; j < 4; ++j) red[kl * 144 + v * 48 + cg * 4 + j] = a[v][j];
        }
        __syncthreads();
        if (tid < 144) {
            float s = 0.f;
            for (int k = 0; k < 42; ++k) s += red[k * 144 + tid];
            const int v = tid / 48, cc = tid % 48;
            MOD[v * NMOD + cb * 48 + cc] = s + p.b_mod[cb * 48 + cc];
        }
        __syncthreads();
    }
}

__device__ __forceinline__ void normmod_row(const float* src, const float* g, const float* sh, const float* sc, bf16_t* dst, int lane) {
    f32x4 v[8], mg[8], mb[8]; float s = 0.f;
#pragma unroll
    for (int j = 0; j < 8; ++j) v[j] = *((const f32x4*)src + lane + 64 * j);
#pragma unroll
    for (int j = 0; j < 8; ++j) {
        const f32x4 gg = *((const f32x4*)g + lane + 64 * j), a = *((const f32x4*)sc + lane + 64 * j); mb[j] = *((const f32x4*)sh + lane + 64 * j);
        mg[j].x = gg.x * (1.f + a.x); mg[j].y = gg.y * (1.f + a.y); mg[j].z = gg.z * (1.f + a.z); mg[j].w = gg.w * (1.f + a.w);
    }
#pragma unroll
    for (int j = 0; j < 8; ++j) s += (v[j].x * v[j].x + v[j].y * v[j].y) + (v[j].z * v[j].z + v[j].w * v[j].w);
    const float rs = rsqrtf(wave_sum(s) * (1.f / D) + 1e-6f);
#pragma unroll
    for (int j = 0; j < 8; ++j) {
        const f32x4 gg = mg[j], b = mb[j]; const f32x4 a = (f32x4){0.f, 0.f, 0.f, 0.f};
        const float o0 = v[j].x * rs * gg.x * (1.f + a.x) + b.x, o1 = v[j].y * rs * gg.y * (1.f + a.y) + b.y, o2 = v[j].z * rs * gg.z * (1.f + a.z) + b.z, o3 = v[j].w * rs * gg.w * (1.f + a.w) + b.w;
        u32x2 w; w.x = pk2(o0, o1); w.y = pk2(o2, o3);
        *((u32x2*)dst + lane + 64 * j) = w;
    }
}
__device__ __forceinline__ void phase_normmod(const P& p, int which, int gw, int ngw, int lane) {
    const float* MOD = (const float*)(p.ws + WS_MOD);
    if (which == 0) {
        bf16_t* HX = (bf16_t*)(p.ws + WS_HX);
        for (int r = gw; r < NROW; r += ngw) {
            const float* src = r < NTOK ? p.x + (size_t)r * D : p.ctx + (size_t)(r - NTOK) * D;
            const int v = r < NTOK ? (r >> 12) : 2;
            normmod_row(src, p.g_norm1, MOD + v * NMOD + 0, MOD + v * NMOD + 2048, HX + (size_t)r * D, lane);
        }
    } else {
        bf16_t* HX2 = (bf16_t*)(p.ws + WS_HX2);
        for (int r = gw; r < NTOK; r += ngw) {
            const int v = r >> 12;
            normmod_row(p.out + (size_t)r * D, p.g_norm2, MOD + v * NMOD + 3 * 2048, MOD + v * NMOD + 4 * 2048, HX2 + (size_t)r * D, lane);
        }
    }
}

__device__ __forceinline__ void phase_lora_ref(const P& p, int bid, int nb, float* lds) {
    float* tl = lds;
    float* la = lds + 128;
    float* sg = lds + 256;
    const bf16_t* PROJ = (const bf16_t*)(p.ws + WS_PROJ);
    bf16_t* LW[2] = {(bf16_t*)(p.ws + WS_LWF), (bf16_t*)(p.ws + WS_LWB)};
    bf16_t* AA[2] = {(bf16_t*)(p.ws + WS_AF), (bf16_t*)(p.ws + WS_AB)};
    bf16_t* GG = (bf16_t*)((unsigned char*)p.out + DO_GG);
    const int tid = threadIdx.x;
    for (int r = bid; r < NROW; r += nb) {
        const bf16_t* pr = PROJ + (size_t)r * LDP;
        if (tid < 128) tl[tid] = tanhf(bf2f(pr[C_LW + tid]));
        else if (tid < 256) la[tid - 128] = bf2f(pr[C_LA + tid - 128]);
        else if (tid < 416) sg[tid - 256] = sigmoidf_(bf2f(pr[C_LG + tid - 256]));
        __syncthreads();
        for (int c = tid; c < RW; c += blockDim.x) {
#pragma unroll
            for (int d = 0; d < 2; ++d) {
                float aw = p.r_w0[d * RW + c], aa = p.r_a0[d * RW + c];
                for (int k = 0; k < 64; ++k) { aw += tl[d * 64 + k] * p.r_w_up[(size_t)(d * 64 + k) * RW + c]; aa += la[d * 64 + k] * p.r_a_up[(size_t)(d * 64 + k) * RW + c]; }
                const float wlog = -softplusf_(-aw) - 0.5f;
                LW[d][(size_t)r * RW + c] = (bf16_t)f2bf(-__expf(wlog));
                AA[d][(size_t)r * RW + c] = (bf16_t)f2bf(sigmoidf_(aa));
            }
            if (r < NTOK) {
                float g = 0.f;
                for (int k = 0; k < 160; ++k) g += sg[k] * p.r_g_up[(size_t)k * RW + c];
                GG[(size_t)r * RW + c] = (bf16_t)f2bf(g);
            }
        }
        __syncthreads();
    }
}

__device__ __forceinline__ void phase_prep(const P& p, int bid, int nb) {
    const bf16_t* PROJ = (const bf16_t*)(p.ws + WS_PROJ);
    bf16_t* QC = (bf16_t*)((unsigned char*)p.out + DO_QC); bf16_t* KC = (bf16_t*)((unsigned char*)p.out + DO_KC);
    float* GATES = (float*)(p.ws + WS_GATES);
    const int tid = threadIdx.x, rl = tid >> 7, c0 = (tid & 127) * 8;
    float cw[3][8], cb[8];
#pragma unroll
    for (int k = 0; k < 3; ++k) { *(f32x4*)&cw[k][0] = *(const f32x4*)(p.m_conv_w + k * 1024 + c0); *(f32x4*)&cw[k][4] = *(const f32x4*)(p.m_conv_w + k * 1024 + c0 + 4); }
    *(f32x4*)&cb[0] = *(const f32x4*)(p.m_conv_b + c0); *(f32x4*)&cb[4] = *(const f32x4*)(p.m_conv_b + c0 + 4);
    for (int r = bid * 4 + rl; r < NROW; r += nb * 4) {
        int base, t, len; row_seq(r, base, t, len);
        const bf16_t* pr = PROJ + (size_t)r * LDP;
        const bool hp = t > 0, hn = t + 1 < len;
        float cur[8], prv[8], nxt[8];
        unpack8(*(const u32x4*)(pr + c0), cur); unpack8(*(const u32x4*)(pr - (hp ? LDP : 0) + c0), prv); unpack8(*(const u32x4*)(pr + (hn ? LDP : 0) + c0), nxt);
        const float mp = hp ? 1.f : 0.f, mn = hn ? 1.f : 0.f, sc = c0 < 512 ? 0.08838834764831845f : 1.f;
        float o[8];
#pragma unroll
        for (int j = 0; j < 8; ++j) o[j] = (prv[j] * (cw[0][j] * mp) + cur[j] * cw[1][j] + nxt[j] * (cw[2][j] * mn) + cb[j]) * sc;
        u32x4 w; w.x = pk2(o[0], o[1]); w.y = pk2(o[2], o[3]); w.z = pk2(o[4], o[5]); w.w = pk2(o[6], o[7]);
        if (c0 < 512) *(u32x4*)(QC + (size_t)r * 512 + c0) = w; else *(u32x4*)(KC + (size_t)r * 512 + c0 - 512) = w;
        if ((tid & 127) < 16) {
            const int j = tid & 127;
            float v = bf2f(pr[C_G + j]) + p.m_gate_b[j];
            if (j >= 8) v = -softplusf_(-v);
            GATES[(size_t)r * 16 + j] = v;
        }
    }
}

__device__ void rwkv_ref_task(const P& p, int gw, int lane) {
    const bf16_t* PROJ = (const bf16_t*)(p.ws + WS_PROJ); const bf16_t* KK = (const bf16_t*)(p.ws + WS_KK);
    const int stream = gw >> 6, vrow = gw & 63, dir = stream >> 5, b = (stream >> 4) & 1, h = stream & 15;
    const bf16_t* LW = (const bf16_t*)(p.ws + (dir ? WS_LWB : WS_LWF)); const bf16_t* AA = (const bf16_t*)(p.ws + (dir ? WS_AB : WS_AF));
    bf16_t* Y = (bf16_t*)(p.ws + (dir ? WS_YB : WS_YF));
    const int c = h * 64 + lane; const float rka = p.r_k_a[c];
    float s = 0.f;
    for (int st = 0; st < NSTEP; ++st) {
        const int r = step_row(st, b, dir);
        const float w = __expf(bf2f(LW[(size_t)r * RW + c])), a = bf2f(AA[(size_t)r * RW + c]), kk = bf2f(KK[(size_t)r * RW + c]);
        const float kr = bf2f(PROJ[(size_t)r * LDP + C_KR + c]), rr = bf2f(PROJ[(size_t)r * LDP + C_R + c]), vv = bf2f(PROJ[(size_t)r * LDP + C_VR + h * 64 + vrow]);
        const float kd = kr * (1.f + (a - 1.f) * rka);
        const float sa = wave_sum(s * kk);
        s = s * w - sa * (kk * a) + vv * kd;
        const float y = wave_sum(s * rr);
        if (st >= LC && lane == 0) Y[(size_t)r * RW + h * 64 + vrow] = (bf16_t)f2bf(y);
    }
}
__device__ void mlstm_ref_task(const P& p, int gw, int lane) {
    const bf16_t* PROJ = (const bf16_t*)(p.ws + WS_PROJ); const bf16_t* QC = (const bf16_t*)((unsigned char*)p.out + DO_QC); const bf16_t* KC = (const bf16_t*)((unsigned char*)p.out + DO_KC);
    const float* GATES = (const float*)(p.ws + WS_GATES);
    const int stream = gw >> 8, vrow = gw & 255, dir = stream >> 3, b = (stream >> 2) & 1, h = stream & 3;
    bf16_t* H = (bf16_t*)(p.ws + (dir ? WS_HB : WS_HF));
    float c0 = 0.f, c1 = 0.f, n0 = 0.f, n1 = 0.f;
    for (int st = 0; st < NSTEP; ++st) {
        const int r = step_row(st, b, dir);
        const float ig = GATES[(size_t)r * 16 + dir * 4 + h], lf = GATES[(size_t)r * 16 + 8 + dir * 4 + h];
        const float f = __expf(lf), ei = __expf(ig);
        const float k0 = bf2f(KC[(size_t)r * 512 + h * 128 + lane]), k1 = bf2f(KC[(size_t)r * 512 + h * 128 + 64 + lane]);
        const float q0 = bf2f(QC[(size_t)r * 512 + h * 128 + lane]), q1 = bf2f(QC[(size_t)r * 512 + h * 128 + 64 + lane]);
        const float v = bf2f(PROJ[(size_t)r * LDP + C_VM + h * 256 + vrow]);
        c0 = f * c0 + ei * v * k0; c1 = f * c1 + ei * v * k1; n0 = f * n0 + ei * k0; n1 = f * n1 + ei * k1;
        const float num = wave_sum(c0 * q0 + c1 * q1), den = wave_sum(n0 * q0 + n1 * q1);
        if (st >= LC && lane == 0) H[(size_t)r * RW + h * 256 + vrow] = (bf16_t)f2bf(num / fmaxf(fabsf(den), 1.f));
    }
}

__device__ __forceinline__ void phase_post(const P& p, int gw, int ngw, int lane) {
    const bf16_t* PROJ = (const bf16_t*)(p.ws + WS_PROJ);
    const bf16_t* YF = (const bf16_t*)(p.ws + WS_YF); const bf16_t* YB = (const bf16_t*)(p.ws + WS_YB);
    const bf16_t* HF = (const bf16_t*)(p.ws + WS_HF); const bf16_t* HB = (const bf16_t*)(p.ws + WS_HB);
    const bf16_t* GG = (const bf16_t*)((unsigned char*)p.out + DO_GG); const float* BONUS = (const float*)(p.ws + WS_BONUS); const float* BONUSB = (const float*)(p.ws + WS_BONUS_B);
    bf16_t* MIX = (bf16_t*)(p.ws + WS_MIX);
    for (int it = gw; it < NTOK * 4; it += ngw) {
        const int r = it >> 2, qt = it & 3, c0 = (qt & 1) * 512 + lane * 8;
        const bf16_t* pr = PROJ + (size_t)r * LDP;
        float o[8];
        if (qt < 2) {
            float a[8], b[8], om[8], gn[8];
            unpack8(*(const u32x4*)(HF + (size_t)r * RW + c0), a); unpack8(*(const u32x4*)(HB + (size_t)r * RW + c0), b); unpack8(*(const u32x4*)(pr + C_OM + c0), om);
            *(f32x4*)&gn[0] = *(const f32x4*)(p.m_norm_g + c0); *(f32x4*)&gn[4] = *(const f32x4*)(p.m_norm_g + c0 + 4);
            float ss = 0.f;
#pragma unroll
            for (int j = 0; j < 8; ++j) { a[j] += b[j]; ss += a[j] * a[j]; }
#pragma unroll
            for (int o2 = 1; o2 < 32; o2 <<= 1) ss += __shfl_xor(ss, o2);
            const float rs = rsqrtf(ss * (1.f / 256.f) + 1e-6f);
#pragma unroll
            for (int j = 0; j < 8; ++j) o[j] = a[j] * rs * gn[j] * __builtin_amdgcn_rcpf(1.f + __expf(-om[j]));
            u32x4 w; w.x = pk2(o[0], o[1]); w.y = pk2(o[2], o[3]); w.z = pk2(o[4], o[5]); w.w = pk2(o[6], o[7]);
            *(u32x4*)(MIX + (size_t)r * D + c0) = w;
        } else {
            float a[8], b[8], vr[8], gg[8], gw_[8], gb[8];
            unpack8(*(const u32x4*)(YF + (size_t)r * RW + c0), a); unpack8(*(const u32x4*)(YB + (size_t)r * RW + c0), b);
            unpack8(*(const u32x4*)(pr + C_VR + c0), vr); unpack8(*(const u32x4*)(GG + (size_t)r * RW + c0), gg);
            *(f32x4*)&gw_[0] = *(const f32x4*)(p.r_gn_w + c0); *(f32x4*)&gw_[4] = *(const f32x4*)(p.r_gn_w + c0 + 4);
            *(f32x4*)&gb[0] = *(const f32x4*)(p.r_gn_b + c0); *(f32x4*)&gb[4] = *(const f32x4*)(p.r_gn_b + c0 + 4);
            const int hd = c0 >> 6;
            const float bn = BONUS[(size_t)r * 16 + hd] + BONUSB[(size_t)r * 16 + hd];
            float sm = 0.f;
#pragma unroll
            for (int j = 0; j < 8; ++j) { a[j] += b[j]; sm += a[j]; }
            sm += __shfl_xor(sm, 1); sm += __shfl_xor(sm, 2); sm += __shfl_xor(sm, 4);
            const float mu = sm * (1.f / 64.f);
            float sv = 0.f;
#pragma unroll
            for (int j = 0; j < 8; ++j) { a[j] -= mu; sv += a[j] * a[j]; }
            sv += __shfl_xor(sv, 1); sv += __shfl_xor(sv, 2); sv += __shfl_xor(sv, 4);
            const float rs = rsqrtf(sv * (1.f / 64.f) + 64e-5f);
#pragma unroll
            for (int j = 0; j < 8; ++j) o[j] = (a[j] * rs * gw_[j] + gb[j] + bn * vr[j]) * gg[j];
            u32x4 w; w.x = pk2(o[0], o[1]); w.y = pk2(o[2], o[3]); w.z = pk2(o[4], o[5]); w.w = pk2(o[6], o[7]);
            *(u32x4*)(MIX + (size_t)r * D + 1024 + c0) = w;
        }
    }
}

__device__ __forceinline__ void phase_convact(const P& p, int gw, int lane) {
    const bf16_t* UG = (const bf16_t*)(p.ws + WS_UG); bf16_t* ACT = (bf16_t*)(p.ws + WS_ACT);
    constexpr int NCGW = FF / 8 / 64, NSTRIPE = 186, TPS = 45;
    const int cgw = gw % NCGW, stripe = gw / NCGW;
    if (stripe >= NSTRIPE) return;
    const int f = (cgw * 64 + lane) * 8;
    float cw[9][8], cb[8];
#pragma unroll
    for (int k = 0; k < 9; ++k) { *(f32x4*)&cw[k][0] = *(const f32x4*)(p.f_conv_w + (size_t)k * FF + f); *(f32x4*)&cw[k][4] = *(const f32x4*)(p.f_conv_w + (size_t)k * FF + f + 4); }
    *(f32x4*)&cb[0] = *(const f32x4*)(p.f_conv_b + f); *(f32x4*)&cb[4] = *(const f32x4*)(p.f_conv_b + f + 4);
    const int r1 = min(NTOK, (stripe + 1) * TPS);
    for (int r = stripe * TPS; r < r1; r += 2) {
        u32x4 ld[2][10]; float msk[2][9]; bool have[2];
#pragma unroll
        for (int tk = 0; tk < 2; ++tk) {
            const int rr_ = min(r + tk, NTOK - 1); have[tk] = (r + tk) < r1;
            const int b = rr_ >> 12, t = rr_ & 4095, gr = t >> 6, gc = t & 63;
#pragma unroll
            for (int dr = 0; dr < 3; ++dr)
#pragma unroll
                for (int dc = 0; dc < 3; ++dc) {
                    const int rr = gr + dr - 1, cc = gc + dc - 1;
                    const bool ok = rr >= 0 && rr < 64 && cc >= 0 && cc < 64;
                    const int nb_ = ok ? (b * 4096 + rr * 64 + cc) : rr_; msk[tk][dr * 3 + dc] = ok ? 1.f : 0.f;
                    ld[tk][dr * 3 + dc] = *(const u32x4*)(UG + (size_t)nb_ * (2 * FF) + f);
                }
            ld[tk][9] = *(const u32x4*)(UG + (size_t)rr_ * (2 * FF) + FF + f);
        }
#pragma unroll
        for (int tk = 0; tk < 2; ++tk) {
            float acc[8];
#pragma unroll
            for (int j = 0; j < 8; ++j) acc[j] = cb[j];
#pragma unroll
            for (int k = 0; k < 9; ++k) { float u[8]; unpack8(ld[tk][k], u);
#pragma unroll
                for (int j = 0; j < 8; ++j) acc[j] += u[j] * (cw[k][j] * msk[tk][k]); }
            float gt[8]; unpack8(ld[tk][9], gt);
            float o[8];
#pragma unroll
            for (int j = 0; j < 8; ++j) { const float u = acc[j], z2 = 1.5957691216057308f * (u + 0.044715f * u * u * u); o[j] = u * __builtin_amdgcn_rcpf(1.f + __expf(-z2)) * gt[j]; }
            u32x4 w; w.x = pk2(o[0], o[1]); w.y = pk2(o[2], o[3]); w.z = pk2(o[4], o[5]); w.w = pk2(o[6], o[7]);
            if (have[tk]) *(u32x4*)(ACT + (size_t)(r + tk) * FF + f) = w;
        }
    }
}

__device__ __forceinline__ void phase_final(const P& p, int gw, int ngw, int lane) {
    for (int r = gw; r < NTOK; r += ngw) {
        float* row = p.out + (size_t)r * D;
        f32x4 v[8], gf[8]; float s = 0.f;
#pragma unroll
        for (int j = 0; j < 8; ++j) { v[j] = *((const f32x4*)row + lane + 64 * j); gf[j] = *((const f32x4*)p.g_final + lane + 64 * j); }
#pragma unroll
        for (int j = 0; j < 8; ++j) s += (v[j].x * v[j].x + v[j].y * v[j].y) + (v[j].z * v[j].z + v[j].w * v[j].w);
        const float rs = rsqrtf(wave_sum(s) * (1.f / D) + 1e-6f);
#pragma unroll
        for (int j = 0; j < 8; ++j) { const f32x4 g = gf[j]; f32x4 o; o.x = v[j].x * rs * g.x; o.y = v[j].y * rs * g.y; o.z = v[j].z * rs * g.z; o.w = v[j].w * rs * g.w; *((f32x4*)row + lane + 64 * j) = o; }
    }
}

typedef short s16x4 __attribute__((ext_vector_type(4)));
__device__ __forceinline__ bf16x8 tr8(const LAS unsigned char* p0, int rstride4) {
    const s16x4 lo = __builtin_amdgcn_ds_read_tr16_b64_v4i16((LAS s16x4*)p0);
    const s16x4 hi = __builtin_amdgcn_ds_read_tr16_b64_v4i16((LAS s16x4*)(p0 + rstride4));
    return (bf16x8){lo[0], lo[1], lo[2], lo[3], hi[0], hi[1], hi[2], hi[3]};
}
template <int CTRL, int RM, bool BC> __device__ __forceinline__ float dppf(float oldv, float src) { return __int_as_float(__builtin_amdgcn_update_dpp(__float_as_int(oldv), __float_as_int(src), CTRL, RM, 0xF, BC)); }
__device__ __forceinline__ float wave_scan_add(float x) {
    x += dppf<0x111, 0xF, true>(0.f, x); x += dppf<0x112, 0xF, true>(0.f, x); x += dppf<0x114, 0xF, true>(0.f, x); x += dppf<0x118, 0xF, true>(0.f, x);
    x += dppf<0x142, 0xA, false>(0.f, x); x += dppf<0x143, 0xC, false>(0.f, x);
    return x;
}
__device__ __forceinline__ float wave_scan_max(float x) {
    const float ni = -__builtin_inff();
    x = fmaxf(x, dppf<0x111, 0xF, false>(ni, x)); x = fmaxf(x, dppf<0x112, 0xF, false>(ni, x)); x = fmaxf(x, dppf<0x114, 0xF, false>(ni, x)); x = fmaxf(x, dppf<0x118, 0xF, false>(ni, x));
    x = fmaxf(x, dppf<0x142, 0xA, false>(ni, x)); x = fmaxf(x, dppf<0x143, 0xC, false>(ni, x));
    return x;
}
__device__ __forceinline__ float lane_bcast63(float x) { return __int_as_float(__builtin_amdgcn_readlane(__float_as_int(x), 63)); }
constexpr int MI_QS = 0, MI_KS = 17408, MI_VS = 34816, MI_PS = 68608, MI_SC = 77824, MI_END = 78336;
constexpr int MI_RS = 272, MI_VRS = 528, MI_PRS = 144;
constexpr int NTASK_MI = 16 * (L / 64);
__device__ __forceinline__ void phase_mintra(const P& p, LAS unsigned char* L3, int bid, int nb) {
    int tid_ = threadIdx.x; asm volatile("" : "+v"(tid_));
    const int tid = tid_, lane = tid & 63, w = __builtin_amdgcn_readfirstlane(tid >> 6), g = lane >> 4, li = lane & 15, q4 = li >> 2, p4 = li & 3;
    const bf16_t* PROJ = (const bf16_t*)(p.ws + WS_PROJ); const bf16_t* QC = (const bf16_t*)((unsigned char*)p.out + DO_QC); const bf16_t* KC = (const bf16_t*)((unsigned char*)p.out + DO_KC);
    const float* GATES = (const float*)(p.ws + WS_GATES);
    const int mt = w >> 1, nh = w & 1;
    for (int task = bid; task < NTASK_MI; task += nb) {
        const int stream = task & 15, c = LC / 64 + (task >> 4), dir = stream >> 3, b = (stream >> 2) & 1, h = stream & 3;
        bf16_t* NUMS = (bf16_t*)(p.ws + (dir ? WS_HB : WS_HF)); float* DENS = (float*)(p.ws + WS_DENS) + dir * (NTOK * 4);
        {
            u32x4 qv[2], kv[2], vv[4];
#pragma unroll
            for (int i = 0; i < 2; ++i) { const int pc = tid + 512 * i, j = pc >> 4, dp = pc & 15; const int r = step_row(64 * c + j, b, dir);
                qv[i] = *(const u32x4*)(QC + (size_t)r * 512 + h * 128 + dp * 8); kv[i] = *(const u32x4*)(KC + (size_t)r * 512 + h * 128 + dp * 8); }
#pragma unroll
            for (int i = 0; i < 4; ++i) { const int pc = tid + 512 * i, j = pc >> 5, dp = pc & 31; const int r = step_row(64 * c + j, b, dir); vv[i] = *(const u32x4*)(PROJ + (size_t)r * LDP + C_VM + h * 256 + dp * 8); }
            if (w == 0) {
                const int r = step_row(64 * c + lane, b, dir);
                const float gi = GATES[(size_t)r * 16 + dir * 4 + h], gf = GATES[(size_t)r * 16 + 8 + dir * 4 + h];
                const float bc = wave_scan_add(gf), av = gi - bc, pml = wave_scan_max(av);
                LAS float* sc = (LAS float*)(L3 + MI_SC); sc[lane] = av; sc[64 + lane] = pml;
            }
#pragma unroll
            for (int i = 0; i < 2; ++i) { const int pc = tid + 512 * i, j = pc >> 4, dp = pc & 15; *(LAS u32x4*)(L3 + MI_QS + j * MI_RS + dp * 16) = qv[i]; *(LAS u32x4*)(L3 + MI_KS + j * MI_RS + dp * 16) = kv[i]; }
#pragma unroll
            for (int i = 0; i < 4; ++i) { const int pc = tid + 512 * i, j = pc >> 5, dp = pc & 31; *(LAS u32x4*)(L3 + MI_VS + j * MI_VRS + dp * 16) = vv[i]; }
        }
        __syncthreads();
        {
            const LAS float* sc = (const LAS float*)(L3 + MI_SC);
            bf16x8 aq[4];
#pragma unroll
            for (int ks = 0; ks < 4; ++ks) aq[ks] = *(const LAS bf16x8*)(L3 + MI_QS + (16 * mt + li) * MI_RS + (32 * ks + 8 * g) * 2);
            const f32x4 pmv = *(const LAS f32x4*)(sc + 64 + 16 * mt + 4 * g);
#pragma unroll
            for (int n = 0; n < 2; ++n) {
                const int nt = 2 * nh + n;
                f32x4 sv = (f32x4){0.f, 0.f, 0.f, 0.f};
                if (nt <= mt) {
#pragma unroll
                    for (int ks = 0; ks < 4; ++ks) { const bf16x8 bk = *(const LAS bf16x8*)(L3 + MI_KS + (16 * nt + li) * MI_RS + (32 * ks + 8 * g) * 2); sv = __builtin_amdgcn_mfma_f32_16x16x32_bf16(aq[ks], bk, sv, 0, 0, 0); }
                    const float av = sc[16 * nt + li];
#pragma unroll
                    for (int r = 0; r < 4; ++r) { const int j = 16 * mt + 4 * g + r, ss = 16 * nt + li; sv[r] = (ss <= j) ? sv[r] * __expf(av - pmv[r]) : 0.f; }
                }
#pragma unroll
                for (int r = 0; r < 4; ++r) *(LAS bf16_t*)(L3 + MI_PS + (16 * mt + 4 * g + r) * MI_PRS + (16 * nt + li) * 2) = (bf16_t)f2bf(sv[r]);
            }
        }
        __syncthreads();
        {
            bf16x8 ap[2];
#pragma unroll
            for (int ks = 0; ks < 2; ++ks) ap[ks] = *(const LAS bf16x8*)(L3 + MI_PS + (16 * mt + li) * MI_PRS + (32 * ks + 8 * g) * 2);
            f32x4 acc[8];
#pragma unroll
            for (int x = 0; x < 8; ++x) acc[x] = (f32x4){0.f, 0.f, 0.f, 0.f};
#pragma unroll
            for (int ks = 0; ks < 2; ++ks)
#pragma unroll
                for (int x = 0; x < 8; ++x) { const bf16x8 bv = tr8(L3 + MI_VS + (32 * ks + 8 * g + q4) * MI_VRS + 32 * (8 * nh + x) + 8 * p4, 4 * MI_VRS); acc[x] = __builtin_amdgcn_mfma_f32_16x16x32_bf16(ap[ks], bv, acc[x], 0, 0, 0); }
            if (nh == 0) {
                const short one = li == 0 ? (short)0x3F80 : (short)0;
                const bf16x8 ones = (bf16x8){one, one, one, one, one, one, one, one};
                f32x4 dn = (f32x4){0.f, 0.f, 0.f, 0.f};
                dn = __builtin_amdgcn_mfma_f32_16x16x32_bf16(ap[0], ones, dn, 0, 0, 0); dn = __builtin_amdgcn_mfma_f32_16x16x32_bf16(ap[1], ones, dn, 0, 0, 0);
                if (li == 0) {
                    const int row0 = step_row(64 * c + 16 * mt + 4 * g, b, dir);
#pragma unroll
                    for (int r = 0; r < 4; ++r) st_b32(DENS + (size_t)(row0 + (dir ? -r : r)) * 4 + h, dn[r]);
                }
            }
#pragma unroll
            for (int x = 0; x < 8; ++x)
#pragma unroll
                for (int r = 0; r < 4; ++r) *(LAS bf16_t*)(L3 + MI_QS + (16 * mt + 4 * g + r) * MI_VRS + (16 * (8 * nh + x) + li) * 2) = (bf16_t)f2bf(acc[x][r]);
        }
        __syncthreads();
#pragma unroll
        for (int i = 0; i < 4; ++i) { const int pc = tid + 512 * i, j = pc >> 5, dp = pc & 31; const int r = step_row(64 * c + j, b, dir); st_b128(NUMS + (size_t)r * RW + h * 256 + dp * 8, *(const LAS u32x4*)(L3 + MI_QS + j * MI_VRS + dp * 16)); }
        __syncthreads();
    }
}

constexpr int ML_QS = 0, ML_KS = 17408, ML_VW = 34816, ML_OFFB = 41984, ML_CS = 83968, ML_CSB = 13056, ML_SC = 110080, ML_SCB = 2048, ML_END = 116224;
constexpr int ML_RS = 272, ML_VRS = 112, NCHUNK = NSTEP / 64;

__device__ __forceinline__ void phase_mlstm(const P& p, LAS unsigned char* L3, int task) {
    int tid_ = threadIdx.x; asm volatile("" : "+v"(tid_));
    const int tid = tid_, lane = tid & 63, w = __builtin_amdgcn_readfirstlane(tid >> 6), g = lane >> 4, li = lane & 15, q4 = li >> 2, p4 = li & 3;
    const int stream = task >> 3, sl = task & 7, dir = stream >> 3, b = (stream >> 2) & 1, h = stream & 3;
    const bf16_t* PROJ = (const bf16_t*)(p.ws + WS_PROJ); const bf16_t* QC = (const bf16_t*)((unsigned char*)p.out + DO_QC); const bf16_t* KC = (const bf16_t*)((unsigned char*)p.out + DO_KC);
    const float* GATES = (const float*)(p.ws + WS_GATES); const float* DENS = (const float*)(p.ws + WS_DENS) + dir * (NTOK * 4);
    bf16_t* H = (bf16_t*)(p.ws + (dir ? WS_HB : WS_HF));
    const int mt = w >> 1, nh = w & 1;
    for (int i = tid; i < 2 * ML_CSB / 4; i += 512) ((LAS unsigned*)(L3 + ML_CS))[i] = 0u;
    auto rlow = [&](int c) -> int { const int r0 = step_row(64 * c, b, dir); return dir ? r0 - 63 : r0; };
    unsigned offQ[2], offV = 0u, offNS[4], offGt, offDn;
#pragma unroll
    for (int i = 0; i < 2; ++i) { const int pc = tid + 512 * i, j = pc >> 4, dp = pc & 15; offQ[i] = (unsigned)((dir ? 63 - j : j) * 1024 + dp * 16); }
    if (tid < 256) { const int j = tid >> 2, pc = tid & 3; offV = (unsigned)((dir ? 63 - j : j) * (LDP * 2) + pc * 16); }
#pragma unroll
    for (int r = 0; r < 4; ++r) { const int j = 16 * mt + 4 * g + r; offNS[r] = (unsigned)((dir ? 63 - j : j) * (RW * 2) + (16 * nh + li) * 2); }
    offGt = (unsigned)((dir ? 63 - lane : lane) * 64); offDn = (unsigned)((dir ? 63 - lane : lane) * 16);
    const unsigned char* QCb = (const unsigned char*)QC + h * 256; const unsigned char* KCb = (const unsigned char*)KC + h * 256;
    const unsigned char* PVb = (const unsigned char*)PROJ + (C_VM + h * 256 + sl * 32) * 2; unsigned char* Hb = (unsigned char*)H + (h * 256 + sl * 32) * 2;
    const unsigned char* GTb = (const unsigned char*)GATES + (dir * 4 + h) * 4; const unsigned char* DNb = (const unsigned char*)DENS + h * 4;
    struct Stg { u32x4 q[2], k[2], v; };
    Stg S; float g_i = 0.f, g_f = 0.f, g_d = 0.f; float m_old = 0.f;
    auto load_chunk = [&](int c) {
        const size_t rl = (size_t)rlow(c);
#pragma unroll
        for (int i = 0; i < 2; ++i) { S.q[i] = *(const u32x4*)(QCb + rl * 1024 + offQ[i]); S.k[i] = *(const u32x4*)(KCb + rl * 1024 + offQ[i]); }
        if (tid < 256) S.v = *(const u32x4*)(PVb + rl * (LDP * 2) + offV);
    };
    auto load_ns = [&](int c, bf16_t (&ns)[4]) {
        if (c >= LC / 64) { const unsigned char* hb = Hb + (size_t)rlow(c) * (RW * 2);
#pragma unroll
            for (int r = 0; r < 4; ++r) ns[r] = *(const bf16_t*)(hb + offNS[r]); }
    };
    auto load_gates = [&](int c) { if (w == 0) { const size_t rl = (size_t)rlow(c); g_i = *(const float*)(GTb + rl * 64 + offGt); g_f = *(const float*)(GTb + rl * 64 + 32 + offGt); g_d = c >= LC / 64 ? *(const float*)(DNb + rl * 16 + offDn) : 0.f; } };
    auto scalars = [&](int buf) {
        const float bc = wave_scan_add(g_f);
        const float a = g_i - bc; const float pml = wave_scan_max(a);
        const float pm = fmaxf(pml, m_old);
        const float pmL = lane_bcast63(pm), bl = lane_bcast63(bc);
        LAS float* sc = (LAS float*)(L3 + ML_SC + buf * ML_SCB);
        sc[lane] = __expf(pml - pm); sc[64 + lane] = __expf(m_old - pm); sc[128 + lane] = __expf(-(bc + pm)); sc[192 + lane] = __expf(a - pmL); sc[256 + lane] = g_d;
        if (lane == 0) sc[320] = __expf(m_old - pmL);
        m_old = bl + pmL;
    };
    auto write_stage = [&](int buf, int scb) {
        LAS unsigned char* B = L3 + buf * ML_OFFB; const LAS float* sc = (const LAS float*)(L3 + ML_SC + scb * ML_SCB);
#pragma unroll
        for (int i = 0; i < 2; ++i) { const int pc = tid + 512 * i, j = pc >> 4, dp = pc & 15; *(LAS u32x4*)(B + ML_QS + j * ML_RS + dp * 16) = S.q[i]; *(LAS u32x4*)(B + ML_KS + j * ML_RS + dp * 16) = S.k[i]; }
        if (tid < 256) { const int j = tid >> 2, pc = tid & 3; const float wk = sc[192 + j]; const u32x4 vreg = S.v;
            u32x4 o; o.x = pk2(bflo(vreg.x) * wk, bfhi(vreg.x) * wk); o.y = pk2(bflo(vreg.y) * wk, bfhi(vreg.y) * wk); o.z = pk2(bflo(vreg.z) * wk, bfhi(vreg.z) * wk); o.w = pk2(bflo(vreg.w) * wk, bfhi(vreg.w) * wk);
            *(LAS u32x4*)(B + ML_VW + j * ML_VRS + pc * 16) = o; }
        else if (tid < 320) { const int j = tid - 256; LAS u32x4* d = (LAS u32x4*)(B + ML_VW + j * ML_VRS + 64); d[0] = (u32x4){f2bf(sc[192 + j]), 0u, 0u, 0u}; d[1] = (u32x4){0u, 0u, 0u, 0u}; }
    };
    load_chunk(0); load_gates(0);
    if (w == 0) scalars(0);
    load_gates(1);
    __syncthreads();
    write_stage(0, 0);
    if (w == 0) scalars(1);
    load_chunk(1); load_gates(2);
    bf16_t nsA[4], nsB[4]; load_ns(0, nsA); load_ns(1, nsB);
    __syncthreads();
    f32x4 accC[3];
#pragma unroll
    for (int i = 0; i < 3; ++i) accC[i] = (f32x4){0.f, 0.f, 0.f, 0.f};
    auto mstep = [&](int c, bf16_t (&nsCur)[4]) {
        const int cur = c & 1, nxt = cur ^ 1;
        LAS unsigned char* B = L3 + cur * ML_OFFB; const LAS float* sc = (const LAS float*)(L3 + ML_SC + (c % 3) * ML_SCB);
        float hv[4];
        if (c >= LC / 64) {
            const LAS unsigned char* CSc = L3 + ML_CS + cur * ML_CSB;
            f32x4 nC[2] = {(f32x4){0.f, 0.f, 0.f, 0.f}, (f32x4){0.f, 0.f, 0.f, 0.f}};
#pragma unroll
            for (int ks = 0; ks < 4; ++ks) {
                const bf16x8 aq = *(const LAS bf16x8*)(B + ML_QS + (16 * mt + li) * ML_RS + (32 * ks + 8 * g) * 2);
#pragma unroll
                for (int x = 0; x < 2; ++x) { const int vt = x ? 2 : nh; const bf16x8 bc = *(const LAS bf16x8*)(CSc + (16 * vt + li) * ML_RS + (32 * ks + 8 * g) * 2); nC[x] = __builtin_amdgcn_mfma_f32_16x16x32_bf16(aq, bc, nC[x], 0, 0, 0); }
            }
            const f32x4 resc = *(const LAS f32x4*)(sc + 16 * mt + 4 * g), inter = *(const LAS f32x4*)(sc + 64 + 16 * mt + 4 * g), emj = *(const LAS f32x4*)(sc + 128 + 16 * mt + 4 * g), dns = *(const LAS f32x4*)(sc + 256 + 16 * mt + 4 * g);
#pragma unroll
            for (int r = 0; r < 4; ++r) {
                const float denC = __shfl(nC[1][r], lane & 48);
                const float den = resc[r] * dns[r] + inter[r] * denC;
                hv[r] = (resc[r] * bf2f(nsCur[r]) + inter[r] * nC[0][r]) * __builtin_amdgcn_rcpf(fmaxf(fabsf(den), emj[r]));
            }
        }
        {
            const float decay = sc[320];
            bf16x8 bkT[2];
#pragma unroll
            for (int ks = 0; ks < 2; ++ks) bkT[ks] = tr8(B + ML_KS + (32 * ks + 8 * g + q4) * ML_RS + 32 * w + 8 * p4, 4 * ML_RS);
#pragma unroll
            for (int vt = 0; vt < 3; ++vt) {
                accC[vt] = accC[vt] * decay;
#pragma unroll
                for (int ks = 0; ks < 2; ++ks) { const bf16x8 av = tr8(B + ML_VW + (32 * ks + 8 * g + q4) * ML_VRS + 32 * vt + 8 * p4, 4 * ML_VRS); accC[vt] = __builtin_amdgcn_mfma_f32_16x16x32_bf16(av, bkT[ks], accC[vt], 0, 0, 0); }
            }
            LAS unsigned char* CSn = L3 + ML_CS + nxt * ML_CSB;
#pragma unroll
            for (int vt = 0; vt < 3; ++vt)
#pragma unroll
                for (int r = 0; r < 4; ++r) *(LAS bf16_t*)(CSn + (16 * vt + 4 * g + r) * ML_RS + (16 * w + li) * 2) = (bf16_t)f2bf(accC[vt][r]);
        }
        if (w == 0 && c + 2 < NCHUNK) scalars((c + 2) % 3);
        if (c + 1 < NCHUNK) write_stage(nxt, (c + 1) % 3);
        if (c >= LC / 64) {
            unsigned char* hb = Hb + (size_t)rlow(c) * (RW * 2);
#pragma unroll
            for (int r = 0; r < 4; ++r) st_b16(hb + offNS[r], f2bf(hv[r]));
        }
        if (c + 2 < NCHUNK) { load_chunk(c + 2); load_ns(c + 2, nsCur); }
        if (c + 3 < NCHUNK) load_gates(c + 3);
        __syncthreads();
    };
    for (int c = 0; c < NCHUNK; c += 2) { mstep(c, nsA); mstep(c + 1, nsB); }
}
template <bool ATR, bool BTR>
__device__ __forceinline__ void mm_tiles(const LAS unsigned char* A, int a_rs, const LAS unsigned char* Bm, int b_rs, int ksteps, f32x4 (&acc)[2], int mt, int nt0, int g, int li) {
    const int q4 = li >> 2, p4 = li & 3;
    for (int ks = 0; ks < ksteps; ++ks) {
        const bf16x8 a = ATR ? tr8(A + (32 * ks + 8 * g + q4) * a_rs + 32 * mt + 8 * p4, 4 * a_rs) : *(const LAS bf16x8*)(A + (16 * mt + li) * a_rs + (32 * ks + 8 * g) * 2);
#pragma unroll
        for (int n = 0; n < 2; ++n) {
            const bf16x8 b = BTR ? tr8(Bm + (32 * ks + 8 * g + q4) * b_rs + 32 * (nt0 + n) + 8 * p4, 4 * b_rs) : *(const LAS bf16x8*)(Bm + (16 * (nt0 + n) + li) * b_rs + (32 * ks + 8 * g) * 2);
            acc[n] = __builtin_amdgcn_mfma_f32_16x16x32_bf16(a, b, acc[n], 0, 0, 0);
        }
    }
}
constexpr int R1_TLW = 0, R1_LA = 9216, R1_SG = 18432, R1_FW = 39936, R1_FA = 57344;
constexpr int R1_AK = 0, R1_ABO = 9216, R1_BK = 18432, R1_BB = 27648, R1_ABF = 36864, R1_AKV = 40960, R1_TINV = 50176, R1_LP = 54272;
constexpr int R1_WT = 74752, R1_ELC = R1_WT + 2048, R1_KAP = 77056, R1_KT = 86272, R1_BT = 95488, R1_RHO = 104704, R1_VV = 113920, R1_XB = 123136, R1_END = 140544;
constexpr int R1_PAR = R1_END;
constexpr int R1_RS = 144, R1_SGRS = 336, R1_FRS = 272, R1_RHRS = 528, R1_XRS = 272;
constexpr int NTASK_R1 = 64 * NCHUNK;
constexpr int CH_M = 0, CH_G = 8192, CH_N = 16384, CH_E = 24576, CH_REC = 24832;
__device__ __forceinline__ int afrag_off(int row, int k) { return ((((row >> 4) * 2 + (k >> 5)) * 64 + ((k >> 3) & 3) * 16 + (row & 15)) * 8 + (k & 7)) * 2; }

__device__ __forceinline__ float fsig(float x) { return __builtin_amdgcn_rcpf(1.f + __expf(-x)); }
__device__ __forceinline__ float ftanh(float x) { return 1.f - 2.f * __builtin_amdgcn_rcpf(1.f + __expf(2.f * x)); }
__device__ __forceinline__ u32x4 map8_tanh(const u32x4 v) { u32x4 o; o.x = pk2(ftanh(bflo(v.x)), ftanh(bfhi(v.x))); o.y = pk2(ftanh(bflo(v.y)), ftanh(bfhi(v.y))); o.z = pk2(ftanh(bflo(v.z)), ftanh(bfhi(v.z))); o.w = pk2(ftanh(bflo(v.w)), ftanh(bfhi(v.w))); return o; }
__device__ __forceinline__ u32x4 map8_sig(const u32x4 v) { u32x4 o; o.x = pk2(fsig(bflo(v.x)), fsig(bfhi(v.x))); o.y = pk2(fsig(bflo(v.y)), fsig(bfhi(v.y))); o.z = pk2(fsig(bflo(v.z)), fsig(bfhi(v.z))); o.w = pk2(fsig(bflo(v.w)), fsig(bfhi(v.w))); return o; }
__device__ __forceinline__ u32x4 pack8(const float (&x)[8]) { u32x4 o; o.x = pk2(x[0], x[1]); o.y = pk2(x[2], x[3]); o.z = pk2(x[4], x[5]); o.w = pk2(x[6], x[7]); return o; }

__device__ __forceinline__ void phase_r1(const P& p, LAS unsigned char* L3, int bid, int nb, unsigned pflags) {
    int tid_ = threadIdx.x; asm volatile("" : "+v"(tid_));
    const int tid = tid_, lane = tid & 63, w = __builtin_amdgcn_readfirstlane(tid >> 6);
#define R1_LANES int lz_ = tid; asm volatile("" : "+v"(lz_)); const int g = (lz_ >> 4) & 3, li = lz_ & 15, q4 = li >> 2, p4 = li & 3, t = lz_ >> 3, c8 = (lz_ & 7) * 8; (void)g; (void)li; (void)q4; (void)p4; (void)t; (void)c8;
    const int mt = w >> 1, nt0 = 2 * (w & 1);
    const bf16_t* PROJ = (const bf16_t*)(p.ws + WS_PROJ);
    const bf16_t* WUPT = (const bf16_t*)(p.ws + WS_WUPT); const bf16_t* AUPT = (const bf16_t*)(p.ws + WS_AUPT); const bf16_t* GUPT = (const bf16_t*)(p.ws + WS_GUPT);
    bf16_t* GG = (bf16_t*)((unsigned char*)p.out + DO_GG);
    if (bid >= NTASK_R1) return;
    const int stream = bid & 63, dir = stream >> 5, b = (stream >> 4) & 1, h = stream & 15;
    float* BON = (float*)(p.ws + (dir ? WS_BONUS_B : WS_BONUS));
    bf16_t* Yo = (bf16_t*)(p.ws + (dir ? WS_YB : WS_YF));
    bf16x8 wfr[2][2], afr[2][2];
    {
        R1_LANES
#pragma unroll
        for (int ks = 0; ks < 2; ++ks)
#pragma unroll
            for (int n = 0; n < 2; ++n) { const size_t wo = ((size_t)(dir * 1024 + 64 * h + 16 * (nt0 + n) + li) * 64 + 32 * ks + 8 * g); wfr[ks][n] = *(const bf16x8*)(WUPT + wo); afr[ks][n] = *(const bf16x8*)(AUPT + wo); }
    }
    if (tid < 64) {
        const int ch = 64 * h + tid; LAS float* pp = (LAS float*)(L3 + R1_PAR);
        pp[tid] = p.r_w0[dir * RW + ch]; pp[64 + tid] = p.r_a0[dir * RW + ch]; pp[128 + tid] = p.r_k_k[ch]; pp[192 + tid] = p.r_k_a[ch]; pp[256 + tid] = p.r_r_k[ch];
    }
    struct Ld { u32x4 rr, kr, vr, lw, la, lg[3]; int row; };
    auto load_task = [&](int task, Ld& X) {
        int lz0_ = tid; asm volatile("" : "+v"(lz0_)); const int t0 = lz0_ >> 3, c80 = (lz0_ & 7) * 8;
        X.row = step_row(64 * (task >> 6) + t0, b, dir);
        const bf16_t* pr = PROJ + (size_t)X.row * LDP;
        X.rr = *(const u32x4*)(pr + C_R + 64 * h + c80); X.kr = *(const u32x4*)(pr + C_KR + 64 * h + c80); X.vr = *(const u32x4*)(pr + C_VR + 64 * h + c80);
        X.lw = *(const u32x4*)(pr + C_LW + 64 * dir + c80); X.la = *(const u32x4*)(pr + C_LA + 64 * dir + c80);
        const int cc_ = task >> 6, tcl_ = dir ? 63 - (cc_ - LC / 64) : cc_ - LC / 64;
        if (cc_ >= LC / 64 && (tcl_ & 1) == dir) {
#pragma unroll
            for (int i = 0; i < 3; ++i) { const int pc = lz0_ + 512 * i; if (pc < 64 * 20) { const int tt = pc / 20, q = pc % 20; X.lg[i] = *(const u32x4*)(PROJ + (size_t)step_row(64 * (task >> 6) + tt, b, dir) * LDP + C_LG + q * 8); } }
        }
    };
    Ld cur; load_task(bid, cur);
    unsigned long long dS[10] = {0,0,0,0,0,0,0,0,0,0}, tq = 0; if (DIAG_ON) tq = tick();
#define R1_MARK(k) if (DIAG_ON) { const unsigned long long tn = tick(); dS[k] += tn - tq; tq = tn; }
    for (int task = bid; task < NTASK_R1; task += nb) {
        const int c = task >> 6;
        const bool lat = c >= LC / 64;
        const int tc_ = dir ? 63 - (c - LC / 64) : c - LC / 64;
        const bool do_g = lat && (tc_ & 1) == dir;
        unsigned char* rec = p.ws + WS_CHD + (size_t)(stream * NCHUNK + c) * CH_REC;
        const u32x4 rr = cur.rr, kr = cur.kr, vr = cur.vr; const int row = cur.row;
        bf16x8 gb[5][2];
        if (do_g) {
            R1_LANES
#pragma unroll
            for (int ks = 0; ks < 5; ++ks)
#pragma unroll
                for (int n = 0; n < 2; ++n) gb[ks][n] = *(const bf16x8*)(GUPT + (size_t)(64 * h + 16 * (nt0 + n) + li) * 160 + 32 * ks + 8 * g);
        }
        {
            R1_LANES
            *(LAS u32x4*)(L3 + R1_TLW + t * R1_RS + c8 * 2) = map8_tanh(cur.lw);
            *(LAS u32x4*)(L3 + R1_LA + t * R1_RS + c8 * 2) = cur.la;
            if (do_g) {
#pragma unroll
                for (int i = 0; i < 3; ++i) { const int pc = lz_ + 512 * i; if (pc < 64 * 20) { const int tt = pc / 20, q = pc % 20; *(LAS u32x4*)(L3 + R1_SG + tt * R1_SGRS + q * 16) = map8_sig(cur.lg[i]); } }
            }
        }
        __syncthreads();
        R1_MARK(0)
        {
            R1_LANES
            f32x4 aw[2], aa[2];
#pragma unroll
            for (int n = 0; n < 2; ++n) { aw[n] = (f32x4){0.f, 0.f, 0.f, 0.f}; aa[n] = (f32x4){0.f, 0.f, 0.f, 0.f}; }
#pragma unroll
            for (int ks = 0; ks < 2; ++ks) {
                const bf16x8 a1 = *(const LAS bf16x8*)(L3 + R1_TLW + (16 * mt + li) * R1_RS + (32 * ks + 8 * g) * 2);
                const bf16x8 a2 = *(const LAS bf16x8*)(L3 + R1_LA + (16 * mt + li) * R1_RS + (32 * ks + 8 * g) * 2);
#pragma unroll
                for (int n = 0; n < 2; ++n) { aw[n] = __builtin_amdgcn_mfma_f32_16x16x32_bf16(a1, wfr[ks][n], aw[n], 0, 0, 0); aa[n] = __builtin_amdgcn_mfma_f32_16x16x32_bf16(a2, afr[ks][n], aa[n], 0, 0, 0); }
            }
#pragma unroll
            for (int n = 0; n < 2; ++n)
#pragma unroll
                for (int r = 0; r < 4; ++r) {
                    *(LAS float*)(L3 + R1_FW + (16 * mt + 4 * g + r) * R1_FRS + (16 * (nt0 + n) + li) * 4) = aw[n][r];
                    *(LAS float*)(L3 + R1_FA + (16 * mt + 4 * g + r) * R1_FRS + (16 * (nt0 + n) + li) * 4) = aa[n][r];
                }
            if (do_g) {
                f32x4 ag[2] = {(f32x4){0.f, 0.f, 0.f, 0.f}, (f32x4){0.f, 0.f, 0.f, 0.f}};
#pragma unroll
                for (int ks = 0; ks < 5; ++ks) {
                    const bf16x8 a3 = *(const LAS bf16x8*)(L3 + R1_SG + (16 * mt + li) * R1_SGRS + (32 * ks + 8 * g) * 2);
#pragma unroll
                    for (int n = 0; n < 2; ++n) ag[n] = __builtin_amdgcn_mfma_f32_16x16x32_bf16(a3, gb[ks][n], ag[n], 0, 0, 0);
                }
#pragma unroll
                for (int n = 0; n < 2; ++n)
#pragma unroll
                    for (int r = 0; r < 4; ++r) *(LAS bf16_t*)(L3 + R1_XB + (16 * mt + 4 * g + r) * R1_RS + (16 * (nt0 + n) + li) * 2) = (bf16_t)f2bf(ag[n][r]);
            }
        }
        __syncthreads();
        R1_MARK(1)
        {
            float kap[8];
            R1_LANES
            const int ch = 64 * h + c8;
            if (do_g) st_b128(GG + (size_t)row * RW + ch, *(const LAS u32x4*)(L3 + R1_XB + t * R1_RS + c8 * 2));
            float fw[8], fa[8], w0[8], a0[8], rkk[8], rka[8], rrk[8];
            *(f32x4*)&fw[0] = *(const LAS f32x4*)(L3 + R1_FW + t * R1_FRS + c8 * 4); *(f32x4*)&fw[4] = *(const LAS f32x4*)(L3 + R1_FW + t * R1_FRS + c8 * 4 + 16);
            *(f32x4*)&fa[0] = *(const LAS f32x4*)(L3 + R1_FA + t * R1_FRS + c8 * 4); *(f32x4*)&fa[4] = *(const LAS f32x4*)(L3 + R1_FA + t * R1_FRS + c8 * 4 + 16);
#pragma unroll
            for (int i = 0; i < 2; ++i) {
                *(f32x4*)&w0[4 * i] = *(const LAS f32x4*)(L3 + R1_PAR + (c8 + 4 * i) * 4); *(f32x4*)&a0[4 * i] = *(const LAS f32x4*)(L3 + R1_PAR + (64 + c8 + 4 * i) * 4);
                *(f32x4*)&rkk[4 * i] = *(const LAS f32x4*)(L3 + R1_PAR + (128 + c8 + 4 * i) * 4); *(f32x4*)&rka[4 * i] = *(const LAS f32x4*)(L3 + R1_PAR + (192 + c8 + 4 * i) * 4); *(f32x4*)&rrk[4 * i] = *(const LAS f32x4*)(L3 + R1_PAR + (256 + c8 + 4 * i) * 4);
            }
            float krf[8], rf[8]; unpack8(kr, krf); unpack8(rr, rf);
            float wl[8], av[8], kkv[8], lam[8]; float ss = 0.f, bs = 0.f;
#pragma unroll
            for (int i = 0; i < 8; ++i) {
                wl[i] = -0.6065306597126334f * fsig(w0[i] + fw[i]);
                av[i] = fsig(a0[i] + fa[i]);
                kkv[i] = krf[i] * rkk[i]; ss += kkv[i] * kkv[i];
                bs += rf[i] * krf[i] * rrk[i] * (1.f - rka[i] + rka[i] * av[i]);
                lam[i] = wl[i];
            }
            ss += __shfl_xor(ss, 1); ss += __shfl_xor(ss, 2); ss += __shfl_xor(ss, 4);
            bs += __shfl_xor(bs, 1); bs += __shfl_xor(bs, 2); bs += __shfl_xor(bs, 4);
            const float rn = rsqrtf(ss + 1e-12f);
            if ((tid & 7) == 0) st_b32(BON + (size_t)row * 16 + h, bs);
#pragma unroll
            for (int o = 8; o < 64; o <<= 1)
#pragma unroll
                for (int i = 0; i < 8; ++i) { const float tv = __shfl_up(lam[i], o); if (lane >= o) lam[i] += tv; }
            if ((lane >> 3) == 7) { *(LAS f32x4*)(L3 + R1_WT + w * 256 + c8 * 4) = *(f32x4*)&lam[0]; *(LAS f32x4*)(L3 + R1_WT + w * 256 + c8 * 4 + 16) = *(f32x4*)&lam[4]; }
            __syncthreads();
            float lc[8];
#pragma unroll
            for (int i = 0; i < 8; ++i) lc[i] = 0.f;
#pragma unroll
            for (int ww = 0; ww < 8; ++ww) {
                float tv[8]; *(f32x4*)&tv[0] = *(const LAS f32x4*)(L3 + R1_WT + ww * 256 + c8 * 4); *(f32x4*)&tv[4] = *(const LAS f32x4*)(L3 + R1_WT + ww * 256 + c8 * 4 + 16);
#pragma unroll
                for (int i = 0; i < 8; ++i) { lc[i] += tv[i]; if (ww < w) lam[i] += tv[i]; }
            }
            float kt8[8], bt8[8], rho8[8];
#pragma unroll
            for (int i = 0; i < 8; ++i) {
                const float e_cur = __expf(lam[i]), e_prev = e_cur * __expf(-wl[i]), e_inv = __expf(-lam[i]);
                const float kk = kkv[i] * rn, kd = krf[i] * (1.f + (av[i] - 1.f) * rka[i]);
                kap[i] = kk * e_prev; rho8[i] = rf[i] * e_cur; kt8[i] = kd * e_inv; bt8[i] = kk * av[i] * e_inv;
            }
            *(LAS u32x4*)(L3 + R1_KAP + t * R1_RS + c8 * 2) = pack8(kap);
            *(LAS u32x4*)(L3 + R1_KT + t * R1_RS + c8 * 2) = pack8(kt8);
            *(LAS u32x4*)(L3 + R1_BT + t * R1_RS + c8 * 2) = pack8(bt8);
            *(LAS u32x4*)(L3 + R1_RHO + t * R1_RS + c8 * 2) = pack8(rho8);
            *(LAS u32x4*)(L3 + R1_VV + t * R1_RS + c8 * 2) = vr;
            if (t == 63) {
                f32x4 e0, e1; e0.x = __expf(lc[0]); e0.y = __expf(lc[1]); e0.z = __expf(lc[2]); e0.w = __expf(lc[3]); e1.x = __expf(lc[4]); e1.y = __expf(lc[5]); e1.z = __expf(lc[6]); e1.w = __expf(lc[7]);
                *(LAS f32x4*)(L3 + R1_ELC + c8 * 4) = e0; *(LAS f32x4*)(L3 + R1_ELC + c8 * 4 + 16) = e1;
                st_f128(rec + CH_E + c8 * 4, e0); st_f128(rec + CH_E + c8 * 4 + 16, e1);
            }
        }
        if (task + nb < NTASK_R1) load_task(task + nb, cur);
        __syncthreads();
        if (pflags & 32u) continue;
        R1_MARK(2)
        {
            R1_LANES
            for (int i = tid; i < 64 * R1_XRS / 16; i += 512) *(LAS u32x4*)(L3 + R1_XB + i * 16) = (u32x4){0u, 0u, 0u, 0u};
            for (int i = tid; i < (4096 + 9216) / 16; i += 512) *(LAS u32x4*)(L3 + R1_TINV + i * 16) = (u32x4){0u, 0u, 0u, 0u};
            f32x4 ak[2], ab[2], bk[2], bb[2];
#pragma unroll
            for (int n = 0; n < 2; ++n) { ak[n] = (f32x4){0.f, 0.f, 0.f, 0.f}; ab[n] = ak[n]; bk[n] = ak[n]; bb[n] = ak[n]; }
            if (nt0 <= mt) {
                mm_tiles<false, false>(L3 + R1_KAP, R1_RS, L3 + R1_KT, R1_RS, 2, ak, mt, nt0, g, li);
                mm_tiles<false, false>(L3 + R1_KAP, R1_RS, L3 + R1_BT, R1_RS, 2, ab, mt, nt0, g, li);
                mm_tiles<false, false>(L3 + R1_RHO, R1_RS, L3 + R1_KT, R1_RS, 2, bk, mt, nt0, g, li);
                mm_tiles<false, false>(L3 + R1_RHO, R1_RS, L3 + R1_BT, R1_RS, 2, bb, mt, nt0, g, li);
            }
#pragma unroll
            for (int n = 0; n < 2; ++n)
#pragma unroll
                for (int r = 0; r < 4; ++r) {
                    const int tt = 16 * mt + 4 * g + r, ii = 16 * (nt0 + n) + li; const bool sl = ii < tt, le = ii <= tt, dg = (nt0 + n) == mt;
                    const int o = tt * R1_RS + ii * 2;
                    *(LAS bf16_t*)(L3 + R1_AK + o) = (bf16_t)f2bf(sl ? ak[n][r] : 0.f);
                    *(LAS bf16_t*)(L3 + R1_ABO + o) = (bf16_t)f2bf((sl && !dg) ? ab[n][r] : 0.f);
                    *(LAS bf16_t*)(L3 + R1_BK + o) = (bf16_t)f2bf(le ? bk[n][r] : 0.f);
                    *(LAS bf16_t*)(L3 + R1_BB + o) = (bf16_t)f2bf(le ? bb[n][r] : 0.f);
                    if (dg) *(LAS float*)(L3 + R1_ABF + (mt * 256 + (4 * g + r) * 16 + li) * 4) = sl ? ab[n][r] : 0.f;
                }
        }
        __syncthreads();
        R1_MARK(3)
        f32x4 y0a[2], na[2];
        {
            R1_LANES
            f32x4 akv[2];
#pragma unroll
            for (int n = 0; n < 2; ++n) { akv[n] = (f32x4){0.f, 0.f, 0.f, 0.f}; y0a[n] = akv[n]; na[n] = akv[n]; }
            mm_tiles<false, true>(L3 + R1_AK, R1_RS, L3 + R1_VV, R1_RS, 2, akv, mt, nt0, g, li);
            mm_tiles<false, true>(L3 + R1_BK, R1_RS, L3 + R1_VV, R1_RS, 2, y0a, mt, nt0, g, li);
            mm_tiles<true, true>(L3 + R1_KT, R1_RS, L3 + R1_VV, R1_RS, 2, na, mt, nt0, g, li);
#pragma unroll
            for (int n = 0; n < 2; ++n)
#pragma unroll
                for (int r = 0; r < 4; ++r) *(LAS bf16_t*)(L3 + R1_AKV + (16 * mt + 4 * g + r) * R1_RS + (16 * (nt0 + n) + li) * 2) = (bf16_t)f2bf(akv[n][r]);
            if (w == 0) {
                const int blk = lz_ >> 4, col = lz_ & 15;
                float tv[16];
#pragma unroll
                for (int i = 0; i < 16; ++i) tv[i] = (i == col) ? 1.f : 0.f;
#pragma unroll
                for (int i = 1; i < 16; ++i) {
                    const LAS float* lrow = (const LAS float*)(L3 + R1_ABF + (blk * 256 + i * 16) * 4);
                    float lv[16];
#pragma unroll
                    for (int j4 = 0; j4 < (i + 3) / 4; ++j4) *(f32x4*)&lv[4 * j4] = *(const LAS f32x4*)(lrow + 4 * j4);
#pragma unroll
                    for (int j = 0; j < i; ++j) tv[i] -= lv[j] * tv[j];
                    asm volatile("" ::: "memory");
                }
#pragma unroll
                for (int i = 0; i < 16; ++i) *(LAS bf16_t*)(L3 + R1_TINV + ((blk * 16 + i) * 32 + col) * 2) = (bf16_t)f2bf(tv[i]);
            }
        }
        __syncthreads();
        R1_MARK(4)
        {
            R1_LANES
            const int g1 = g & 1;
            const LAS unsigned char* Rsrc = (w < 4) ? (L3 + R1_KAP + 32 * w) : (L3 + R1_AKV + 32 * (w - 4));
            f32x4 xr[4];
#pragma unroll
            for (int bi = 0; bi < 4; ++bi) {
                const bf16x8 ta = *(const LAS bf16x8*)(L3 + R1_TINV + ((bi * 16 + li) * 32 + 8 * g) * 2);
                const bf16x8 rb = tr8(Rsrc + (16 * bi + 8 * g1 + q4) * R1_RS + 8 * p4, 4 * R1_RS);
                xr[bi] = __builtin_amdgcn_mfma_f32_16x16x32_bf16(ta, rb, (f32x4){0.f, 0.f, 0.f, 0.f}, 0, 0, 0);
            }
            if (w < 6) {
                const int bi = w < 1 ? 1 : (w < 3 ? 2 : 3), bj = w < 1 ? 0 : (w < 3 ? w - 1 : w - 3);
                const bf16x8 ta = *(const LAS bf16x8*)(L3 + R1_TINV + ((bi * 16 + li) * 32 + 8 * g) * 2);
                const bf16x8 lb = tr8(L3 + R1_ABO + (16 * bi + 8 * g1 + q4) * R1_RS + 32 * bj + 8 * p4, 4 * R1_RS);
                const f32x4 lp = __builtin_amdgcn_mfma_f32_16x16x32_bf16(ta, lb, (f32x4){0.f, 0.f, 0.f, 0.f}, 0, 0, 0);
#pragma unroll
                for (int r = 0; r < 4; ++r) *(LAS bf16_t*)(L3 + R1_LP + (16 * bi + 4 * g + r) * R1_RS + (16 * bj + li) * 2) = (bf16_t)f2bf(lp[r]);
            }
            __syncthreads();
#pragma unroll
            for (int bi = 0; bi < 4; ++bi) {
                if (bi > 0) {
                    f32x4 acc = (f32x4){0.f, 0.f, 0.f, 0.f};
#pragma unroll
                    for (int ks = 0; ks < (bi + 1) / 2; ++ks) {
                        const bf16x8 a = *(const LAS bf16x8*)(L3 + R1_LP + (16 * bi + li) * R1_RS + (32 * ks + 8 * g) * 2);
                        const bf16x8 bx = tr8(L3 + R1_XB + (32 * ks + 8 * g + q4) * R1_XRS + 32 * w + 8 * p4, 4 * R1_XRS);
                        acc = __builtin_amdgcn_mfma_f32_16x16x32_bf16(a, bx, acc, 0, 0, 0);
                    }
                    xr[bi] = xr[bi] - acc;
                }
#pragma unroll
                for (int r = 0; r < 4; ++r) *(LAS bf16_t*)(L3 + R1_XB + (16 * bi + 4 * g + r) * R1_XRS + (16 * w + li) * 2) = (bf16_t)f2bf(xr[bi][r]);
                asm volatile("s_waitcnt lgkmcnt(0)" ::: "memory");
            }
        }
        __syncthreads();
        R1_MARK(5)
        {
            R1_LANES
            f32x4 gx[2], yx[2], mx[2], nx[2];
#pragma unroll
            for (int n = 0; n < 2; ++n) { gx[n] = (f32x4){0.f, 0.f, 0.f, 0.f}; yx[n] = gx[n]; mx[n] = gx[n]; nx[n] = gx[n]; }
            mm_tiles<false, true>(L3 + R1_BB, R1_RS, L3 + R1_XB, R1_XRS, 2, gx, mt, nt0, g, li);
            mm_tiles<false, true>(L3 + R1_BB, R1_RS, L3 + R1_XB + 128, R1_XRS, 2, yx, mt, nt0, g, li);
            mm_tiles<true, true>(L3 + R1_BT, R1_RS, L3 + R1_XB, R1_XRS, 2, mx, mt, nt0, g, li);
            mm_tiles<true, true>(L3 + R1_BT, R1_RS, L3 + R1_XB + 128, R1_XRS, 2, nx, mt, nt0, g, li);
            const f32x4 elc = *(const LAS f32x4*)(L3 + R1_ELC + (16 * mt + 4 * g) * 4);
#pragma unroll
            for (int n = 0; n < 2; ++n) {
                const int col = 16 * (nt0 + n) + li;
                float nv[4];
#pragma unroll
                for (int r = 0; r < 4; ++r) {
                    const int rw = 16 * mt + 4 * g + r, o = rw * R1_RS + col * 2;
                    const float rho = bf2f(*(const LAS bf16_t*)(L3 + R1_RHO + o));
                    *(LAS bf16_t*)(L3 + R1_AK + o) = (bf16_t)f2bf(rho - gx[n][r]);
                    *(LAS bf16_t*)(L3 + R1_ABO + o) = (bf16_t)f2bf(-elc[r] * mx[n][r]);
                    *(LAS bf16_t*)(L3 + R1_BK + o) = (bf16_t)f2bf(y0a[n][r] - yx[n][r]);
                    nv[r] = elc[r] * (na[n][r] - nx[n][r]);
                }
                u32x2 nf; nf.x = pk2(nv[0], nv[1]); nf.y = pk2(nv[2], nv[3]);
                st_b64(rec + CH_N + ((mt * 4 + nt0 + n) * 64 + lane) * 8, nf);
            }
        }
        __syncthreads();
        R1_MARK(6)
        {
            R1_LANES
            const int fo = (16 * (w >> 1) + li) * R1_RS + (32 * (w & 1) + 8 * g) * 2;
            st_b128(rec + CH_G + (w * 64 + lane) * 16, *(const LAS u32x4*)(L3 + R1_AK + fo));
            st_b128(rec + CH_M + (w * 64 + lane) * 16, *(const LAS u32x4*)(L3 + R1_ABO + fo));
            if (lat) st_b128(Yo + (size_t)row * RW + 64 * h + c8, *(const LAS u32x4*)(L3 + R1_BK + t * R1_RS + c8 * 2));
        }
        __syncthreads();
        R1_MARK(7)
    }
    if (DIAG_ON && bid == 0 && tid == 0) { float* dg = (float*)(p.ws + WS_DIAG); for (int k = 0; k < 8; ++k) dg[8 + k] = (float)dS[k]; }
#undef R1_MARK
#undef R1_LANES
}

constexpr int R2_SB = 0, R2_SRS = 80, R2_SBB = 64 * R2_SRS;
struct R2Regs { bf16x8 am[2], ag[2]; u32x2 nf; f32x4 el; bf16_t y0[4]; };
__device__ __forceinline__ void phase_r2(const P& p, LAS unsigned char* L3, int task, unsigned pflags) {
    int tid_ = threadIdx.x; asm volatile("" : "+v"(tid_));
    const int tid = tid_, lane = tid & 63, w = __builtin_amdgcn_readfirstlane(tid >> 6), g = lane >> 4, li = lane & 15, q4 = li >> 2, p4 = li & 3;
    const int stream = task >> 1, vh = task & 1, dir = stream >> 5, b = (stream >> 4) & 1, h = stream & 15;
    const int kt = w >> 1, vt = w & 1, vtg = 2 * vh + vt;
    bf16_t* Yo = (bf16_t*)(p.ws + (dir ? WS_YB : WS_YF));
    const unsigned char* rec0 = p.ws + WS_CHD + (size_t)stream * NCHUNK * CH_REC;
    auto rlow = [&](int c) -> int { const int r0 = step_row(64 * c, b, dir); return dir ? r0 - 63 : r0; };
    unsigned offY[4];
#pragma unroll
    for (int r = 0; r < 4; ++r) { const int j = 16 * kt + 4 * g + r; offY[r] = (unsigned)((dir ? 63 - j : j) * (RW * 2) + (16 * vtg + li) * 2); }
    unsigned char* Yb = (unsigned char*)Yo + 64 * h * 2;
    const unsigned offA0 = (unsigned)(((kt * 2 + 0) * 64 + lane) * 16), offA1 = (unsigned)(((kt * 2 + 1) * 64 + lane) * 16), offN = (unsigned)(CH_N + ((kt * 4 + vtg) * 64 + lane) * 8), offE = (unsigned)(CH_E + (16 * kt + 4 * g) * 4);
    auto loadstep = [&](int c, R2Regs& R) {
        if (pflags & 128u) return;
        const unsigned char* rec = rec0 + (size_t)c * CH_REC;
        R.am[0] = *(const bf16x8*)(rec + CH_M + offA0); R.am[1] = *(const bf16x8*)(rec + CH_M + offA1); R.ag[0] = *(const bf16x8*)(rec + CH_G + offA0); R.ag[1] = *(const bf16x8*)(rec + CH_G + offA1);
        R.nf = *(const u32x2*)(rec + offN);
        R.el = *(const f32x4*)(rec + offE);
        if (c >= LC / 64) {
            const unsigned char* yb = Yb + (size_t)rlow(c) * (RW * 2);
#pragma unroll
            for (int r = 0; r < 4; ++r) R.y0[r] = *(const bf16_t*)(yb + offY[r]);
        }
    };
    f32x4 S = (f32x4){0.f, 0.f, 0.f, 0.f};
    unsigned long long dT[4] = {0ull, 0ull, 0ull, 0ull};
    auto step = [&](int c, const R2Regs& R) {
        unsigned long long q0 = 0, q1 = 0, q2 = 0;
        if (DIAG_ON) q0 = tick();
        LAS unsigned char* SB = L3 + R2_SB + (c & 1) * R2_SBB;
        bf16x8 bs[2] = {(bf16x8){0, 0, 0, 0, 0, 0, 0, 0}, (bf16x8){0, 0, 0, 0, 0, 0, 0, 0}};
        if (!(pflags & 256u)) {
#pragma unroll
        for (int r = 0; r < 4; ++r) *(LAS bf16_t*)(SB + (16 * kt + 4 * g + r) * R2_SRS + (16 * vt + li) * 2) = (bf16_t)f2bf(S[r]);
        __syncthreads();
#pragma unroll
        for (int ks = 0; ks < 2; ++ks) bs[ks] = tr8(SB + (32 * ks + 8 * g + q4) * R2_SRS + 32 * vt + 8 * p4, 4 * R2_SRS);
        }
        if (DIAG_ON) { asm volatile("s_waitcnt lgkmcnt(0)" ::: "memory"); q1 = tick(); }
        f32x4 ns; ns[0] = R.el[0] * S[0] + bflo(R.nf.x); ns[1] = R.el[1] * S[1] + bfhi(R.nf.x); ns[2] = R.el[2] * S[2] + bflo(R.nf.y); ns[3] = R.el[3] * S[3] + bfhi(R.nf.y);
        f32x4 ya = (f32x4){0.f, 0.f, 0.f, 0.f};
        const bool lat = c >= LC / 64;
        if (lat) { ya[0] = bf2f(R.y0[0]); ya[1] = bf2f(R.y0[1]); ya[2] = bf2f(R.y0[2]); ya[3] = bf2f(R.y0[3]); }
#pragma unroll
        for (int ks = 0; ks < 2; ++ks) { ns = __builtin_amdgcn_mfma_f32_16x16x32_bf16(R.am[ks], bs[ks], ns, 0, 0, 0); ya = __builtin_amdgcn_mfma_f32_16x16x32_bf16(R.ag[ks], bs[ks], ya, 0, 0, 0); }
        if (lat && !(pflags & 512u)) {
            unsigned char* yb = Yb + (size_t)rlow(c) * (RW * 2);
#pragma unroll
            for (int r = 0; r < 4; ++r) st_b16(yb + offY[r], f2bf(ya[r]));
        }
        S = ns;
        if (DIAG_ON) { asm volatile("s_nop 7\n\ts_nop 7" : "+v"(S)); q2 = tick(); dT[0] += q1 - q0; dT[1] += q2 - q1; }
    };
    unsigned long long tA = 0, rA = 0; if (DIAG_ON) { tA = tick(); rA = __builtin_amdgcn_s_memrealtime(); }
    R2Regs Q0, Q1, Q2, Q3, Q4, Q5;
    loadstep(0, Q0); loadstep(1, Q1); loadstep(2, Q2); loadstep(3, Q3); loadstep(4, Q4);
#define R2_STEP(k, QL, QS) { if (c + (k) + 5 < NCHUNK) loadstep(c + (k) + 5, QL); if (c + (k) < NCHUNK) step(c + (k), QS); }
    for (int c = 0; c < NCHUNK; c += 6) {
        R2_STEP(0, Q5, Q0) R2_STEP(1, Q0, Q1) R2_STEP(2, Q1, Q2) R2_STEP(3, Q2, Q3) R2_STEP(4, Q3, Q4) R2_STEP(5, Q4, Q5)
    }
#undef R2_STEP
    if (DIAG_ON && task == 0 && tid == 0) { float* dg = (float*)(p.ws + WS_DIAG); dg[0] = (float)(tick() - tA); dg[1] = (float)(__builtin_amdgcn_s_memrealtime() - rA); dg[2] = (float)dT[0]; dg[3] = (float)dT[1]; }
    __syncthreads();
}
constexpr int TR_SCR = 64 * 65 * 4;
__device__ __forceinline__ void transpose_item(const float* W, int K, int N, int Npad, bf16_t* WT, int row_off, LAS float* scr, int item, int lane) {
    const int nblk = Npad / 64, kb = item / nblk, nb = item % nblk, k0 = 64 * kb, n0 = 64 * nb;
    const int n4 = (lane & 15) * 4, kq = lane >> 4;
    f32x4 v[16];
#pragma unroll
    for (int i = 0; i < 16; ++i) v[i] = (n0 + n4 < N) ? *(const f32x4*)(W + (size_t)(k0 + 4 * i + kq) * N + n0 + n4) : (f32x4){0.f, 0.f, 0.f, 0.f};
#pragma unroll
    for (int i = 0; i < 16; ++i) { LAS float* d = scr + (4 * i + kq) * 65 + n4; d[0] = v[i].x; d[1] = v[i].y; d[2] = v[i].z; d[3] = v[i].w; }
    LDS_WAIT(); asm volatile("" ::: "memory");
    const int c = lane & 7;
#pragma unroll
    for (int j = 0; j < 8; ++j) { const int n = (lane >> 3) + 8 * j; const LAS float* s = scr + (8 * c) * 65 + n;
        v4u o; o.x = pk2(s[0 * 65], s[1 * 65]); o.y = pk2(s[2 * 65], s[3 * 65]); o.z = pk2(s[4 * 65], s[5 * 65]); o.w = pk2(s[6 * 65], s[7 * 65]);
        *(GAS v4u*)(WT + (size_t)(row_off + n0 + n) * K + k0 + 8 * c) = o; }
    LDS_WAIT(); asm volatile("" ::: "memory");
}

constexpr int RING_OFF = 0, RING_BYTES = 131072;
constexpr int LDS_BYTES = 147456;
constexpr int LDSCTL_OFF = LDS_BYTES - 512, MISC_OFF = LDSCTL_OFF + 320, PARAM_OFF = LDS_BYTES - 1024;
__device__ __forceinline__ P load_params(const LAS unsigned* src) {
    P q; void** d = (void**)&q;
#pragma unroll
    for (int i = 0; i < 32; ++i) {
        const unsigned long long v = (unsigned long long)(unsigned)__builtin_amdgcn_readfirstlane((int)src[2 * i]) | ((unsigned long long)(unsigned)__builtin_amdgcn_readfirstlane((int)src[2 * i + 1]) << 32);
        d[i] = (void*)(GAS void*)v;
    }
    q.mask = 0u; q.pad = 0u;
    return q;
}
static_assert(8 * TR_SCR <= PARAM_OFF && ML_END <= PARAM_OFF && MI_END <= PARAM_OFF && R1_PAR + 1280 <= PARAM_OFF && sizeof(P) == 264, "LDS map");
constexpr int CW_BAR = 4096;
constexpr size_t CTL_ZERO_BYTES = 1 * MiB;
constexpr int NWAVES = 8;

__global__ void __launch_bounds__(NWAVES * 64, 2) mega_fwd(P p_arg) {
    extern __shared__ __attribute__((aligned(16))) unsigned char lds[];
    LAS unsigned char* L3 = (LAS unsigned char*)lds;
    volatile LAS unsigned* MISC = (volatile LAS unsigned*)(L3 + MISC_OFF);
    const int tid0 = threadIdx.x, wave = __builtin_amdgcn_readfirstlane(tid0 >> 6);
    const int G = gridDim.x, bx = blockIdx.x;
    const int vcu = (G % 8 == 0) ? (bx % 8) * (G / 8) + bx / 8 : bx;
    for (int u = tid0; u < (LDS_BYTES - LDSCTL_OFF) / 4; u += NWAVES * 64) ((LAS unsigned*)(L3 + LDSCTL_OFF))[u] = 0u;
    const LAS unsigned* PRM = (const LAS unsigned*)(L3 + PARAM_OFF);
    if (tid0 < 66) ((LAS unsigned*)(L3 + PARAM_OFF))[tid0] = ((const unsigned*)__builtin_amdgcn_kernarg_segment_ptr())[tid0];
    __syncthreads();
    XcdBarrier bar;
    { const P p = load_params(PRM); const unsigned region = (unsigned)__builtin_amdgcn_readfirstlane((int)PRM[65]); bar = xcd_barrier_post((unsigned*)(p.ws + WS_CTL) + CW_BAR + region * XCD_BAR_WORDS, MISC + 8); }
    const int gw = vcu * NWAVES + wave, ngw = G * NWAVES;
    const unsigned pflags = (unsigned)__builtin_amdgcn_readfirstlane((int)PRM[65]);
    const unsigned pmask = (unsigned)__builtin_amdgcn_readfirstlane((int)PRM[64]);
    int ph_idx_ = 0;
#define PH_BEGIN if ((pmask >> ph_idx_) & 1u) { const int tid = threadIdx.x, lane = tid & 63; (void)tid; (void)lane; const P p = load_params(PRM); unsigned char* ws = p.ws; const float* MOD = (const float*)(ws + WS_MOD); (void)MOD;
#define PH_END }
#define PH_BAR if ((pmask >> ph_idx_) & 1u) xcd_barrier(bar); ++ph_idx_;

    PH_BEGIN
    phase_mod(p, bx, G, (float*)lds);
    {
        LAS float* scr = (LAS float*)(L3 + RING_OFF + wave * TR_SCR);
        constexpr int I_IN = (D / 64) * (LDP / 64), I_OUT = (D / 64) * (D / 64);
        for (int it = gw; it < I_IN + I_OUT; it += ngw) {
            if (it < I_IN) transpose_item(p.w_in, D, NIN, LDP, (bf16_t*)(ws + WS_WIN_T), 0, scr, it, lane);
            else transpose_item(p.w_out, D, D, D, (bf16_t*)(ws + WS_WOUT_T), 0, scr, it - I_IN, lane);
        }
    }
    {
        bf16_t* WUPT = (bf16_t*)(ws + WS_WUPT); bf16_t* AUPT = (bf16_t*)(ws + WS_AUPT); bf16_t* GUPT = (bf16_t*)(ws + WS_GUPT);
        const int gt = bx * (NWAVES * 64) + tid, ngt = G * NWAVES * 64;
        for (int o = gt; o < 2 * 1024 * 64; o += ngt) { const int r = o & 63, c = (o >> 6) & 1023, d = o >> 16; const size_t si = (size_t)(d * 64 + r) * RW + c; WUPT[o] = (bf16_t)f2bf(p.r_w_up[si]); AUPT[o] = (bf16_t)f2bf(p.r_a_up[si]); }
        for (int o = gt; o < 1024 * 160; o += ngt) { const int i = o % 160, c = o / 160; GUPT[o] = (bf16_t)f2bf(p.r_g_up[(size_t)i * RW + c]); }
    }
    PH_END
    PH_BAR
    PH_BEGIN
    phase_normmod(p, 0, gw, ngw, lane);
    PH_END
    PH_BAR
    PH_BEGIN
    {
        pg8::Gemm g{(const bf16_t*)(ws + WS_HX), (const bf16_t*)(ws + WS_WIN_T), NROW, LDP, D}; pg8::StaticOrder S; S.init(NROW, LDP, G, bx);
        pg8::EpiBf16<0> E{(bf16_t*)(ws + WS_PROJ), LDP, nullptr, 0, 0, 1.f};
        pg8::gemm_phase<pg8::EpiBf16<0>, pg8::StaticOrder, true, true>(L3 + RING_OFF, g, S, E);
        {
            const bool tail = (G == 256);
            const int w0 = tail ? (bx - 116) * NWAVES + wave : gw, nw = tail ? 140 * NWAVES : ngw;
            if (!tail || bx >= 116) {
                __syncthreads();
                LAS float* scr = (LAS float*)(L3 + RING_OFF + wave * TR_SCR);
                constexpr int I_UP = (D / 64) * (FF / 64), I_DN = (FF / 64) * (D / 64);
                for (int it = w0; it < 2 * I_UP + I_DN; it += nw) {
                    if (it < I_UP) transpose_item(p.f_w_up, D, FF, FF, (bf16_t*)(ws + WS_WUG_T), 0, scr, it, lane);
                    else if (it < 2 * I_UP) transpose_item(p.f_w_gate, D, FF, FF, (bf16_t*)(ws + WS_WUG_T), FF, scr, it - I_UP, lane);
                    else transpose_item(p.f_w_down, FF, D, D, (bf16_t*)(ws + WS_WDN_T), 0, scr, it - 2 * I_UP, lane);
                }
            }
        }
    }
    PH_END
    PH_BAR
    PH_BEGIN
    if (!(pflags & 8u)) phase_prep(p, bx, G);
    if (!(pflags & 16u)) phase_r1(p, L3, bx, G, pflags);
    PH_END
    PH_BAR
    PH_BEGIN
    phase_mintra(p, L3, bx, G);
    PH_END
    PH_BAR
    PH_BEGIN
    if (bx < 128) { if (!(pflags & 2u)) phase_mlstm(p, L3, bx); } else if (bx < 256) { if (!(pflags & 4u)) phase_r2(p, L3, bx - 128, pflags); }
    PH_END
    PH_BAR
    PH_BEGIN
    phase_post(p, gw, ngw, lane);
    PH_END
    PH_BAR
    PH_BEGIN
    {
        pg8::Gemm g{(const bf16_t*)(ws + WS_MIX), (const bf16_t*)(ws + WS_WOUT_T), NTOK, D, D}; pg8::StaticOrder S; S.init(NTOK, D, G, bx);
        pg8::EpiResid E{p.x, p.out, D, MOD + 2 * 2048, NMOD};
        pg8::gemm_phase<pg8::EpiResid, pg8::StaticOrder, true, true>(L3 + RING_OFF, g, S, E);
    }
    PH_END
    PH_BAR
    PH_BEGIN
    phase_normmod(p, 1, gw, ngw, lane);
    PH_END
    PH_BAR
    PH_BEGIN
    {
        pg8::Gemm g{(const bf16_t*)(ws + WS_HX2), (const bf16_t*)(ws + WS_WUG_T), NTOK, 2 * FF, D}; pg8::StaticOrder S; S.init(NTOK, 2 * FF, G, bx);
        pg8::EpiBf16<0> E{(bf16_t*)(ws + WS_UG), 2 * FF, nullptr, 0, 0, 1.f};
        pg8::gemm_phase<pg8::EpiBf16<0>, pg8::StaticOrder, true, true>(L3 + RING_OFF, g, S, E);
    }
    PH_END
    PH_BAR
    PH_BEGIN
    phase_convact(p, gw, lane);
    PH_END
    PH_BAR
    PH_BEGIN
    {
        pg8::Gemm g{(const bf16_t*)(ws + WS_ACT), (const bf16_t*)(ws + WS_WDN_T), NTOK, D, FF}; pg8::StaticOrder S; S.init(NTOK, D, G, bx);
        pg8::EpiResid E{p.out, p.out, D, MOD + 5 * 2048, NMOD};
        pg8::gemm_phase<pg8::EpiResid, pg8::StaticOrder, true, true>(L3 + RING_OFF, g, S, E);
    }
    PH_END
    PH_BAR
    PH_BEGIN
    phase_final(p, gw, ngw, lane);
#ifdef DIAG_SLOT
    if (bx == 0 && threadIdx.x == 0) { asm volatile("s_waitcnt vmcnt(0)" ::: "memory"); p.out[0] = rintf(log2f(fmaxf(((const float*)(ws + WS_DIAG))[DIAG_SLOT], 1.f)) * 4.f) + (DIAG_SCALE); }
#endif
    PH_END
#undef PH_BEGIN
#undef PH_END
#undef PH_BAR
}

extern "C" void kernel_launch(void* const* d_in, const int* in_sizes, int n_in, void* d_out, int out_size, void* d_ws, size_t ws_size, hipStream_t stream) {
    static int grid = 0;
    if (grid == 0) {
        if (n_in != 30 || out_size != NTOK * D || ws_size < WS_END) { fprintf(stderr, "kernel_launch: unexpected n_in %d / out %d / ws %zu\n", n_in, out_size, ws_size); grid = -1; return; }
        int dev = 0, cus = 0, per_cu = 0;
        if (hipGetDevice(&dev) != hipSuccess || hipDeviceGetAttribute(&cus, hipDeviceAttributeMultiprocessorCount, dev) != hipSuccess) { grid = -1; return; }
        if (hipFuncSetAttribute((const void*)mega_fwd, hipFuncAttributeMaxDynamicSharedMemorySize, LDS_BYTES) != hipSuccess) { fprintf(stderr, "kernel_launch: hipFuncSetAttribute failed\n"); grid = -1; return; }
        if (hipOccupancyMaxActiveBlocksPerMultiprocessor(&per_cu, (const void*)mega_fwd, NWAVES * 64, LDS_BYTES) != hipSuccess || per_cu < 1) fprintf(stderr, "kernel_launch: occupancy query reports %d\n", per_cu);
        (void)hipGetLastError();
        grid = cus;
    }
    if (grid < 0) return;
    if (hipMemsetAsync((char*)d_ws + WS_CTL, 0, CTL_ZERO_BYTES, stream) != hipSuccess) { fprintf(stderr, "kernel_launch: memset failed\n"); return; }
    P p{};
    const float** f = (const float**)&p;
    for (int i = 0; i < 30; ++i) f[i] = (const float*)d_in[i];
    p.out = (float*)d_out; p.ws = (unsigned char*)d_ws; p.mask = 0x1FFFu;
    hipLaunchKernelGGL(mega_fwd, dim3(grid), dim3(NWAVES * 64), LDS_BYTES, stream, p);
#ifdef PROBE_PHASE
#ifndef PROBE_FLAGS
#define PROBE_FLAGS 0u
#endif
    { P q = p; q.mask = PROBE_PHASE; q.pad = 1u | (PROBE_FLAGS); hipLaunchKernelGGL(mega_fwd, dim3(grid), dim3(NWAVES * 64), LDS_BYTES, stream, q); }
#endif
}
```
